# Optimizing an MI355X kernel written in HIP

```python
import math
import jax, jax.numpy as jnp
from jax import lax
import numpy as np

D_MODEL = 1024
BATCH = 4
SEQ = 8192
DEPTH = 1

CHUNK = 64
Q_BLOCK = 128
ATT_HEADS = 8
ATT_HEAD_DIM = 64
ATT_WIDTH = ATT_HEADS * ATT_HEAD_DIM
IDX_HEADS = 8
IDX_DIM = 64
TOPK_MAX = 256
REL_BUCKETS = 32
REL_MAX_DIST = 1024
CONV_CH = 512
CONV_WIDTH = 31
N_BRANCH = 2
PEER_HEADS = 8
N_KEYS = 128
N_EXPERTS = N_KEYS * N_KEYS
PEER_QDIM = 256
PEER_HALF = PEER_QDIM // 2
PEER_TOPK = 16
PEER_TOKEN_BLOCK = 128
PLE_DIM = 256
EPS = 1e-6

IN_WIDTHS = (ATT_WIDTH, ATT_WIDTH, ATT_WIDTH, IDX_HEADS * IDX_DIM, IDX_DIM, IDX_HEADS, 2 * CONV_CH, N_BRANCH * D_MODEL)
IN_TOTAL = 3 * ATT_WIDTH + IDX_HEADS * IDX_DIM + IDX_DIM + IDX_HEADS + 2 * CONV_CH + N_BRANCH * D_MODEL

kernel_name = 'hybrid_dsa_conformer_peer_block'


def _split_points():
    pts, acc = [], 0
    for w in IN_WIDTHS[:-1]:
        acc += w
        pts.append(acc)
    return pts


def rms_norm(x, g):
    x32 = x.astype(jnp.float32)
    y = x32 * lax.rsqrt(jnp.mean(x32 * x32, axis=-1, keepdims=True) + EPS)
    return (y * g.astype(jnp.float32)).astype(x.dtype)


def layer_norm(x, g, b):
    x32 = x.astype(jnp.float32)
    mu = jnp.mean(x32, axis=-1, keepdims=True)
    xc = x32 - mu
    y = xc * lax.rsqrt(jnp.mean(xc * xc, axis=-1, keepdims=True) + EPS)
    return (y * g.astype(jnp.float32) + b.astype(jnp.float32)).astype(x.dtype)


def t5_bucket(rel):
    half = REL_BUCKETS // 2
    max_exact = half // 2
    ret = jnp.where(rel > 0, half, 0)
    n = jnp.abs(rel)
    nf = jnp.maximum(n, 1).astype(jnp.float32)
    large = max_exact + (jnp.log(nf / max_exact) / math.log(REL_MAX_DIST / max_exact) * (half - max_exact)).astype(jnp.int32)
    large = jnp.minimum(large, half - 1)
    return ret + jnp.where(n < max_exact, n, large)


def dsa_attention(q, k, v, qi, ki, wi, rel_bias):
    B, S = q.shape[0], q.shape[1]
    topk = min(TOPK_MAX, S // 4)
    nb = S // Q_BLOCK
    key_chunk = jnp.arange(S, dtype=jnp.int32) // CHUNK
    scale = ATT_HEAD_DIM ** -0.5
    idx_scale = (IDX_DIM ** -0.5) * (IDX_HEADS ** -0.5)

    def blockify(a):
        return jnp.moveaxis(a.reshape((B, nb, Q_BLOCK) + a.shape[2:]), 1, 0)

    def one_block(args):
        qb, qib, wib, qpos = args
        qchunk = qpos // CHUNK
        dots = jax.nn.relu(jnp.einsum('bqhd,bsd->bqhs', qib, ki))
        score = jnp.einsum('bqhs,bqh->bqs', dots, wib) * idx_scale
        visible = key_chunk[None, :] <= qchunk[:, None]
        score = jnp.where(visible[None], score, -jnp.inf)
        _, sel = lax.top_k(score, topk)
        kg = jax.vmap(lambda kk, ii: kk[ii])(k, sel)
        vg = jax.vmap(lambda vv, ii: vv[ii])(v, sel)
        logits = jnp.einsum('bqhd,bqkhd->bqhk', qb, kg).astype(jnp.float32) * scale
        bias = rel_bias[t5_bucket(sel - qpos[None, :, None])]
        logits = logits + jnp.transpose(bias, (0, 1, 3, 2)).astype(jnp.float32)
        ok = (sel // CHUNK) <= qchunk[None, :, None]
        logits = jnp.where(ok[:, :, None, :], logits, -jnp.inf)
        probs = jax.nn.softmax(logits, axis=-1).astype(vg.dtype)
        return jnp.einsum('bqhk,bqkhd->bqhd', probs, vg)

    qpos_blocks = jnp.arange(S, dtype=jnp.int32).reshape(nb, Q_BLOCK)
    out = lax.map(one_block, (blockify(q), blockify(qi), blockify(wi), qpos_blocks))
    return jnp.moveaxis(out, 0, 1).reshape(B, S, ATT_WIDTH)


def conformer_conv(glu_in, conv_w, conv_b, ln_g, ln_b, w_proj):
    a, g = jnp.split(glu_in, 2, axis=-1)
    u = a * jax.nn.sigmoid(g)
    y = lax.conv_general_dilated(u, conv_w, window_strides=(1,), padding=[(CONV_WIDTH - 1, 0)],
                                 dimension_numbers=('NWC', 'WIO', 'NWC'), feature_group_count=CONV_CH)
    y = layer_norm(y + conv_b, ln_g, ln_b)
    return jax.nn.silu(y) @ w_proj


def peer(h, w_query, sub_keys, expert_u, expert_v):
    B, S, D = h.shape
    q = (h @ w_query).reshape(B, S, PEER_HEADS, 2, PEER_HALF)
    sc = jnp.einsum('bshcd,hckd->bshck', q, sub_keys)
    sv, si = lax.top_k(sc, PEER_TOPK)
    n_cand = PEER_TOPK * PEER_TOPK
    cand_s = (sv[..., 0, :, None] + sv[..., 1, None, :]).reshape(B, S, PEER_HEADS, n_cand)
    cand_i = (si[..., 0, :, None] * N_KEYS + si[..., 1, None, :]).reshape(B, S, PEER_HEADS, n_cand)
    top_s, top_j = lax.top_k(cand_s, PEER_TOPK)
    eidx = jnp.take_along_axis(cand_i, top_j, axis=-1)
    gate = jax.nn.softmax(top_s.astype(jnp.float32), axis=-1).astype(h.dtype)
    n_sel = PEER_HEADS * PEER_TOPK
    nb = (B * S) // PEER_TOKEN_BLOCK
    hb = h.reshape(nb, PEER_TOKEN_BLOCK, D)
    eb = eidx.reshape(nb, PEER_TOKEN_BLOCK, n_sel)
    gb = gate.reshape(nb, PEER_TOKEN_BLOCK, n_sel)

    def one_block(args):
        xt, et, gt = args
        u = expert_u[et]
        v = expert_v[et]
        act = jax.nn.gelu(jnp.einsum('tnd,td->tn', u, xt)) * gt
        return jnp.einsum('tn,tnd->td', act, v)

    return lax.map(one_block, (hb, eb, gb)).reshape(B, S, D)


def setup_inputs(seed: int = 0) -> dict:
    key = jax.random.key(seed)
    ks = jax.random.split(key, 24)
    f = jnp.float32

    def nrm(k, shape, scale):
        return jax.random.normal(k, shape, f) * scale

    def gain(k, shape):
        return 1.0 + 0.05 * jax.random.normal(k, shape, f)

    return {
        'x': nrm(ks[0], (BATCH, SEQ, D_MODEL), 1.0),
        'p': nrm(ks[1], (DEPTH, BATCH, SEQ, PLE_DIM), 1.0),
        'rel_bias': nrm(ks[2], (REL_BUCKETS, ATT_HEADS), 0.1),
        'attn_norm_g': gain(ks[3], (DEPTH, D_MODEL)),
        'w_in': nrm(ks[4], (DEPTH, D_MODEL, IN_TOTAL), D_MODEL ** -0.5),
        'b_gate': nrm(ks[5], (DEPTH, N_BRANCH * D_MODEL), 0.02),
        'q_norm_g': gain(ks[6], (DEPTH, ATT_HEAD_DIM)),
        'k_norm_g': gain(ks[7], (DEPTH, ATT_HEAD_DIM)),
        'w_att_out': nrm(ks[8], (DEPTH, ATT_WIDTH, D_MODEL), ATT_WIDTH ** -0.5),
        'conv_w': nrm(ks[9], (DEPTH, CONV_WIDTH, 1, CONV_CH), CONV_WIDTH ** -0.5),
        'conv_b': nrm(ks[10], (DEPTH, CONV_CH), 0.02),
        'conv_ln_g': gain(ks[11], (DEPTH, CONV_CH)),
        'conv_ln_b': nrm(ks[12], (DEPTH, CONV_CH), 0.02),
        'w_conv_out': nrm(ks[13], (DEPTH, CONV_CH, D_MODEL), CONV_CH ** -0.5),
        'w_out': nrm(ks[14], (DEPTH, D_MODEL, D_MODEL), D_MODEL ** -0.5),
        'ffn_norm_g': gain(ks[15], (DEPTH, D_MODEL)),
        'w_peer_q': nrm(ks[16], (DEPTH, D_MODEL, PEER_HEADS * PEER_QDIM), D_MODEL ** -0.5),
        'peer_sub_keys': nrm(ks[17], (DEPTH, PEER_HEADS, 2, N_KEYS, PEER_HALF), PEER_HALF ** -0.5),
        'peer_u': nrm(ks[18], (DEPTH, N_EXPERTS, D_MODEL), D_MODEL ** -0.5),
        'peer_v': nrm(ks[19], (DEPTH, N_EXPERTS, D_MODEL), PEER_HEADS ** -0.5),
        'ple_norm_g': gain(ks[20], (DEPTH, D_MODEL)),
        'w_ple_gate': nrm(ks[21], (DEPTH, D_MODEL, D_MODEL), D_MODEL ** -0.5),
        'w_ple_proj': nrm(ks[22], (DEPTH, PLE_DIM, D_MODEL), PLE_DIM ** -0.5),
    }


def reference(x, p, rel_bias, attn_norm_g, w_in, b_gate, q_norm_g, k_norm_g, w_att_out,
              conv_w, conv_b, conv_ln_g, conv_ln_b, w_conv_out, w_out, ffn_norm_g,
              w_peer_q, peer_sub_keys, peer_u, peer_v, ple_norm_g, w_ple_gate, w_ple_proj):
    B, S, D = x.shape
    for i in range(DEPTH):
        h = rms_norm(x, attn_norm_g[i])
        proj = h @ w_in[i]
        q, k, v, qi, ki, wi, glu_in, gates = jnp.split(proj, _split_points(), axis=-1)
        q = rms_norm(q.reshape(B, S, ATT_HEADS, ATT_HEAD_DIM), q_norm_g[i])
        k = rms_norm(k.reshape(B, S, ATT_HEADS, ATT_HEAD_DIM), k_norm_g[i])
        v = v.reshape(B, S, ATT_HEADS, ATT_HEAD_DIM)
        qi = qi.reshape(B, S, IDX_HEADS, IDX_DIM)
        y_att = dsa_attention(q, k, v, qi, ki, wi, rel_bias) @ w_att_out[i]
        y_conv = conformer_conv(glu_in, conv_w[i], conv_b[i], conv_ln_g[i], conv_ln_b[i], w_conv_out[i])
        g = jax.nn.sigmoid(gates + b_gate[i]).reshape(B, S, N_BRANCH, D)
        mixed = g[:, :, 0, :] * y_att + g[:, :, 1, :] * y_conv
        x = x + mixed @ w_out[i]
        h2 = rms_norm(x, ffn_norm_g[i])
        x = x + peer(h2, w_peer_q[i], peer_sub_keys[i], peer_u[i], peer_v[i])
        h3 = rms_norm(x, ple_norm_g[i])
        x = x + jax.nn.sigmoid(h3 @ w_ple_gate[i]) * (p[i] @ w_ple_proj[i])
    return x
```

```cpp
#include <hip/hip_runtime.h>
#include <cstdio>
#include <cstdint>
namespace pg8 {
#define PG8_LAS __attribute__((address_space(3)))
typedef unsigned short bf16_t;
typedef short bf16x8 __attribute__((ext_vector_type(8)));
typedef float f32x4 __attribute__((ext_vector_type(4)));
typedef unsigned u32x4 __attribute__((ext_vector_type(4)));
constexpr int BM = 256, BK = 64, HALF = 128, HTB = HALF * BK * 2  , STAGE_BYTES = 8 * HTB, NXCD = 8, WGM = 8;

__host__ __device__ __forceinline__ int lds_byte(int r, int c) { const int st = (r >> 4) * 2 + (c >> 5), rr = r & 15, cc = c & 31, ob = rr * 64 + cc * 2; return st * 1024 + (ob ^ (((ob >> 9) & 1) << 5)); }
__host__ __device__ __forceinline__ void stage_rc(int b, int& R, int& C) { const int st = b / 1024, sb = b % 1024, swz = sb ^ (((sb >> 9) & 1) << 5); R = (st >> 1) * 16 + swz / 64; C = (st & 1) * 32 + (swz % 64) / 2; }
__host__ __device__ __forceinline__ int perm32(int rho) { const int n = rho >> 4, i = rho & 15; return 8 * (i >> 2) + 4 * n + (i & 3); }

struct Unit { int pm, pn; };
struct Gemm { const bf16_t* A; const bf16_t* Bt; int M, N, K; };

struct StaticOrder {
    int nM, nN, nwg, G, c;
    __host__ __device__ void init(int M, int N, int G_, int c_) { nM = M / BM; nN = N / BM; nwg = nM * nN; G = G_; c = c_; }
    __host__ __device__ bool next(int i, Unit& u) const {
        const long L = (long)i * G + c; if (L >= nwg) return false;
        int wgid = (int)L; { const int q = nwg / NXCD, r = nwg % NXCD, xcd = wgid % NXCD, off = wgid / NXCD; wgid = (xcd < r ? xcd * (q + 1) : r * (q + 1) + (xcd - r) * q) + off; }
        const int nig = WGM * nN, gid = wgid / nig, fm = gid * WGM, gsz = (nM - fm) < WGM ? (nM - fm) : WGM;
        u.pm = fm + ((wgid % nig) % gsz); u.pn = (wgid % nig) / gsz; return true;
    }
    __device__ __forceinline__ void a_ready(const Unit&) const {}
    __device__ __forceinline__ void done(const Unit&) const {}
};

__device__ __forceinline__ unsigned cvt_pk_bf16(float lo, float hi) { unsigned r; asm volatile("v_cvt_pk_bf16_f32 %0, %1, %2" : "=v"(r) : "v"(lo), "v"(hi)); return r; }
typedef float f32x2 __attribute__((ext_vector_type(2)));
__device__ __forceinline__ f32x2 gelu_pk(f32x2 v) {
    const f32x2 av = __builtin_elementwise_abs(v), d = av * 0.2316418882f + 1.0f;
    f32x2 t; t.x = __builtin_amdgcn_rcpf(d.x); t.y = __builtin_amdgcn_rcpf(d.y);
    f32x2 q = t * 0.5307027145f + (-0.7265760135f); q = q * t + 0.7107068705f; q = q * t + (-0.142248368f); q = q * t + 0.127414796f; q = q * t;
    const f32x2 s = (v * v) * (-0.72134752044f);
    f32x2 e; e.x = __builtin_amdgcn_exp2f(s.x); e.y = __builtin_amdgcn_exp2f(s.y);
    const f32x2 m = v * (q * e), r = v - m;
    f32x2 o; o.x = v.x < 0.f ? m.x : r.x; o.y = v.y < 0.f ? m.y : r.y; return o;
}

template <int ACT  > struct EpiBf16 {
    static constexpr bool PERM = true, AFTER_DRAIN = false; static_assert(ACT == 0 || ACT == 1, "EpiBf16: ACT is 0 (none) or 1 (gelu_pk)");
    bf16_t* O; int ldc; const float* bias; int split_cols; size_t split_stride; float scale0;
    __device__ __forceinline__ void operator()(const f32x4 (&acc)[2][2][4][2], const Unit& u, int wr, int wc, int fr, int fq) const {
        const int row0 = u.pm * BM + wr * 64 + fr; int colt = u.pn * BM; bf16_t* base = O;
        float sc = 1.f; if (split_cols) { const int t = colt / split_cols; base += (size_t)t * split_stride; colt -= t * split_cols; if (t == 0) sc = scale0; }
        const int col0 = colt + wc * 32 + 8 * fq, bcol0 = u.pn * BM + wc * 32 + 8 * fq;
        f32x4 bv[2][2];
#pragma unroll
        for (int bj = 0; bj < 2; ++bj)
#pragma unroll
            for (int n = 0; n < 2; ++n) bv[bj][n] = bias ? *(const f32x4*)(bias + bcol0 + bj * HALF + 4 * n) : (f32x4){0.f, 0.f, 0.f, 0.f};
#pragma unroll
        for (int ai = 0; ai < 2; ++ai)
#pragma unroll
            for (int m = 0; m < 4; ++m) { bf16_t* rowp = base + (size_t)(row0 + ai * HALF + m * 16) * ldc + col0;
#pragma unroll
                for (int bj = 0; bj < 2; ++bj) { f32x4 v0 = acc[ai][bj][m][0] + bv[bj][0], v1 = acc[ai][bj][m][1] + bv[bj][1];
                    if (ACT == 1) { f32x2 a = gelu_pk((f32x2){v0[0], v0[1]}), b = gelu_pk((f32x2){v0[2], v0[3]}), c = gelu_pk((f32x2){v1[0], v1[1]}), d = gelu_pk((f32x2){v1[2], v1[3]});
                        v0 = (f32x4){a.x, a.y, b.x, b.y}; v1 = (f32x4){c.x, c.y, d.x, d.y}; }
                    v0 = v0 * sc; v1 = v1 * sc; u32x4 w; w.x = cvt_pk_bf16(v0[0], v0[1]); w.y = cvt_pk_bf16(v0[2], v0[3]); w.z = cvt_pk_bf16(v1[0], v1[1]); w.w = cvt_pk_bf16(v1[2], v1[3]);
                    *(u32x4*)(rowp + bj * HALF) = w; } }
    }
};

struct PanelStats {
    unsigned* xbuf;
    unsigned* cnt;
    unsigned* tmo;
    int ntn; float eps;
    unsigned code;
    __device__ __forceinline__ bool run(const f32x4 (&v)[2][2][4][2], const Unit& u, int wr, int wc, int fr, int fq, PG8_LAS unsigned char* lds, int wid, int lane) const {
        typedef float f32x2v __attribute__((ext_vector_type(2)));
        PG8_LAS f32x2v* P = (PG8_LAS f32x2v*)lds;
        PG8_LAS f32x2v* S = (PG8_LAS f32x2v*)(lds + 8192);
        PG8_LAS unsigned* flag = (PG8_LAS unsigned*)(lds + 8192 + 2048);
#pragma unroll
        for (int ai = 0; ai < 2; ++ai)
#pragma unroll
            for (int m = 0; m < 4; ++m) {
                float s = 0.f;
#pragma unroll
                for (int bj = 0; bj < 2; ++bj)
#pragma unroll
                    for (int n = 0; n < 2; ++n) { const f32x4 x = v[ai][bj][m][n]; s += (x[0] + x[1]) + (x[2] + x[3]); }
                s += __shfl_xor(s, 16); s += __shfl_xor(s, 32);
                const float mw = s * (1.0f / 64.0f); float q = 0.f;
#pragma unroll
                for (int bj = 0; bj < 2; ++bj)
#pragma unroll
                    for (int n = 0; n < 2; ++n) { const f32x4 d = v[ai][bj][m][n] - mw; q += (d[0] * d[0] + d[1] * d[1]) + (d[2] * d[2] + d[3] * d[3]); }
                q += __shfl_xor(q, 16); q += __shfl_xor(q, 32);
                if (fq == 0) P[(ai * HALF + wr * 64 + m * 16 + fr) * 4 + wc] = (f32x2v){mw, q};
            }
        asm volatile("s_waitcnt lgkmcnt(0)" ::: "memory"); __builtin_amdgcn_s_barrier(); asm volatile("" ::: "memory");
#if defined(BROKEN_EXCHANGE_NO_WAIT)
#warning BROKEN CONTROL BUILD: the row-statistics exchange does not wait; results are wrong by design
        if (blockIdx.x >= 64) { const long long t0_ = clock64(); while (clock64() - t0_ < 60000) __builtin_amdgcn_s_sleep(8); }
#endif
        const int row = wid * 32 + (lane & 31);
        if (lane < 32) {
            const f32x2v a = P[row * 4 + 0], b = P[row * 4 + 1], c = P[row * 4 + 2], d = P[row * 4 + 3];
            const float mt = (a.x + b.x + c.x + d.x) * 0.25f;
            const float da = a.x - mt, db = b.x - mt, dc = c.x - mt, dd = d.x - mt;
            const float m2 = (a.y + b.y) + (c.y + d.y) + 64.0f * ((da * da + db * db) + (dc * dc + dd * dd));
            unsigned long long* slot = (unsigned long long*)xbuf + ((size_t)(u.pm * BM + row) * 4 + u.pn);
            __hip_atomic_store(slot, ((unsigned long long)__float_as_uint(m2) << 32) | __float_as_uint(mt), __ATOMIC_RELAXED, __HIP_MEMORY_SCOPE_AGENT);
        }
        asm volatile("s_waitcnt vmcnt(0)" ::: "memory");
        if (lane == 0) __hip_atomic_fetch_add(cnt + 64 * u.pm, 1u, __ATOMIC_RELAXED, __HIP_MEMORY_SCOPE_AGENT);
        if (wid == 0) {
            bool dead = false; const unsigned long long t0 = __builtin_amdgcn_s_memrealtime(); const unsigned want = 8u * (unsigned)ntn;
            for (;;) {
#if defined(BROKEN_EXCHANGE_NO_WAIT)
                break;
#endif
                if ((unsigned)__builtin_amdgcn_readfirstlane(__hip_atomic_load(cnt + 64 * u.pm, __ATOMIC_RELAXED, __HIP_MEMORY_SCOPE_AGENT)) >= want) break;
                if (__builtin_amdgcn_s_memrealtime() - t0 > 2000000ull) {
                    if (lane == 0) { unsigned expect = 0u; __hip_atomic_compare_exchange_strong(tmo + 1, &expect, code | (unsigned)(u.pm & 0xff), __ATOMIC_RELAXED, __ATOMIC_RELAXED, __HIP_MEMORY_SCOPE_AGENT);
                                     __hip_atomic_store(tmo, 1u, __ATOMIC_RELAXED, __HIP_MEMORY_SCOPE_AGENT); }
                    dead = true; break; }
                __builtin_amdgcn_s_sleep(2);
            }
            __builtin_amdgcn_fence(__ATOMIC_ACQUIRE, "agent");
            if (lane == 0) flag[0] = dead ? 1u : 0u;
        }
        asm volatile("s_waitcnt vmcnt(0) lgkmcnt(0)" ::: "memory"); __builtin_amdgcn_s_barrier(); asm volatile("" ::: "memory");
        const bool bad = flag[0] != 0u;
        if (lane < 32) {
            const unsigned long long* slot = (const unsigned long long*)xbuf + (size_t)(u.pm * BM + row) * 4; float mt[4], m2[4]; float ms = 0.f;
#pragma unroll
            for (int t = 0; t < 4; ++t) { if (t < ntn) { const unsigned long long w = __hip_atomic_load(slot + t, __ATOMIC_RELAXED, __HIP_MEMORY_SCOPE_AGENT); mt[t] = __uint_as_float((unsigned)w); m2[t] = __uint_as_float((unsigned)(w >> 32)); } else { mt[t] = 0.f; m2[t] = 0.f; } ms += mt[t]; }
            const float mean = ms / (float)ntn; float q = 0.f;
#pragma unroll
            for (int t = 0; t < 4; ++t) if (t < ntn) { const float dm = mt[t] - mean; q += m2[t] + 256.0f * dm * dm; }
            S[row] = (f32x2v){mean, 1.0f / sqrtf(q / (256.0f * (float)ntn) + eps)};
        }
        asm volatile("s_waitcnt lgkmcnt(0)" ::: "memory"); __builtin_amdgcn_s_barrier(); asm volatile("" ::: "memory");
        return bad;
    }
};
struct EpiLnRes {
    static constexpr bool PERM = false, AFTER_DRAIN = true;
    const float* base; float* out; int ldc; const float* bias; PanelStats st; unsigned poison;
    __device__ __forceinline__ void fused(f32x4 (&acc)[2][2][4][2], const Unit& u, int wr, int wc, int fr, int fq, PG8_LAS unsigned char* lds, int wid, int lane) const {
        typedef float f32x2v __attribute__((ext_vector_type(2)));
        const PG8_LAS f32x2v* S = (const PG8_LAS f32x2v*)(lds + 8192);
        const int col0 = u.pn * BM + wc * 32 + 4 * fq;
#pragma unroll
        for (int bj = 0; bj < 2; ++bj)
#pragma unroll
            for (int n = 0; n < 2; ++n) { const f32x4 bv = bias ? *(const f32x4*)(bias + col0 + bj * HALF + n * 16) : (f32x4){0.f, 0.f, 0.f, 0.f};
#pragma unroll
                for (int ai = 0; ai < 2; ++ai)
#pragma unroll
                    for (int m = 0; m < 4; ++m) acc[ai][bj][m][n] += bv; }
        f32x4 pre[4][2][2];
#pragma unroll
        for (int m = 0; m < 4; ++m) { const size_t off = (size_t)(u.pm * BM + wr * 64 + m * 16 + fr) * ldc + col0;
#pragma unroll
            for (int bj = 0; bj < 2; ++bj)
#pragma unroll
                for (int n = 0; n < 2; ++n) pre[m][bj][n] = *(const f32x4*)(base + off + bj * HALF + n * 16); }
        const bool bad = st.run(acc, u, wr, wc, fr, fq, lds, wid, lane) || poison != 0u;
        const float qnan = __builtin_nanf("");
#pragma unroll
        for (int ai = 0; ai < 2; ++ai)
#pragma unroll
            for (int m = 0; m < 4; ++m) { const int r = ai * HALF + wr * 64 + m * 16 + fr; const f32x2v sr = S[r]; const size_t off = (size_t)(u.pm * BM + r) * ldc + col0;
#pragma unroll
                for (int bj = 0; bj < 2; ++bj)
#pragma unroll
                    for (int n = 0; n < 2; ++n) { const f32x4 bs = ai == 0 ? pre[m][bj][n] : *(const f32x4*)(base + off + bj * HALF + n * 16); f32x4 o = bs + (acc[ai][bj][m][n] - sr.x) * sr.y;
                        if (bad) o = (f32x4){qnan, qnan, qnan, qnan}; *(f32x4*)(out + off + bj * HALF + n * 16) = o; }
                if (m & 1) asm volatile("" ::: "memory"); }
    }
};
struct EpiLnResLn {
    static constexpr bool PERM = false, AFTER_DRAIN = true;
    const float* base; float* out; bf16_t* xn; int ldc; const float* bias; PanelStats st1, st2; unsigned poison;
    __device__ __forceinline__ void fused(f32x4 (&acc)[2][2][4][2], const Unit& u, int wr, int wc, int fr, int fq, PG8_LAS unsigned char* lds, int wid, int lane) const {
        typedef float f32x2v __attribute__((ext_vector_type(2))); typedef unsigned u32x2v __attribute__((ext_vector_type(2)));
        const PG8_LAS f32x2v* S = (const PG8_LAS f32x2v*)(lds + 8192);
        const int col0 = u.pn * BM + wc * 32 + 4 * fq;
#pragma unroll
        for (int bj = 0; bj < 2; ++bj)
#pragma unroll
            for (int n = 0; n < 2; ++n) { const f32x4 bv = bias ? *(const f32x4*)(bias + col0 + bj * HALF + n * 16) : (f32x4){0.f, 0.f, 0.f, 0.f};
#pragma unroll
                for (int ai = 0; ai < 2; ++ai)
#pragma unroll
                    for (int m = 0; m < 4; ++m) acc[ai][bj][m][n] += bv; }
        bool bad = st1.run(acc, u, wr, wc, fr, fq, lds, wid, lane) || poison != 0u;
        const float qnan = __builtin_nanf("");
#pragma unroll
        for (int ai = 0; ai < 2; ++ai)
#pragma unroll
            for (int m = 0; m < 4; ++m) { const int r = ai * HALF + wr * 64 + m * 16 + fr; const f32x2v sr = S[r]; const size_t off = (size_t)(u.pm * BM + r) * ldc + col0;
#pragma unroll
                for (int bj = 0; bj < 2; ++bj)
#pragma unroll
                    for (int n = 0; n < 2; ++n) { const f32x4 bs = *(const f32x4*)(base + off + bj * HALF + n * 16); acc[ai][bj][m][n] = bs + (acc[ai][bj][m][n] - sr.x) * sr.y; }
                asm volatile("" : "+v"(acc[ai][0][m][0]), "+v"(acc[ai][0][m][1]), "+v"(acc[ai][1][m][0]), "+v"(acc[ai][1][m][1]));
                if (m & 1) asm volatile("" ::: "memory"); }
        const bool bad1 = bad;
        bad = st2.run(acc, u, wr, wc, fr, fq, lds, wid, lane) || bad;
#pragma unroll
        for (int ai = 0; ai < 2; ++ai)
#pragma unroll
            for (int m = 0; m < 4; ++m) { const int r = ai * HALF + wr * 64 + m * 16 + fr; const f32x2v sr = S[r]; const size_t off = (size_t)(u.pm * BM + r) * ldc + col0;
#pragma unroll
                for (int bj = 0; bj < 2; ++bj)
#pragma unroll
                    for (int n = 0; n < 2; ++n) { const f32x4 x1 = acc[ai][bj][m][n]; *(f32x4*)(out + off + bj * HALF + n * 16) = bad1 ? (f32x4){qnan, qnan, qnan, qnan} : x1;
                        const f32x4 o = (x1 - sr.x) * sr.y; u32x2v w; w.x = cvt_pk_bf16(o[0], o[1]); w.y = cvt_pk_bf16(o[2], o[3]);
                        if (bad) { w.x = 0x7fc07fc0u; w.y = 0x7fc07fc0u; } *(u32x2v*)(xn + off + bj * HALF + n * 16) = w; }
                asm volatile("" ::: "memory"); }
    }
};

template <class Epi, class Sched, bool ALIGN_EPI = false, bool SP2 = false>
__device__ __forceinline__ void gemm_phase(PG8_LAS unsigned char* lds, const Gemm g, const Sched& S, const Epi& E) {
    const int tid = threadIdx.x, wid = __builtin_amdgcn_readfirstlane(tid >> 6), lane = tid & 63, wr = wid >> 2, wc = wid & 3, fr = lane & 15, fq = lane >> 4;
    const int K = g.K, nt = K / BK;
    unsigned voffA[2], voffB[2];
#pragma unroll
    for (int i = 0; i < 2; ++i) { int R, C; stage_rc(tid * 16 + i * 8192, R, C); const int Rb = Epi::PERM ? ((R & ~31) + perm32(R & 31)) : R;
        voffA[i] = (unsigned)(R * K + C) * 2u; voffB[i] = (unsigned)(Rb * K + C) * 2u; }
    const size_t kstep = (size_t)(BK * 2);
    const size_t hstep = (size_t)HALF * K * 2;
    const size_t tstep = 2 * hstep;
    const unsigned ldsw = (unsigned)wid * 1024u;
    const int aoff = lds_byte(wr * 64 + fr, fq * 8), boff = lds_byte(wc * 32 + fr, fq * 8);
#define PG8_SA(b, h) (((b) * 2 + (h)) * HTB)
#define PG8_SB(b, h) ((4 + (b) * 2 + (h)) * HTB)
#define PG8_STAGE(bufoff, gbase, voff) do { _Pragma("unroll") for (int _i = 0; _i < 2; ++_i) \
        __builtin_amdgcn_global_load_lds((const unsigned*)((const char*)(gbase) + (voff)[_i]), (PG8_LAS unsigned*)(lds + (bufoff) + ldsw + _i * 8192), 16, 0, 0); } while (0)
#define PG8_LDA(dst, b, h) do { _Pragma("unroll") for (int m = 0; m < 4; ++m) _Pragma("unroll") for (int k = 0; k < 2; ++k) dst[m][k] = *(const PG8_LAS bf16x8*)(lds + PG8_SA(b, h) + aoff + m * 2048 + k * 1024); } while (0)
#define PG8_LDB(dst, b, h) do { _Pragma("unroll") for (int n = 0; n < 2; ++n) _Pragma("unroll") for (int k = 0; k < 2; ++k) dst[n][k] = *(const PG8_LAS bf16x8*)(lds + PG8_SB(b, h) + boff + n * 2048 + k * 1024); } while (0)
#define PG8_MMA(ai, bj, At, Bt) do { __builtin_amdgcn_s_setprio(1); _Pragma("unroll") for (int m = 0; m < 4; ++m) _Pragma("unroll") for (int n = 0; n < 2; ++n) _Pragma("unroll") for (int k = 0; k < 2; ++k) \
        acc[ai][bj][m][n] = __builtin_amdgcn_mfma_f32_16x16x32_bf16(Bt[n][k], At[m][k], acc[ai][bj][m][n], 0, 0, 0); __builtin_amdgcn_s_setprio(0); } while (0)
#define PG8_WAIT_V(n) asm volatile("s_waitcnt vmcnt(" #n ")" ::: "memory")
#define PG8_WAIT_L(n) asm volatile("s_waitcnt lgkmcnt(" #n ")" ::: "memory")
#define PG8_BAR __builtin_amdgcn_s_barrier()
#define PG8_SCHED __builtin_amdgcn_sched_barrier(0)
    Unit cur, nxt; int ui = 0;
    if (!S.next(0, cur)) return;
    f32x4 acc[2][2][4][2];
#pragma unroll
    for (int a = 0; a < 2; ++a)
#pragma unroll
        for (int b = 0; b < 2; ++b)
#pragma unroll
            for (int m = 0; m < 4; ++m)
#pragma unroll
                for (int n = 0; n < 2; ++n) acc[a][b][m][n] = (f32x4){0.f, 0.f, 0.f, 0.f};
    bf16x8 At[4][2], B0[2][2], B1[2][2];
    const char* cA = (const char*)g.A + (size_t)cur.pm * tstep; const char* cB = (const char*)g.Bt + (size_t)cur.pn * tstep;
    S.a_ready(cur);
    if constexpr (SP2) {
        PG8_STAGE(PG8_SB(0, 0), cB, voffB); PG8_STAGE(PG8_SB(0, 1), cB + hstep, voffB); PG8_STAGE(PG8_SA(0, 0), cA, voffA); PG8_STAGE(PG8_SA(0, 1), cA + hstep, voffA);
        if (wr == 1) PG8_BAR;
        PG8_WAIT_V(2); PG8_BAR;
        PG8_STAGE(PG8_SB(1, 0), cB + kstep, voffB); PG8_STAGE(PG8_SA(1, 0), cA + kstep, voffA); PG8_STAGE(PG8_SB(1, 1), cB + hstep + kstep, voffB);
        PG8_WAIT_V(6); PG8_BAR;
    } else {
        PG8_STAGE(PG8_SB(0, 0), cB, voffB); PG8_STAGE(PG8_SA(0, 0), cA, voffA); PG8_STAGE(PG8_SB(0, 1), cB + hstep, voffB); PG8_STAGE(PG8_SA(0, 1), cA + hstep, voffA);
        if (wr == 1) PG8_BAR;
        PG8_WAIT_V(4); PG8_BAR;
        PG8_STAGE(PG8_SB(1, 0), cB + kstep, voffB); PG8_STAGE(PG8_SA(1, 0), cA + kstep, voffA); PG8_STAGE(PG8_SB(1, 1), cB + hstep + kstep, voffB);
        PG8_WAIT_V(6); PG8_BAR;
    }
    for (;;) {
        const bool has_next = S.next(ui + 1, nxt);
        const char* nA = has_next ? (const char*)g.A + (size_t)nxt.pm * tstep : cA; const char* nB = has_next ? (const char*)g.Bt + (size_t)nxt.pn * tstep : cB;
        for (int t = 0; t < nt; t += 2) {
            const bool last = (t == nt - 2);
            const char* a1 = cA + (size_t)(t + 1) * kstep;
            const char* a2 = last ? nA : cA + (size_t)(t + 2) * kstep; const char* b2 = last ? nB : cB + (size_t)(t + 2) * kstep;
            const char* a3 = a2 + kstep; const char* b3 = b2 + kstep;
            if (last && has_next) S.a_ready(nxt);
            if constexpr (SP2) {
            PG8_LDB(B0, 0, 0); PG8_LDB(B1, 0, 1); PG8_SCHED; PG8_LDA(At, 0, 0); PG8_STAGE(PG8_SA(1, 1), a1 + hstep, voffA);
            PG8_WAIT_V(8); PG8_WAIT_L(0); PG8_BAR; PG8_MMA(0, 0, At, B0); PG8_MMA(0, 1, At, B1); PG8_BAR; PG8_SCHED;
            PG8_LDA(At, 0, 1); PG8_STAGE(PG8_SB(0, 0), b2, voffB); PG8_STAGE(PG8_SB(0, 1), b2 + hstep, voffB); PG8_STAGE(PG8_SA(0, 0), a2, voffA);
            PG8_WAIT_V(8); PG8_WAIT_L(0); PG8_BAR; PG8_MMA(1, 0, At, B0); PG8_MMA(1, 1, At, B1); PG8_BAR; PG8_SCHED;
            PG8_LDB(B0, 1, 0); PG8_LDB(B1, 1, 1); PG8_SCHED; PG8_LDA(At, 1, 0); PG8_STAGE(PG8_SA(0, 1), a2 + hstep, voffA);
            PG8_WAIT_V(8); PG8_WAIT_L(0); PG8_BAR; PG8_MMA(0, 0, At, B0); PG8_MMA(0, 1, At, B1); PG8_BAR; PG8_SCHED;
            PG8_LDA(At, 1, 1); PG8_STAGE(PG8_SB(1, 0), b3, voffB); PG8_STAGE(PG8_SB(1, 1), b3 + hstep, voffB); PG8_STAGE(PG8_SA(1, 0), a3, voffA);
            PG8_WAIT_V(8); PG8_WAIT_L(0); PG8_BAR; PG8_MMA(1, 0, At, B0); PG8_MMA(1, 1, At, B1); PG8_BAR; PG8_SCHED;
            } else {
            PG8_LDB(B0, 0, 0); PG8_SCHED; PG8_LDA(At, 0, 0); PG8_STAGE(PG8_SA(1, 1), a1 + hstep, voffA);
            PG8_WAIT_L(8); PG8_BAR; PG8_WAIT_L(0); PG8_MMA(0, 0, At, B0); PG8_BAR; PG8_SCHED;
            PG8_LDB(B1, 0, 1); PG8_STAGE(PG8_SB(0, 0), b2, voffB);
            PG8_BAR; PG8_WAIT_L(0); PG8_MMA(0, 1, At, B1); PG8_BAR;
            PG8_LDA(At, 0, 1); PG8_STAGE(PG8_SA(0, 0), a2, voffA);
            PG8_BAR; PG8_WAIT_L(0); PG8_MMA(1, 0, At, B0); PG8_BAR; PG8_SCHED;
            PG8_STAGE(PG8_SB(0, 1), b2 + hstep, voffB);
            PG8_WAIT_V(6); PG8_BAR; PG8_MMA(1, 1, At, B1); PG8_BAR;
            PG8_LDB(B0, 1, 0); PG8_SCHED; PG8_LDA(At, 1, 0); PG8_STAGE(PG8_SA(0, 1), a2 + hstep, voffA);
            PG8_WAIT_L(8); PG8_BAR; PG8_WAIT_L(0); PG8_MMA(0, 0, At, B0); PG8_BAR; PG8_SCHED;
            PG8_LDB(B1, 1, 1); PG8_STAGE(PG8_SB(1, 0), b3, voffB);
            PG8_BAR; PG8_WAIT_L(0); PG8_MMA(0, 1, At, B1); PG8_BAR;
            PG8_LDA(At, 1, 1); PG8_STAGE(PG8_SA(1, 0), a3, voffA);
            PG8_BAR; PG8_WAIT_L(0); PG8_MMA(1, 0, At, B0); PG8_BAR; PG8_SCHED;
            PG8_STAGE(PG8_SB(1, 1), b3 + hstep, voffB);
            PG8_WAIT_V(6); PG8_BAR; PG8_MMA(1, 1, At, B1); PG8_BAR;
            }
        }
        if constexpr (ALIGN_EPI) { if (wr == 0) PG8_BAR; }
        if constexpr (!Epi::AFTER_DRAIN) { E(acc, cur, wr, wc, fr, fq); S.done(cur); }
        if (!has_next) break;
#pragma unroll
        for (int a = 0; a < 2; ++a)
#pragma unroll
            for (int b = 0; b < 2; ++b)
#pragma unroll
                for (int m = 0; m < 4; ++m)
#pragma unroll
                    for (int n = 0; n < 2; ++n) acc[a][b][m][n] = (f32x4){0.f, 0.f, 0.f, 0.f};
        cur = nxt; cA = nA; cB = nB; ++ui;
        if constexpr (ALIGN_EPI) { if (wr == 1) PG8_BAR; }
    }
    PG8_WAIT_V(0);
    if constexpr (!ALIGN_EPI) { if (wr == 0) PG8_BAR; }
    PG8_BAR;
    if constexpr (Epi::AFTER_DRAIN) { E.fused(acc, cur, wr, wc, fr, fq, lds, wid, lane); S.done(cur); }
#undef PG8_SA
#undef PG8_SB
#undef PG8_STAGE
#undef PG8_LDA
#undef PG8_LDB
#undef PG8_MMA
#undef PG8_WAIT_V
#undef PG8_WAIT_L
#undef PG8_BAR
#undef PG8_SCHED
}
}

constexpr int NWAVES = 8;
constexpr int BATCH = 4, SEQ = 8192, M = BATCH * SEQ, D = 1024;
constexpr int AW = 512, NH = 8, HD = 64, TOPK = 256;
constexpr int NIN = 5376;
constexpr int PEER_H = 8, NKEYS = 128, PTOPK = 16, PLE = 256, CONVW = 31;
constexpr float EPS = 1e-6f, LOG2E = 1.4426950408889634f;
constexpr float C2 = 0.125f * LOG2E;
constexpr float IDX_SCALE = 0.125f * 0.35355339059327373f;
constexpr int TABN = 1152, TABOFF = 1087;

constexpr size_t MiB = 1u << 20;
constexpr size_t WS_CTL = 0, CTL_ZERO_BYTES = 1 * MiB;
constexpr size_t WS_SS1 = 512 * 1024;
constexpr size_t WS_RSTD1 = 1 * MiB, WS_RSTD3 = 1 * MiB + 128 * 1024, WS_TAB = 1 * MiB + 256 * 1024;
constexpr size_t WS_WI = 2 * MiB, WS_KI = 3 * MiB;
constexpr size_t WS_WIN = 8 * MiB, WS_WA = 19 * MiB, WS_WC = 20 * MiB, WS_WOUT = 21 * MiB, WS_WQ = 23 * MiB, WS_WG = 27 * MiB, WS_WP = 29 * MiB, WS_SUBK = 29 * MiB + 512 * 1024;
constexpr size_t WS_EU = 30 * MiB, WS_EV = 62 * MiB, WS_PB = 94 * MiB;
constexpr size_t WS_RC = 110 * MiB;
constexpr size_t WS_RD = 174 * MiB;
constexpr size_t WS_RB = 238 * MiB;
constexpr size_t WS_RA = 366 * MiB;
constexpr size_t WS_END = 494 * MiB;
constexpr int CW_TMO = 0, CW_CODE = 1, CW_BAR = 4096;

constexpr int RING_OFF = 0, RING_BYTES = 131072;
constexpr int LDSCTL_OFF = RING_BYTES, MISC_OFF = LDSCTL_OFF + 320;
constexpr int LDS_BYTES = 147456;

#define GAS __attribute__((address_space(1)))
#define LAS __attribute__((address_space(3)))
typedef unsigned short bf16;
typedef unsigned v4u __attribute__((ext_vector_type(4)));
typedef unsigned v2u __attribute__((ext_vector_type(2)));
typedef float f32x4 __attribute__((ext_vector_type(4)));
typedef __bf16 bf2_t __attribute__((ext_vector_type(2)));
#define LDS_WAIT() asm volatile("s_waitcnt lgkmcnt(0)" ::: "memory")
#define VM_WAIT() asm volatile("s_waitcnt vmcnt(0)" ::: "memory")
__device__ __forceinline__ unsigned f2bf(float f) { unsigned u = __builtin_bit_cast(unsigned, f); return (u + 0x7fffu + ((u >> 16) & 1u)) >> 16; }
__device__ __forceinline__ unsigned pk2(float lo, float hi) { return f2bf(lo) | (f2bf(hi) << 16); }
__device__ __forceinline__ float bflo(unsigned w) { return __uint_as_float(w << 16); }
__device__ __forceinline__ float bfhi(unsigned w) { return __uint_as_float(w & 0xffff0000u); }
__device__ __forceinline__ float bf1(bf16 b) { return __uint_as_float((unsigned)b << 16); }
__device__ __forceinline__ float dot2(unsigned a, unsigned b, float c) { return __builtin_amdgcn_fdot2_f32_bf16(__builtin_bit_cast(bf2_t, a), __builtin_bit_cast(bf2_t, b), c, false); }
__device__ __forceinline__ float dot8(v4u a, v4u b, float c) { c = dot2(a.x, b.x, c); c = dot2(a.y, b.y, c); c = dot2(a.z, b.z, c); return dot2(a.w, b.w, c); }
__device__ __forceinline__ float sigmoidf_(float x) { return 1.0f / (1.0f + __expf(-x)); }
__device__ __forceinline__ float gelu_tanh(float x) { const float y = 0.7978845608028654f * (x + 0.044715f * x * x * x); const float th = 1.0f - 2.0f / (1.0f + __expf(2.0f * y)); return 0.5f * x * (1.0f + th); }
__device__ __forceinline__ unsigned sortable(float f) { const unsigned u = __float_as_uint(f); return (u & 0x80000000u) ? ~u : (u | 0x80000000u); }
__device__ __forceinline__ float wave_sum(float v) {
#pragma unroll
    for (int o = 1; o < 64; o <<= 1) v += __shfl_xor(v, o);
    return v;
}
__device__ __forceinline__ float wave_max(float v) {
#pragma unroll
    for (int o = 1; o < 64; o <<= 1) v = fmaxf(v, __shfl_xor(v, o));
    return v;
}
__device__ __forceinline__ unsigned long long wave_max_u64(unsigned long long v) {
#pragma unroll
    for (int o = 1; o < 64; o <<= 1) { const unsigned lo = __shfl_xor((unsigned)v, o), hi = __shfl_xor((unsigned)(v >> 32), o); const unsigned long long w = ((unsigned long long)hi << 32) | lo; v = w > v ? w : v; }
    return v;
}

__device__ __forceinline__ int opaque_i(int v) { asm volatile("" : "+s"(v)); return v; }
#define XB_TMO      128
#define XB_XCNT(j)  (256  + 64 * (j))
#define XB_XSUB(j)  (1280 + 64 * (j))
#define XB_XGEN(j)  (2304 + 64 * (j))
#define XB_TOP      3328
#define XB_TOPGEN   3392
#define XCD_BAR_WORDS 3456
#define XB_SPIN_CAP (1u << 18)
__device__ __forceinline__ unsigned xb_ld(unsigned* p)              { return __hip_atomic_load(p, __ATOMIC_RELAXED, __HIP_MEMORY_SCOPE_AGENT); }
__device__ __forceinline__ unsigned xb_add(unsigned* p, unsigned v) { return __hip_atomic_fetch_add(p, v, __ATOMIC_RELAXED, __HIP_MEMORY_SCOPE_AGENT); }
__device__ __forceinline__ unsigned xb_xcc_id() { return (unsigned)__builtin_amdgcn_s_getreg((3 << 11) | 20) & 0xFu; }
#define XB_SPIN(cond, bar) do { unsigned _sp = 0; while (cond) { __builtin_amdgcn_s_sleep(1); \
    if ((++_sp & 255u) == 0u) { if (xb_ld(&(bar)[XB_TMO])) break; if (_sp > XB_SPIN_CAP) { atomicAdd(&(bar)[XB_TMO], 1u); break; } } } } while (0)
struct XcdBarrier { unsigned* bar; unsigned x; volatile LAS unsigned* st; };
__device__ __forceinline__ XcdBarrier xcd_barrier_post(unsigned* bar, volatile LAS unsigned* st) {
    XcdBarrier b; b.bar = bar; b.x = xb_xcc_id(); b.st = st;
    if (threadIdx.x == 0) (void)xb_add(&bar[XB_XCNT(b.x)], 1u);
    return b;
}
__device__ __forceinline__ void xcd_barrier_complete(unsigned* bar, unsigned x, unsigned& nloc, unsigned& nx) {
    const unsigned G = gridDim.x * gridDim.y * gridDim.z;
    unsigned sum, cnt, mine, sp = 0u;
    for (;;) {
        sum = 0u; cnt = 0u; mine = 0u;
#pragma unroll
        for (unsigned j = 0; j < 16; ++j) { const unsigned c = xb_ld(&bar[XB_XCNT(j)]); sum += c; cnt += (c > 0u) ? 1u : 0u; mine = (j == x) ? c : mine; }
        if (sum == G) break;
        __builtin_amdgcn_s_sleep(1);
        if ((++sp & 255u) == 0u) { if (xb_ld(&bar[XB_TMO])) break; if (sp > XB_SPIN_CAP) { atomicAdd(&bar[XB_TMO], 1u); break; } }
    }
    nloc = mine > 0u ? mine : 1u; nx = cnt > 0u ? cnt : 1u;
}
__device__ __forceinline__ void xcd_barrier(const XcdBarrier& b) {
    asm volatile("s_waitcnt vmcnt(0)" ::: "memory");
    __syncthreads();
    if (threadIdx.x == 0) {
        unsigned* bar = b.bar;
        __builtin_amdgcn_s_waitcnt(0);
        unsigned nloc = b.st[0], nx = b.st[1];
        if (nloc == 0u) { xcd_barrier_complete(bar, b.x, nloc, nx); b.st[0] = nloc; b.st[1] = nx; }
        const unsigned old = xb_add(&bar[XB_XSUB(b.x)], 1u);
        const unsigned gen = old / nloc;
        if (old + 1u == (gen + 1u) * nloc) {
            __builtin_amdgcn_fence(__ATOMIC_RELEASE, "agent");
            asm volatile("s_waitcnt vmcnt(0)" ::: "memory");
            const unsigned og = xb_add(&bar[XB_TOP], 1u);
            const unsigned tg = og / nx;
            if (og + 1u == (tg + 1u) * nx) xb_add(&bar[XB_TOPGEN], 1u);
            else XB_SPIN(xb_ld(&bar[XB_TOPGEN]) == tg, bar);
            __builtin_amdgcn_fence(__ATOMIC_ACQUIRE, "agent");
            xb_add(&bar[XB_XGEN(b.x)], 1u);
            asm volatile("s_waitcnt vmcnt(0)" ::: "memory");
        } else {
            XB_SPIN(xb_ld(&bar[XB_XGEN(b.x)]) == gen, bar);
            __builtin_amdgcn_fence(__ATOMIC_ACQUIRE, "agent");
            asm volatile("s_waitcnt vmcnt(0)" ::: "memory");
        }
    }
    __syncthreads();
}

struct Frame {
    LAS unsigned char* lds;
    volatile LAS unsigned* MISC;
    unsigned* ctl;
    int tid, lane, wave, G, gw, NGW;
    const float *x, *p, *rel_bias, *attn_g, *w_in, *b_gate, *q_g, *k_g, *w_att, *conv_w, *conv_b, *ln_g, *ln_b, *w_conv, *w_out, *ffn_g, *w_pq, *subk, *pu, *pv, *ple_g, *w_pg, *w_pp;
    float* out;
    float *ss1, *rstd1, *rstd3, *tab, *WI;
    bf16 *KI, *Win_t, *Wa_t, *Wc_t, *Wout_t, *Wq_t, *Wg_t, *Wp_t, *SUBK, *EU, *EV, *PB;
    bf16 *XB, *ATT, *CV, *UB, *MIX, *PP, *Q, *K, *V, *QI, *GB, *QP;
    unsigned* bitmap;
};

namespace epi {
using pg8::f32x4; using pg8::u32x4; using pg8::Unit; using pg8::bf16_t;
__device__ __forceinline__ u32x4 pack8(const float* v) { u32x4 w; w.x = pk2(v[0], v[1]); w.y = pk2(v[2], v[3]); w.z = pk2(v[4], v[5]); w.w = pk2(v[6], v[7]); return w; }
__device__ __forceinline__ void unpack8(u32x4 w, float* v) { v[0] = bflo(w.x); v[1] = bfhi(w.x); v[2] = bflo(w.y); v[3] = bfhi(w.y); v[4] = bflo(w.z); v[5] = bfhi(w.z); v[6] = bflo(w.w); v[7] = bfhi(w.w); }

struct EpiInProj {
    static constexpr bool PERM = true, AFTER_DRAIN = false;
    const float* rstd; bf16_t *Q, *K, *V, *QI, *U, *G, *KI; float* WI; const float *qg, *kg, *bgate;
    __device__ __forceinline__ void operator()(const f32x4 (&acc)[2][2][4][2], const Unit& u, int wr, int wc, int fr, int fq) const {
        const int pn = u.pn, row0 = u.pm * 256 + wr * 64 + fr;
        if (pn < 4) {
            const bool isq = pn < 2; const float* g = isq ? qg : kg; bf16_t* O = isq ? Q : K; const float sc = isq ? C2 : 1.0f;
            const int head = (pn & 1) * 4 + wc;
            float gv[2][8];
#pragma unroll
            for (int bj = 0; bj < 2; ++bj)
#pragma unroll
                for (int j = 0; j < 8; ++j) gv[bj][j] = g[32 * bj + 8 * fq + j];
#pragma unroll
            for (int ai = 0; ai < 2; ++ai)
#pragma unroll
                for (int m = 0; m < 4; ++m) {
                    const int row = row0 + ai * 128 + m * 16; const float rs = rstd[row];
                    float v[2][8]; float ss = 0.f;
#pragma unroll
                    for (int bj = 0; bj < 2; ++bj)
#pragma unroll
                        for (int n = 0; n < 2; ++n)
#pragma unroll
                            for (int i = 0; i < 4; ++i) { const float xv = acc[ai][bj][m][n][i] * rs; v[bj][4 * n + i] = xv; ss += xv * xv; }
                    ss += __shfl_xor(ss, 16); ss += __shfl_xor(ss, 32);
                    const float inv = rsqrtf(ss * (1.0f / 64.0f) + EPS) * sc;
#pragma unroll
                    for (int bj = 0; bj < 2; ++bj) { float o[8];
#pragma unroll
                        for (int j = 0; j < 8; ++j) o[j] = v[bj][j] * inv * gv[bj][j];
                        *(u32x4*)(O + (size_t)row * AW + head * 64 + 32 * bj + 8 * fq) = pack8(o); }
                }
        } else if (pn < 8) {
            bf16_t* O = pn < 6 ? V : QI; const int cb = (pn & 1) * 256 + 32 * wc + 8 * fq;
#pragma unroll
            for (int ai = 0; ai < 2; ++ai)
#pragma unroll
                for (int m = 0; m < 4; ++m) {
                    const int row = row0 + ai * 128 + m * 16; const float rs = rstd[row];
#pragma unroll
                    for (int bj = 0; bj < 2; ++bj) { float o[8];
#pragma unroll
                        for (int n = 0; n < 2; ++n)
#pragma unroll
                            for (int i = 0; i < 4; ++i) o[4 * n + i] = acc[ai][bj][m][n][i] * rs;
                        *(u32x4*)(O + (size_t)row * AW + cb + 128 * bj) = pack8(o); }
                }
        } else if (pn < 12) {
            const int ch0 = (pn - 8) * 128 + 32 * wc + 8 * fq;
#pragma unroll
            for (int ai = 0; ai < 2; ++ai)
#pragma unroll
                for (int m = 0; m < 4; ++m) {
                    const int row = row0 + ai * 128 + m * 16; const float rs = rstd[row]; float o[8];
#pragma unroll
                    for (int n = 0; n < 2; ++n)
#pragma unroll
                        for (int i = 0; i < 4; ++i) { const float a = acc[ai][0][m][n][i] * rs, gg = acc[ai][1][m][n][i] * rs; o[4 * n + i] = a * sigmoidf_(gg); }
                    *(u32x4*)(U + (size_t)row * 512 + ch0) = pack8(o);
                }
        } else if (pn < 20) {
            const int cb = (pn - 12) * 256 + 32 * wc + 8 * fq;
            float bv[2][8];
#pragma unroll
            for (int bj = 0; bj < 2; ++bj)
#pragma unroll
                for (int j = 0; j < 8; ++j) bv[bj][j] = bgate[cb + 128 * bj + j];
#pragma unroll
            for (int ai = 0; ai < 2; ++ai)
#pragma unroll
                for (int m = 0; m < 4; ++m) {
                    const int row = row0 + ai * 128 + m * 16; const float rs = rstd[row];
#pragma unroll
                    for (int bj = 0; bj < 2; ++bj) { float o[8];
#pragma unroll
                        for (int n = 0; n < 2; ++n)
#pragma unroll
                            for (int i = 0; i < 4; ++i) o[4 * n + i] = sigmoidf_(acc[ai][bj][m][n][i] * rs + bv[bj][4 * n + i]);
                        *(u32x4*)(G + (size_t)row * 2048 + cb + 128 * bj) = pack8(o); }
                }
        } else {
#pragma unroll
            for (int ai = 0; ai < 2; ++ai)
#pragma unroll
                for (int m = 0; m < 4; ++m) {
                    const int row = row0 + ai * 128 + m * 16; const float rs = rstd[row]; float o[8];
#pragma unroll
                    for (int n = 0; n < 2; ++n)
#pragma unroll
                        for (int i = 0; i < 4; ++i) o[4 * n + i] = acc[ai][0][m][n][i] * rs;
                    if (wc < 2) *(u32x4*)(KI + (size_t)row * 64 + 32 * wc + 8 * fq) = pack8(o);
                    else if (wc == 2 && fq == 0) {
                        *(f32x4*)(WI + (size_t)row * 8) = (f32x4){o[0] * IDX_SCALE, o[1] * IDX_SCALE, o[2] * IDX_SCALE, o[3] * IDX_SCALE};
                        *(f32x4*)(WI + (size_t)row * 8 + 4) = (f32x4){o[4] * IDX_SCALE, o[5] * IDX_SCALE, o[6] * IDX_SCALE, o[7] * IDX_SCALE}; }
                }
        }
    }
};
template <bool ADD> struct EpiGate {
    static constexpr bool PERM = true, AFTER_DRAIN = false;
    const bf16_t* G; int goff; bf16_t* O;
    __device__ __forceinline__ void operator()(const f32x4 (&acc)[2][2][4][2], const Unit& u, int wr, int wc, int fr, int fq) const {
        const int row0 = u.pm * 256 + wr * 64 + fr, col0 = u.pn * 256 + 32 * wc + 8 * fq;
#pragma unroll
        for (int ai = 0; ai < 2; ++ai)
#pragma unroll
            for (int m = 0; m < 4; ++m) { const int row = row0 + ai * 128 + m * 16;
#pragma unroll
                for (int bj = 0; bj < 2; ++bj) { const int col = col0 + 128 * bj; float gt[8], pv[8], o[8];
                    unpack8(*(const u32x4*)(G + (size_t)row * 2048 + goff + col), gt);
                    if (ADD) unpack8(*(const u32x4*)(O + (size_t)row * D + col), pv);
#pragma unroll
                    for (int n = 0; n < 2; ++n)
#pragma unroll
                        for (int i = 0; i < 4; ++i) o[4 * n + i] = (ADD ? pv[4 * n + i] : 0.f) + gt[4 * n + i] * acc[ai][bj][m][n][i];
                    *(u32x4*)(O + (size_t)row * D + col) = pack8(o); } }
    }
};
struct EpiRes1 {
    static constexpr bool PERM = true, AFTER_DRAIN = false;
    const float* x; float* out; bf16_t* xb; float* ss;
    __device__ __forceinline__ void operator()(const f32x4 (&acc)[2][2][4][2], const Unit& u, int wr, int wc, int fr, int fq) const {
        const int row0 = u.pm * 256 + wr * 64 + fr, col0 = u.pn * 256 + 32 * wc + 8 * fq;
#pragma unroll
        for (int ai = 0; ai < 2; ++ai)
#pragma unroll
            for (int m = 0; m < 4; ++m) { const int row = row0 + ai * 128 + m * 16; float s = 0.f;
#pragma unroll
                for (int bj = 0; bj < 2; ++bj) { const size_t off = (size_t)row * D + col0 + 128 * bj;
                    const f32x4 a = *(const f32x4*)(x + off) + acc[ai][bj][m][0], b = *(const f32x4*)(x + off + 4) + acc[ai][bj][m][1];
                    *(f32x4*)(out + off) = a; *(f32x4*)(out + off + 4) = b;
                    u32x4 w; w.x = pk2(a[0], a[1]); w.y = pk2(a[2], a[3]); w.z = pk2(b[0], b[1]); w.w = pk2(b[2], b[3]); *(u32x4*)(xb + off) = w;
                    s += (a[0] * a[0] + a[1] * a[1]) + (a[2] * a[2] + a[3] * a[3]) + (b[0] * b[0] + b[1] * b[1]) + (b[2] * b[2] + b[3] * b[3]); }
                s += __shfl_xor(s, 16); s += __shfl_xor(s, 32);
                if (fq == 0) atomicAdd(ss + row, s); }
    }
};
struct EpiScaleRow {
    static constexpr bool PERM = true, AFTER_DRAIN = false;
    const float* ss; bf16_t* O; int ldc;
    __device__ __forceinline__ void operator()(const f32x4 (&acc)[2][2][4][2], const Unit& u, int wr, int wc, int fr, int fq) const {
        const int row0 = u.pm * 256 + wr * 64 + fr, col0 = u.pn * 256 + 32 * wc + 8 * fq;
#pragma unroll
        for (int ai = 0; ai < 2; ++ai)
#pragma unroll
            for (int m = 0; m < 4; ++m) { const int row = row0 + ai * 128 + m * 16; const float rs = rsqrtf(ss[row] * (1.0f / 1024.0f) + EPS);
#pragma unroll
                for (int bj = 0; bj < 2; ++bj) { float o[8];
#pragma unroll
                    for (int n = 0; n < 2; ++n)
#pragma unroll
                        for (int i = 0; i < 4; ++i) o[4 * n + i] = acc[ai][bj][m][n][i] * rs;
                    *(u32x4*)(O + (size_t)row * ldc + col0 + 128 * bj) = pack8(o); } }
    }
};
struct EpiPlain {
    static constexpr bool PERM = true, AFTER_DRAIN = false;
    bf16_t* O; int ldc;
    __device__ __forceinline__ void operator()(const f32x4 (&acc)[2][2][4][2], const Unit& u, int wr, int wc, int fr, int fq) const {
        const int row0 = u.pm * 256 + wr * 64 + fr, col0 = u.pn * 256 + 32 * wc + 8 * fq;
#pragma unroll
        for (int ai = 0; ai < 2; ++ai)
#pragma unroll
            for (int m = 0; m < 4; ++m) { const int row = row0 + ai * 128 + m * 16;
#pragma unroll
                for (int bj = 0; bj < 2; ++bj) { float o[8];
#pragma unroll
                    for (int n = 0; n < 2; ++n)
#pragma unroll
                        for (int i = 0; i < 4; ++i) o[4 * n + i] = acc[ai][bj][m][n][i];
                    *(u32x4*)(O + (size_t)row * ldc + col0 + 128 * bj) = pack8(o); } }
    }
};
struct EpiPle {
    static constexpr bool PERM = true, AFTER_DRAIN = false;
    const float* rstd; const bf16_t* pp; float* out;
    __device__ __forceinline__ void operator()(const f32x4 (&acc)[2][2][4][2], const Unit& u, int wr, int wc, int fr, int fq) const {
        const int row0 = u.pm * 256 + wr * 64 + fr, col0 = u.pn * 256 + 32 * wc + 8 * fq;
#pragma unroll
        for (int ai = 0; ai < 2; ++ai)
#pragma unroll
            for (int m = 0; m < 4; ++m) { const int row = row0 + ai * 128 + m * 16; const float rs = rstd[row];
#pragma unroll
                for (int bj = 0; bj < 2; ++bj) { const size_t off = (size_t)row * D + col0 + 128 * bj; float pv[8];
                    unpack8(*(const u32x4*)(pp + off), pv);
                    f32x4 a = *(const f32x4*)(out + off), b = *(const f32x4*)(out + off + 4);
#pragma unroll
                    for (int i = 0; i < 4; ++i) { a[i] += sigmoidf_(acc[ai][bj][m][0][i] * rs) * pv[i]; b[i] += sigmoidf_(acc[ai][bj][m][1][i] * rs) * pv[4 + i]; }
                    *(f32x4*)(out + off) = a; *(f32x4*)(out + off + 4) = b; }
                asm volatile("" ::: "memory"); }
    }
};
}

__device__ __forceinline__ void tr_item(const float* W, int ldw, int K, int src_col0, int nvalid, bf16* WT, int dst_row0, const float* gain, LAS float* scr, int kb, int lane) {
    const int k0 = 64 * kb;
#pragma unroll 8
    for (int i = 0; i < 32; ++i) { const int kk = 2 * i + (lane >> 5), c = lane & 31; float v = 0.f;
        if (src_col0 >= 0 && c < nvalid) { v = W[(size_t)(k0 + kk) * ldw + src_col0 + c]; if (gain) v *= gain[k0 + kk]; }
        scr[kk * 33 + c] = v; }
    LDS_WAIT(); asm volatile("" ::: "memory");
    const int c = lane & 7;
#pragma unroll
    for (int j = 0; j < 4; ++j) { const int n = (lane >> 3) + 8 * j; const LAS float* s = scr + (8 * c) * 33 + n;
        v4u o; o.x = pk2(s[0 * 33], s[1 * 33]); o.y = pk2(s[2 * 33], s[3 * 33]); o.z = pk2(s[4 * 33], s[5 * 33]); o.w = pk2(s[6 * 33], s[7 * 33]);
        *(v4u*)(WT + (size_t)(dst_row0 + n) * K + k0 + 8 * c) = o; }
    LDS_WAIT(); asm volatile("" ::: "memory");
}
__device__ __forceinline__ void win_src_col(int gidx, int& src, int& nvalid) {
    const int tile = gidx >> 3, gi = gidx & 7; nvalid = 32;
    if (tile < 2) src = (tile * 4 + (gi & 3)) * 64 + (gi >> 2) * 32;
    else if (tile < 4) src = 512 + ((tile - 2) * 4 + (gi & 3)) * 64 + (gi >> 2) * 32;
    else if (tile < 6) src = 1024 + (tile - 4) * 256 + gi * 32;
    else if (tile < 8) src = 1536 + (tile - 6) * 256 + gi * 32;
    else if (tile < 12) src = (gi < 4) ? 2120 + 128 * (tile - 8) + 32 * gi : 2632 + 128 * (tile - 8) + 32 * (gi - 4);
    else if (tile < 20) src = 3144 + (tile - 12) * 256 + 32 * gi;
    else { if (gi < 2) src = 2048 + 32 * gi; else if (gi == 2) { src = 2112; nvalid = 8; } else { src = -1; nvalid = 0; } }
}
__device__ __forceinline__ void cvt_bf16_stream(const float* src, bf16* dst, size_t n8, size_t start, size_t stride) {
    for (size_t i = start; i < n8; i += stride) { const f32x4 a = *(const f32x4*)(src + i * 8), b = *(const f32x4*)(src + i * 8 + 4);
        v4u o; o.x = pk2(a[0], a[1]); o.y = pk2(a[2], a[3]); o.z = pk2(b[0], b[1]); o.w = pk2(b[2], b[3]); *(v4u*)(dst + i * 8) = o; }
}
__device__ __forceinline__ int t5_bucket(int rel) {
    const int n = rel < 0 ? -rel : rel; int v;
    if (n < 8) v = n; else { v = 8 + (int)(logf((float)n / 8.0f) / logf(128.0f) * 8.0f); if (v > 15) v = 15; }
    return (rel > 0 ? 16 : 0) + v;
}
__device__ __forceinline__ void p0_prologue(Frame& F) {
    LAS float* scr = (LAS float*)(F.lds + RING_OFF + F.wave * 16384);
    const int gw = F.gw, NGW = F.NGW, lane = F.lane;
    constexpr int I_IN = 168 * 16, I_A = 32 * 8, I_C = 32 * 8, I_O = 32 * 16, I_Q = 64 * 16, I_G = 32 * 16, I_P = 32 * 4;
    constexpr int NITEMS = I_IN + I_A + I_C + I_O + I_Q + I_G + I_P;
    for (int it = gw; it < NITEMS; it += NGW) {
        int r = it;
        if (r < I_IN) { int src, nv; win_src_col(r / 16, src, nv); tr_item(F.w_in, 5192, D, src, nv, F.Win_t, (r / 16) * 32, F.attn_g, scr, r % 16, lane); continue; } r -= I_IN;
        if (r < I_A) { tr_item(F.w_att, D, 512, (r / 8) * 32, 32, F.Wa_t, (r / 8) * 32, nullptr, scr, r % 8, lane); continue; } r -= I_A;
        if (r < I_C) { tr_item(F.w_conv, D, 512, (r / 8) * 32, 32, F.Wc_t, (r / 8) * 32, nullptr, scr, r % 8, lane); continue; } r -= I_C;
        if (r < I_O) { tr_item(F.w_out, D, D, (r / 16) * 32, 32, F.Wout_t, (r / 16) * 32, nullptr, scr, r % 16, lane); continue; } r -= I_O;
        if (r < I_Q) { tr_item(F.w_pq, 2048, D, (r / 16) * 32, 32, F.Wq_t, (r / 16) * 32, F.ffn_g, scr, r % 16, lane); continue; } r -= I_Q;
        if (r < I_G) { tr_item(F.w_pg, D, D, (r / 16) * 32, 32, F.Wg_t, (r / 16) * 32, F.ple_g, scr, r % 16, lane); continue; } r -= I_G;
        tr_item(F.w_pp, D, PLE, (r / 4) * 32, 32, F.Wp_t, (r / 4) * 32, nullptr, scr, r % 4, lane);
    }
    const size_t gt = (size_t)blockIdx.x * (NWAVES * 64) + F.tid, GT = (size_t)F.G * NWAVES * 64;
    cvt_bf16_stream(F.subk, F.SUBK, (size_t)PEER_H * 2 * NKEYS * 128 / 8, gt, GT);
    cvt_bf16_stream(F.pu, F.EU, (size_t)16384 * D / 8, gt, GT);
    cvt_bf16_stream(F.pv, F.EV, (size_t)16384 * D / 8, gt, GT);
    cvt_bf16_stream(F.p, F.PB, (size_t)M * PLE / 8, gt, GT);
    for (int m = gw; m < M; m += NGW) {
        const f32x4* xr = (const f32x4*)(F.x + (size_t)m * D) + lane; f32x4 v[4]; float s = 0.f;
#pragma unroll
        for (int j = 0; j < 4; ++j) { v[j] = xr[64 * j]; s += (v[j][0] * v[j][0] + v[j][1] * v[j][1]) + (v[j][2] * v[j][2] + v[j][3] * v[j][3]); }
        s = wave_sum(s);
        if (lane == 0) F.rstd1[m] = rsqrtf(s * (1.0f / D) + EPS);
        v2u* o8 = (v2u*)(F.XB + (size_t)m * D) + lane;
#pragma unroll
        for (int j = 0; j < 4; ++j) { v2u o; o.x = pk2(v[j][0], v[j][1]); o.y = pk2(v[j][2], v[j][3]); o8[64 * j] = o; }
    }
    for (size_t i = gt; i < (size_t)NH * TABN; i += GT) { const int h = (int)(i / TABN), rel = (int)(i % TABN) - TABOFF; F.tab[i] = LOG2E * F.rel_bias[t5_bucket(rel) * NH + h]; }
}

__device__ __forceinline__ void p2_index_naive(Frame& F, float* scratch) {
    const int lane = F.lane;
    LAS unsigned* qi_l = (LAS unsigned*)(F.lds + F.wave * 1024);
    LAS unsigned* hist = (LAS unsigned*)(F.lds + 8192 + F.wave * 1024);
    float* scr = scratch + (size_t)F.gw * SEQ;
    const unsigned long long lt = __lanemask_lt();
    for (int t = F.gw; t < M; t += F.NGW) {
        const int b = t / SEQ, sq = t % SEQ, vis = (sq / 64 + 1) * 64, nst = vis / 64;
        unsigned* bm = F.bitmap + (size_t)t * 256;
        if (vis <= TOPK) { for (int wd = lane; wd < 256; wd += 64) bm[wd] = (wd * 32 < vis) ? 0xffffffffu : 0u; continue; }
        *(LAS v4u*)(qi_l + lane * 4) = *(const v4u*)(F.QI + (size_t)t * 512 + lane * 8);
        float w[8];
#pragma unroll
        for (int h = 0; h < 8; ++h) w[h] = F.WI[(size_t)t * 8 + h];
        LDS_WAIT();
        for (int st = 0; st < nst; ++st) {
            asm volatile("" ::: "memory");
            const int key = st * 64 + lane; const v4u* kr = (const v4u*)(F.KI + ((size_t)b * SEQ + key) * 64);
            v4u kk[8];
#pragma unroll
            for (int i = 0; i < 8; ++i) kk[i] = kr[i];
            float s = 0.f;
#pragma unroll
            for (int h = 0; h < 8; ++h) { float d = 0.f;
#pragma unroll
                for (int i = 0; i < 8; ++i) d = dot8(*(const LAS v4u*)(qi_l + h * 32 + i * 4), kk[i], d);
                s += w[h] * fmaxf(d, 0.f); }
            scr[key] = s;
        }
        unsigned prefix = 0u, remaining = TOPK;
        for (int pass = 0; pass < 4; ++pass) {
            const int shift = 24 - 8 * pass;
            *(LAS v4u*)(hist + lane * 4) = (v4u){0u, 0u, 0u, 0u};
            LDS_WAIT();
            for (int st = 0; st < nst; ++st) { const unsigned uu = sortable(scr[st * 64 + lane]);
                const bool ok = (pass == 0) || ((uu >> (shift + 8)) == prefix);
                if (ok) __hip_atomic_fetch_add(hist + ((uu >> shift) & 255u), 1u, __ATOMIC_RELAXED, __HIP_MEMORY_SCOPE_WORKGROUP); }
            LDS_WAIT();
            const v4u c = *(const LAS v4u*)(hist + lane * 4);
            const unsigned tot = c.x + c.y + c.z + c.w; unsigned incl = tot;
#pragma unroll
            for (int o = 1; o < 64; o <<= 1) { const unsigned v = __shfl_down(incl, o); incl += (lane + o < 64) ? v : 0u; }
            const unsigned excl = incl - tot;
            const bool mine = (excl < remaining) && (remaining <= incl);
            unsigned bsel = 0u, before = 0u;
            if (mine) { unsigned cum = excl;
                if (remaining <= cum + c.w) { bsel = 3u; before = cum; } else { cum += c.w;
                if (remaining <= cum + c.z) { bsel = 2u; before = cum; } else { cum += c.z;
                if (remaining <= cum + c.y) { bsel = 1u; before = cum; } else { cum += c.y; bsel = 0u; before = cum; } } }
                bsel += 4u * lane; }
            const unsigned long long mm = __ballot(mine);
            const int src = __ffsll((long long)mm) - 1;
            bsel = __shfl(bsel, src); before = __shfl(before, src);
            prefix = (prefix << 8) | bsel; remaining -= before;
            LDS_WAIT();
        }
        unsigned taken = 0u;
        for (int st = 0; st < nst; ++st) { const unsigned uu = sortable(scr[st * 64 + lane]);
            const bool gtb = uu > prefix, eq = uu == prefix; const unsigned long long meq = __ballot(eq);
            const unsigned rank = __popcll(meq & lt); const bool sel = gtb || (eq && (taken + rank < remaining)); taken += __popcll(meq);
            const unsigned long long ms = __ballot(sel);
            if (lane == 0) { bm[2 * st] = (unsigned)ms; bm[2 * st + 1] = (unsigned)(ms >> 32); } }
        for (int wd = 2 * nst + lane; wd < 256; wd += 64) bm[wd] = 0u;
    }
}
__device__ __forceinline__ void p2_conv_naive(Frame& F) {
    const int lane = F.lane, c0 = 8 * lane;
    for (int t = F.gw; t < M; t += F.NGW) {
        const int sq = t % SEQ; float y[8];
#pragma unroll
        for (int i = 0; i < 8; ++i) y[i] = F.conv_b[c0 + i];
        for (int j = 0; j < CONVW; ++j) { const int sp = sq - (CONVW - 1) + j; if (sp < 0) continue;
            float uv[8]; epi::unpack8(*(const v4u*)(F.UB + (size_t)(t - (CONVW - 1) + j) * 512 + c0), uv);
            const f32x4 w0 = *(const f32x4*)(F.conv_w + j * 512 + c0), w1 = *(const f32x4*)(F.conv_w + j * 512 + c0 + 4);
#pragma unroll
            for (int i = 0; i < 4; ++i) { y[i] += uv[i] * w0[i]; y[4 + i] += uv[4 + i] * w1[i]; } }
        float s = 0.f;
#pragma unroll
        for (int i = 0; i < 8; ++i) s += y[i];
        const float mean = wave_sum(s) * (1.0f / 512.0f); float q = 0.f;
#pragma unroll
        for (int i = 0; i < 8; ++i) { y[i] -= mean; q += y[i] * y[i]; }
        const float rstd = rsqrtf(wave_sum(q) * (1.0f / 512.0f) + EPS); float o[8];
#pragma unroll
        for (int i = 0; i < 8; ++i) { const float z = y[i] * rstd * F.ln_g[c0 + i] + F.ln_b[c0 + i]; o[i] = z * sigmoidf_(z); }
        *(v4u*)(F.CV + (size_t)t * 512 + c0) = epi::pack8(o);
    }
}
__device__ __forceinline__ void p3_attn_naive(Frame& F) {
    const int lane = F.lane;
    LAS int* sel = (LAS int*)(F.lds + F.wave * 2048);
    LAS float* pl = (LAS float*)(F.lds + F.wave * 2048 + 1024);
    const unsigned long long lt = __lanemask_lt();
    for (int t = F.gw; t < M; t += F.NGW) {
        const int b = t / SEQ, sq = t % SEQ, vis = (sq / 64 + 1) * 64, nst = vis / 64;
        const unsigned* bm = F.bitmap + (size_t)t * 256; int nsel = 0;
        for (int st = 0; st < nst; ++st) { const unsigned long long m = (unsigned long long)bm[2 * st] | ((unsigned long long)bm[2 * st + 1] << 32);
            if ((m >> lane) & 1ull) sel[nsel + __popcll(m & lt)] = st * 64 + lane;
            nsel += __popcll(m); }
        LDS_WAIT();
        for (int h = 0; h < NH; ++h) {
            v4u qq[8]; const v4u* qr = (const v4u*)(F.Q + (size_t)t * AW + h * 64);
#pragma unroll
            for (int i = 0; i < 8; ++i) qq[i] = qr[i];
            float lg[4]; float mx = -INFINITY;
#pragma unroll
            for (int j = 0; j < 4; ++j) { const int idx = lane + 64 * j; lg[j] = -INFINITY;
                if (idx < nsel) { const int key = sel[idx]; const v4u* kr = (const v4u*)(F.K + ((size_t)b * SEQ + key) * AW + h * 64); float d = 0.f;
#pragma unroll
                    for (int i = 0; i < 8; ++i) d = dot8(qq[i], kr[i], d);
                    int ti = key - sq + TABOFF; ti = ti < 0 ? 0 : ti; d += F.tab[h * TABN + ti]; lg[j] = d; mx = fmaxf(mx, d); } }
            mx = wave_max(mx); float sm = 0.f;
#pragma unroll
            for (int j = 0; j < 4; ++j) { const int idx = lane + 64 * j; if (idx < nsel) { const float pj = exp2f(lg[j] - mx); sm += pj; pl[idx] = pj; } }
            sm = wave_sum(sm); LDS_WAIT();
            float o = 0.f; const bf16* vb = F.V + (size_t)b * SEQ * AW + h * 64 + lane;
            for (int j = 0; j < nsel; ++j) o += pl[j] * bf1(vb[(size_t)sel[j] * AW]);
            F.ATT[(size_t)t * AW + h * 64 + lane] = (bf16)f2bf(o / sm);
            LDS_WAIT();
        }
    }
}
__device__ __forceinline__ void p7_peer_naive(Frame& F) {
    const int lane = F.lane;
    LAS int* EI = (LAS int*)(F.lds + F.wave * 2048);
    LAS float* GT = (LAS float*)(F.lds + F.wave * 2048 + 512);
    LAS float* sv = (LAS float*)(F.lds + F.wave * 2048 + 1024);
    LAS int* si = (LAS int*)(F.lds + F.wave * 2048 + 1024 + 128);
    LAS float* ts = (LAS float*)(F.lds + F.wave * 2048 + 1024 + 256);
    for (int t = F.gw; t < M; t += F.NGW) {
        for (int h = 0; h < PEER_H; ++h) {
            for (int c = 0; c < 2; ++c) {
                v4u qv[16]; const v4u* qr = (const v4u*)(F.QP + (size_t)t * 2048 + h * 256 + c * 128);
#pragma unroll
                for (int i = 0; i < 16; ++i) qv[i] = qr[i];
                float s[2];
#pragma unroll
                for (int kk = 0; kk < 2; ++kk) { const v4u* kr = (const v4u*)(F.SUBK + ((size_t)(h * 2 + c) * NKEYS + lane + 64 * kk) * 128); float d = 0.f;
#pragma unroll
                    for (int i = 0; i < 16; ++i) d = dot8(qv[i], kr[i], d);
                    s[kk] = d; }
                unsigned long long k0 = ((unsigned long long)sortable(s[0]) << 32) | (0xffffffffu - (unsigned)lane), k1 = ((unsigned long long)sortable(s[1]) << 32) | (0xffffffffu - (unsigned)(lane + 64));
                for (int r = 0; r < PTOPK; ++r) {
                    const unsigned long long best = wave_max_u64(k0 > k1 ? k0 : k1);
                    const int bi = (int)(0xffffffffu - (unsigned)best);
                    if (k0 == best) { sv[c * 16 + r] = s[0]; si[c * 16 + r] = bi; k0 = 0ull; }
                    if (k1 == best) { sv[c * 16 + r] = s[1]; si[c * 16 + r] = bi; k1 = 0ull; }
                }
            }
            LDS_WAIT();
            unsigned long long ck[4]; float cs[4];
#pragma unroll
            for (int jj = 0; jj < 4; ++jj) { const int n = lane + 64 * jj; cs[jj] = sv[n >> 4] + sv[16 + (n & 15)]; ck[jj] = ((unsigned long long)sortable(cs[jj]) << 32) | (0xffffffffu - (unsigned)n); }
            for (int r = 0; r < PTOPK; ++r) {
                unsigned long long loc = ck[0] > ck[1] ? ck[0] : ck[1]; const unsigned long long loc2 = ck[2] > ck[3] ? ck[2] : ck[3]; loc = loc > loc2 ? loc : loc2;
                const unsigned long long best = wave_max_u64(loc);
                const int n = (int)(0xffffffffu - (unsigned)best);
#pragma unroll
                for (int jj = 0; jj < 4; ++jj) if (ck[jj] == best) { ts[r] = cs[jj]; EI[h * 16 + r] = si[n >> 4] * NKEYS + si[16 + (n & 15)]; ck[jj] = 0ull; }
            }
            LDS_WAIT();
            { const float t0 = ts[0]; float e = (lane < 16) ? __expf(ts[lane & 15] - t0) : 0.f; const float sum = wave_sum(e); if (lane < 16) GT[h * 16 + lane] = e / sum; }
            LDS_WAIT();
        }
        const float rs2 = rsqrtf(F.ss1[t] * (1.0f / D) + EPS);
        f32x4 x1[4]; float hx[16], oa[16];
#pragma unroll
        for (int j = 0; j < 4; ++j) { x1[j] = *((const f32x4*)(F.out + (size_t)t * D) + lane + 64 * j); const f32x4 g = *((const f32x4*)F.ffn_g + lane + 64 * j);
#pragma unroll
            for (int i = 0; i < 4; ++i) { hx[4 * j + i] = x1[j][i] * rs2 * g[i]; oa[4 * j + i] = 0.f; } }
        for (int n = 0; n < PEER_H * PTOPK; ++n) {
            const int e = EI[n]; const float g = GT[n];
            const v2u* ur = (const v2u*)(F.EU + (size_t)e * D) + lane; const v2u* vr = (const v2u*)(F.EV + (size_t)e * D) + lane; float d = 0.f; v2u vv[4];
#pragma unroll
            for (int j = 0; j < 4; ++j) { const v2u uu = ur[64 * j]; vv[j] = vr[64 * j];
                d += bflo(uu.x) * hx[4 * j] + bfhi(uu.x) * hx[4 * j + 1] + bflo(uu.y) * hx[4 * j + 2] + bfhi(uu.y) * hx[4 * j + 3]; }
            d = wave_sum(d); const float a = gelu_tanh(d) * g;
#pragma unroll
            for (int j = 0; j < 4; ++j) { oa[4 * j] += a * bflo(vv[j].x); oa[4 * j + 1] += a * bfhi(vv[j].x); oa[4 * j + 2] += a * bflo(vv[j].y); oa[4 * j + 3] += a * bfhi(vv[j].y); }
        }
        float s = 0.f;
#pragma unroll
        for (int j = 0; j < 4; ++j) { f32x4 o;
#pragma unroll
            for (int i = 0; i < 4; ++i) { o[i] = x1[j][i] + oa[4 * j + i]; s += o[i] * o[i]; }
            *((f32x4*)(F.out + (size_t)t * D) + lane + 64 * j) = o;
            v2u w; w.x = pk2(o[0], o[1]); w.y = pk2(o[2], o[3]); *((v2u*)(F.XB + (size_t)t * D) + lane + 64 * j) = w; }
        s = wave_sum(s); if (lane == 0) F.rstd3[t] = rsqrtf(s * (1.0f / D) + EPS);
        LDS_WAIT();
    }
}

constexpr int NPHASE = 9;
struct Args { const float* in[23]; float* out; unsigned char* ws; int ph_lo, ph_hi; };
__global__ void __launch_bounds__(NWAVES * 64, 2) fwd(Args args) {
    extern __shared__ __attribute__((aligned(16))) unsigned char lds[];
    Frame F;
    F.lds = (LAS unsigned char*)lds; F.MISC = (volatile LAS unsigned*)(F.lds + MISC_OFF);
    F.tid = threadIdx.x; F.lane = F.tid & 63; F.wave = __builtin_amdgcn_readfirstlane(F.tid >> 6); F.G = gridDim.x;
    F.gw = blockIdx.x * NWAVES + F.wave; F.NGW = F.G * NWAVES;
    unsigned char* ws = args.ws;
    F.ctl = (unsigned*)(ws + WS_CTL);
    F.x = args.in[0]; F.p = args.in[1]; F.rel_bias = args.in[2]; F.attn_g = args.in[3]; F.w_in = args.in[4]; F.b_gate = args.in[5]; F.q_g = args.in[6]; F.k_g = args.in[7];
    F.w_att = args.in[8]; F.conv_w = args.in[9]; F.conv_b = args.in[10]; F.ln_g = args.in[11]; F.ln_b = args.in[12]; F.w_conv = args.in[13]; F.w_out = args.in[14]; F.ffn_g = args.in[15];
    F.w_pq = args.in[16]; F.subk = args.in[17]; F.pu = args.in[18]; F.pv = args.in[19]; F.ple_g = args.in[20]; F.w_pg = args.in[21]; F.w_pp = args.in[22]; F.out = args.out;
    F.ss1 = (float*)(ws + WS_SS1); F.rstd1 = (float*)(ws + WS_RSTD1); F.rstd3 = (float*)(ws + WS_RSTD3); F.tab = (float*)(ws + WS_TAB); F.WI = (float*)(ws + WS_WI); F.KI = (bf16*)(ws + WS_KI);
    F.Win_t = (bf16*)(ws + WS_WIN); F.Wa_t = (bf16*)(ws + WS_WA); F.Wc_t = (bf16*)(ws + WS_WC); F.Wout_t = (bf16*)(ws + WS_WOUT); F.Wq_t = (bf16*)(ws + WS_WQ); F.Wg_t = (bf16*)(ws + WS_WG); F.Wp_t = (bf16*)(ws + WS_WP);
    F.SUBK = (bf16*)(ws + WS_SUBK); F.EU = (bf16*)(ws + WS_EU); F.EV = (bf16*)(ws + WS_EV); F.PB = (bf16*)(ws + WS_PB);
    F.XB = (bf16*)(ws + WS_RC); F.ATT = (bf16*)(ws + WS_RC); F.CV = (bf16*)(ws + WS_RC + 32 * MiB);
    F.UB = (bf16*)(ws + WS_RD); F.bitmap = (unsigned*)(ws + WS_RD + 32 * MiB); F.MIX = (bf16*)(ws + WS_RD); F.PP = (bf16*)(ws + WS_RD);
    F.Q = (bf16*)(ws + WS_RB); F.K = (bf16*)(ws + WS_RB + 32 * MiB); F.V = (bf16*)(ws + WS_RB + 64 * MiB); F.QI = (bf16*)(ws + WS_RB + 96 * MiB);
    F.GB = (bf16*)(ws + WS_RA); F.QP = (bf16*)(ws + WS_RA);
    for (int u = F.tid; u < (LDS_BYTES - LDSCTL_OFF) / 4; u += NWAVES * 64) ((LAS unsigned*)(F.lds + LDSCTL_OFF))[u] = 0u;
    __syncthreads();
    const int lo = args.ph_lo, hi = args.ph_hi;
    XcdBarrier bar; bar.bar = F.ctl + CW_BAR; bar.x = 0; bar.st = nullptr;
    if (hi - lo > 1) bar = xcd_barrier_post(F.ctl + CW_BAR, F.MISC + 8);
#ifndef PH_MASK
#define PH_MASK 0x1ff
#endif
#define IN(k) (((PH_MASK >> (k)) & 1) && lo <= (k) && (k) < hi)
#define SEAM(k) do { if (IN(k) && IN((k) + 1)) xcd_barrier(bar); } while (0)
    const int bid = (int)blockIdx.x;

    if (IN(0)) { p0_prologue(F); } SEAM(0);
    if (IN(1)) {
        pg8::Gemm g{F.XB, F.Win_t, M, NIN, opaque_i(D)}; pg8::StaticOrder S; S.init(M, NIN, F.G, bid);
        epi::EpiInProj E{F.rstd1, F.Q, F.K, F.V, F.QI, F.UB, F.GB, F.KI, F.WI, F.q_g, F.k_g, F.b_gate};
        pg8::gemm_phase<epi::EpiInProj, pg8::StaticOrder, true, true>(F.lds + RING_OFF, g, S, E);
    } SEAM(1);
    if (IN(2)) { p2_index_naive(F, F.out); p2_conv_naive(F); } SEAM(2);
    if (IN(3)) { p3_attn_naive(F); } SEAM(3);
    if (IN(4)) {
        { pg8::Gemm g{F.ATT, F.Wa_t, M, D, opaque_i(512)}; pg8::StaticOrder S; S.init(M, D, F.G, bid); epi::EpiGate<false> E{F.GB, 0, F.MIX};
          pg8::gemm_phase<epi::EpiGate<false>, pg8::StaticOrder, true, true>(F.lds + RING_OFF, g, S, E); }
        { pg8::Gemm g{F.CV, F.Wc_t, M, D, opaque_i(512)}; pg8::StaticOrder S; S.init(M, D, F.G, bid); epi::EpiGate<true> E{F.GB, 1024, F.MIX};
          pg8::gemm_phase<epi::EpiGate<true>, pg8::StaticOrder, true, true>(F.lds + RING_OFF, g, S, E); }
    } SEAM(4);
    if (IN(5)) {
        pg8::Gemm g{F.MIX, F.Wout_t, M, D, opaque_i(D)}; pg8::StaticOrder S; S.init(M, D, F.G, bid); epi::EpiRes1 E{F.x, F.out, F.XB, F.ss1};
        pg8::gemm_phase<epi::EpiRes1, pg8::StaticOrder, true, true>(F.lds + RING_OFF, g, S, E);
    } SEAM(5);
    if (IN(6)) {
        pg8::Gemm g{F.XB, F.Wq_t, M, 2048, opaque_i(D)}; pg8::StaticOrder S; S.init(M, 2048, F.G, bid); epi::EpiScaleRow E{F.ss1, F.QP, 2048};
        pg8::gemm_phase<epi::EpiScaleRow, pg8::StaticOrder, true, true>(F.lds + RING_OFF, g, S, E);
    } SEAM(6);
    if (IN(7)) { p7_peer_naive(F); } SEAM(7);
    if (IN(8)) {
#ifndef NO8A
        { pg8::Gemm g{F.PB, F.Wp_t, M, D, opaque_i(PLE)}; pg8::StaticOrder S; S.init(M, D, F.G, bid); epi::EpiPlain E{F.PP, D};
          pg8::gemm_phase<epi::EpiPlain, pg8::StaticOrder, true, true>(F.lds + RING_OFF, g, S, E); }
#endif
#ifndef NO8B
        { pg8::Gemm g{F.XB, F.Wg_t, M, D, opaque_i(D)}; pg8::StaticOrder S; S.init(M, D, F.G, bid); epi::EpiPle E{F.rstd3, F.PP, F.out};
          pg8::gemm_phase<epi::EpiPle, pg8::StaticOrder, true, true>(F.lds + RING_OFF, g, S, E); }
#endif
    }
#undef IN
#undef SEAM
}

#ifndef MK_MULTI
#define MK_MULTI 1
#endif
extern "C" void kernel_launch(void* const* d_in, const int* in_sizes, int n_in, void* d_out, int out_size, void* d_ws, size_t ws_size, hipStream_t stream) {
    static int grid = 0;
    if (grid == 0) {
        if (n_in != 23 || in_sizes[0] != M * D || out_size != M * D || ws_size < WS_END) { fprintf(stderr, "kernel_launch: unexpected problem: n_in %d in0 %d out %d ws %zu (need %zu)\n", n_in, n_in > 0 ? in_sizes[0] : -1, out_size, ws_size, (size_t)WS_END); grid = -1; return; }
        int dev = 0, cus = 0;
        if (hipGetDevice(&dev) != hipSuccess || hipDeviceGetAttribute(&cus, hipDeviceAttributeMultiprocessorCount, dev) != hipSuccess) { grid = -1; return; }
        if (hipFuncSetAttribute((const void*)fwd, hipFuncAttributeMaxDynamicSharedMemorySize, LDS_BYTES) != hipSuccess) { fprintf(stderr, "kernel_launch: hipFuncSetAttribute failed\n"); grid = -1; return; }
        int per_cu = 0;
        if (hipOccupancyMaxActiveBlocksPerMultiprocessor(&per_cu, (const void*)fwd, NWAVES * 64, LDS_BYTES) != hipSuccess || per_cu < 1) fprintf(stderr, "kernel_launch: occupancy query says %d\n", per_cu);
        (void)hipGetLastError();
        grid = cus;
    }
    if (grid < 0) return;
    if (hipMemsetAsync((char*)d_ws + WS_CTL, 0, CTL_ZERO_BYTES, stream) != hipSuccess) return;
    Args a{};
    for (int i = 0; i < 23; ++i) a.in[i] = (const float*)d_in[i];
    a.out = (float*)d_out; a.ws = (unsigned char*)d_ws;
#if MK_MULTI
    for (int ph = 0; ph < NPHASE; ++ph) { a.ph_lo = ph; a.ph_hi = ph + 1; hipLaunchKernelGGL(fwd, dim3(grid), dim3(NWAVES * 64), LDS_BYTES, stream, a); }
#else
    a.ph_lo = 0; a.ph_hi = NPHASE; hipLaunchKernelGGL(fwd, dim3(grid), dim3(NWAVES * 64), LDS_BYTES, stream, a);
#endif
}
```

```cpp
#include <hip/hip_runtime.h>
#include <cstdio>
#include <cstdint>
namespace pg8 {
#define PG8_LAS __attribute__((address_space(3)))
typedef unsigned short bf16_t;
typedef short bf16x8 __attribute__((ext_vector_type(8)));
typedef float f32x4 __attribute__((ext_vector_type(4)));
typedef unsigned u32x4 __attribute__((ext_vector_type(4)));
constexpr int BM = 256, BK = 64, HALF = 128, HTB = HALF * BK * 2  , STAGE_BYTES = 8 * HTB, NXCD = 8, WGM = 8;

__host__ __device__ __forceinline__ int lds_byte(int r, int c) { const int st = (r >> 4) * 2 + (c >> 5), rr = r & 15, cc = c & 31, ob = rr * 64 + cc * 2; return st * 1024 + (ob ^ (((ob >> 9) & 1) << 5)); }
__host__ __device__ __forceinline__ void stage_rc(int b, int& R, int& C) { const int st = b / 1024, sb = b % 1024, swz = sb ^ (((sb >> 9) & 1) << 5); R = (st >> 1) * 16 + swz / 64; C = (st & 1) * 32 + (swz % 64) / 2; }
__host__ __device__ __forceinline__ int perm32(int rho) { const int n = rho >> 4, i = rho & 15; return 8 * (i >> 2) + 4 * n + (i & 3); }

struct Unit { int pm, pn; };
struct Gemm { const bf16_t* A; const bf16_t* Bt; int M, N, K; };

struct StaticOrder {
    int nM, nN, nwg, G, c;
    __host__ __device__ void init(int M, int N, int G_, int c_) { nM = M / BM; nN = N / BM; nwg = nM * nN; G = G_; c = c_; }
    __host__ __device__ bool next(int i, Unit& u) const {
        const long L = (long)i * G + c; if (L >= nwg) return false;
        int wgid = (int)L; { const int q = nwg / NXCD, r = nwg % NXCD, xcd = wgid % NXCD, off = wgid / NXCD; wgid = (xcd < r ? xcd * (q + 1) : r * (q + 1) + (xcd - r) * q) + off; }
        const int nig = WGM * nN, gid = wgid / nig, fm = gid * WGM, gsz = (nM - fm) < WGM ? (nM - fm) : WGM;
        u.pm = fm + ((wgid % nig) % gsz); u.pn = (wgid % nig) / gsz; return true;
    }
    __device__ __forceinline__ void a_ready(const Unit&) const {}
    __device__ __forceinline__ void done(const Unit&) const {}
};

__device__ __forceinline__ unsigned cvt_pk_bf16(float lo, float hi) { unsigned r; asm volatile("v_cvt_pk_bf16_f32 %0, %1, %2" : "=v"(r) : "v"(lo), "v"(hi)); return r; }
typedef float f32x2 __attribute__((ext_vector_type(2)));
__device__ __forceinline__ f32x2 gelu_pk(f32x2 v) {
    const f32x2 av = __builtin_elementwise_abs(v), d = av * 0.2316418882f + 1.0f;
    f32x2 t; t.x = __builtin_amdgcn_rcpf(d.x); t.y = __builtin_amdgcn_rcpf(d.y);
    f32x2 q = t * 0.5307027145f + (-0.7265760135f); q = q * t + 0.7107068705f; q = q * t + (-0.142248368f); q = q * t + 0.127414796f; q = q * t;
    const f32x2 s = (v * v) * (-0.72134752044f);
    f32x2 e; e.x = __builtin_amdgcn_exp2f(s.x); e.y = __builtin_amdgcn_exp2f(s.y);
    const f32x2 m = v * (q * e), r = v - m;
    f32x2 o; o.x = v.x < 0.f ? m.x : r.x; o.y = v.y < 0.f ? m.y : r.y; return o;
}

template <int ACT  > struct EpiBf16 {
    static constexpr bool PERM = true, AFTER_DRAIN = false; static_assert(ACT == 0 || ACT == 1, "EpiBf16: ACT is 0 (none) or 1 (gelu_pk)");
    bf16_t* O; int ldc; const float* bias; int split_cols; size_t split_stride; float scale0;
    __device__ __forceinline__ void operator()(const f32x4 (&acc)[2][2][4][2], const Unit& u, int wr, int wc, int fr, int fq) const {
        const int row0 = u.pm * BM + wr * 64 + fr; int colt = u.pn * BM; bf16_t* base = O;
        float sc = 1.f; if (split_cols) { const int t = colt / split_cols; base += (size_t)t * split_stride; colt -= t * split_cols; if (t == 0) sc = scale0; }
        const int col0 = colt + wc * 32 + 8 * fq, bcol0 = u.pn * BM + wc * 32 + 8 * fq;
        f32x4 bv[2][2];
#pragma unroll
        for (int bj = 0; bj < 2; ++bj)
#pragma unroll
            for (int n = 0; n < 2; ++n) bv[bj][n] = bias ? *(const f32x4*)(bias + bcol0 + bj * HALF + 4 * n) : (f32x4){0.f, 0.f, 0.f, 0.f};
#pragma unroll
        for (int ai = 0; ai < 2; ++ai)
#pragma unroll
            for (int m = 0; m < 4; ++m) { bf16_t* rowp = base + (size_t)(row0 + ai * HALF + m * 16) * ldc + col0;
#pragma unroll
                for (int bj = 0; bj < 2; ++bj) { f32x4 v0 = acc[ai][bj][m][0] + bv[bj][0], v1 = acc[ai][bj][m][1] + bv[bj][1];
                    if (ACT == 1) { f32x2 a = gelu_pk((f32x2){v0[0], v0[1]}), b = gelu_pk((f32x2){v0[2], v0[3]}), c = gelu_pk((f32x2){v1[0], v1[1]}), d = gelu_pk((f32x2){v1[2], v1[3]});
                        v0 = (f32x4){a.x, a.y, b.x, b.y}; v1 = (f32x4){c.x, c.y, d.x, d.y}; }
                    v0 = v0 * sc; v1 = v1 * sc; u32x4 w; w.x = cvt_pk_bf16(v0[0], v0[1]); w.y = cvt_pk_bf16(v0[2], v0[3]); w.z = cvt_pk_bf16(v1[0], v1[1]); w.w = cvt_pk_bf16(v1[2], v1[3]);
                    *(u32x4*)(rowp + bj * HALF) = w; } }
    }
};

struct PanelStats {
    unsigned* xbuf;
    unsigned* cnt;
    unsigned* tmo;
    int ntn; float eps;
    unsigned code;
    __device__ __forceinline__ bool run(const f32x4 (&v)[2][2][4][2], const Unit& u, int wr, int wc, int fr, int fq, PG8_LAS unsigned char* lds, int wid, int lane) const {
        typedef float f32x2v __attribute__((ext_vector_type(2)));
        PG8_LAS f32x2v* P = (PG8_LAS f32x2v*)lds;
        PG8_LAS f32x2v* S = (PG8_LAS f32x2v*)(lds + 8192);
        PG8_LAS unsigned* flag = (PG8_LAS unsigned*)(lds + 8192 + 2048);
#pragma unroll
        for (int ai = 0; ai < 2; ++ai)
#pragma unroll
            for (int m = 0; m < 4; ++m) {
                float s = 0.f;
#pragma unroll
                for (int bj = 0; bj < 2; ++bj)
#pragma unroll
                    for (int n = 0; n < 2; ++n) { const f32x4 x = v[ai][bj][m][n]; s += (x[0] + x[1]) + (x[2] + x[3]); }
                s += __shfl_xor(s, 16); s += __shfl_xor(s, 32);
                const float mw = s * (1.0f / 64.0f); float q = 0.f;
#pragma unroll
                for (int bj = 0; bj < 2; ++bj)
#pragma unroll
                    for (int n = 0; n < 2; ++n) { const f32x4 d = v[ai][bj][m][n] - mw; q += (d[0] * d[0] + d[1] * d[1]) + (d[2] * d[2] + d[3] * d[3]); }
                q += __shfl_xor(q, 16); q += __shfl_xor(q, 32);
                if (fq == 0) P[(ai * HALF + wr * 64 + m * 16 + fr) * 4 + wc] = (f32x2v){mw, q};
            }
        asm volatile("s_waitcnt lgkmcnt(0)" ::: "memory"); __builtin_amdgcn_s_barrier(); asm volatile("" ::: "memory");
#if defined(BROKEN_EXCHANGE_NO_WAIT)
#warning BROKEN CONTROL BUILD: the row-statistics exchange does not wait; results are wrong by design
        if (blockIdx.x >= 64) { const long long t0_ = clock64(); while (clock64() - t0_ < 60000) __builtin_amdgcn_s_sleep(8); }
#endif
        const int row = wid * 32 + (lane & 31);
        if (lane < 32) {
            const f32x2v a = P[row * 4 + 0], b = P[row * 4 + 1], c = P[row * 4 + 2], d = P[row * 4 + 3];
            const float mt = (a.x + b.x + c.x + d.x) * 0.25f;
            const float da = a.x - mt, db = b.x - mt, dc = c.x - mt, dd = d.x - mt;
            const float m2 = (a.y + b.y) + (c.y + d.y) + 64.0f * ((da * da + db * db) + (dc * dc + dd * dd));
            unsigned long long* slot = (unsigned long long*)xbuf + ((size_t)(u.pm * BM + row) * 4 + u.pn);
            __hip_atomic_store(slot, ((unsigned long long)__float_as_uint(m2) << 32) | __float_as_uint(mt), __ATOMIC_RELAXED, __HIP_MEMORY_SCOPE_AGENT);
        }
        asm volatile("s_waitcnt vmcnt(0)" ::: "memory");
        if (lane == 0) __hip_atomic_fetch_add(cnt + 64 * u.pm, 1u, __ATOMIC_RELAXED, __HIP_MEMORY_SCOPE_AGENT);
        if (wid == 0) {
            bool dead = false; const unsigned long long t0 = __builtin_amdgcn_s_memrealtime(); const unsigned want = 8u * (unsigned)ntn;
            for (;;) {
#if defined(BROKEN_EXCHANGE_NO_WAIT)
                break;
#endif
                if ((unsigned)__builtin_amdgcn_readfirstlane(__hip_atomic_load(cnt + 64 * u.pm, __ATOMIC_RELAXED, __HIP_MEMORY_SCOPE_AGENT)) >= want) break;
                if (__builtin_amdgcn_s_memrealtime() - t0 > 2000000ull) {
                    if (lane == 0) { unsigned expect = 0u; __hip_atomic_compare_exchange_strong(tmo + 1, &expect, code | (unsigned)(u.pm & 0xff), __ATOMIC_RELAXED, __ATOMIC_RELAXED, __HIP_MEMORY_SCOPE_AGENT);
                                     __hip_atomic_store(tmo, 1u, __ATOMIC_RELAXED, __HIP_MEMORY_SCOPE_AGENT); }
                    dead = true; break; }
                __builtin_amdgcn_s_sleep(2);
            }
            __builtin_amdgcn_fence(__ATOMIC_ACQUIRE, "agent");
            if (lane == 0) flag[0] = dead ? 1u : 0u;
        }
        asm volatile("s_waitcnt vmcnt(0) lgkmcnt(0)" ::: "memory"); __builtin_amdgcn_s_barrier(); asm volatile("" ::: "memory");
        const bool bad = flag[0] != 0u;
        if (lane < 32) {
            const unsigned long long* slot = (const unsigned long long*)xbuf + (size_t)(u.pm * BM + row) * 4; float mt[4], m2[4]; float ms = 0.f;
#pragma unroll
            for (int t = 0; t < 4; ++t) { if (t < ntn) { const unsigned long long w = __hip_atomic_load(slot + t, __ATOMIC_RELAXED, __HIP_MEMORY_SCOPE_AGENT); mt[t] = __uint_as_float((unsigned)w); m2[t] = __uint_as_float((unsigned)(w >> 32)); } else { mt[t] = 0.f; m2[t] = 0.f; } ms += mt[t]; }
            const float mean = ms / (float)ntn; float q = 0.f;
#pragma unroll
            for (int t = 0; t < 4; ++t) if (t < ntn) { const float dm = mt[t] - mean; q += m2[t] + 256.0f * dm * dm; }
            S[row] = (f32x2v){mean, 1.0f / sqrtf(q / (256.0f * (float)ntn) + eps)};
        }
        asm volatile("s_waitcnt lgkmcnt(0)" ::: "memory"); __builtin_amdgcn_s_barrier(); asm volatile("" ::: "memory");
        return bad;
    }
};
struct EpiLnRes {
    static constexpr bool PERM = false, AFTER_DRAIN = true;
    const float* base; float* out; int ldc; const float* bias; PanelStats st; unsigned poison;
    __device__ __forceinline__ void fused(f32x4 (&acc)[2][2][4][2], const Unit& u, int wr, int wc, int fr, int fq, PG8_LAS unsigned char* lds, int wid, int lane) const {
        typedef float f32x2v __attribute__((ext_vector_type(2)));
        const PG8_LAS f32x2v* S = (const PG8_LAS f32x2v*)(lds + 8192);
        const int col0 = u.pn * BM + wc * 32 + 4 * fq;
#pragma unroll
        for (int bj = 0; bj < 2; ++bj)
#pragma unroll
            for (int n = 0; n < 2; ++n) { const f32x4 bv = bias ? *(const f32x4*)(bias + col0 + bj * HALF + n * 16) : (f32x4){0.f, 0.f, 0.f, 0.f};
#pragma unroll
                for (int ai = 0; ai < 2; ++ai)
#pragma unroll
                    for (int m = 0; m < 4; ++m) acc[ai][bj][m][n] += bv; }
        f32x4 pre[4][2][2];
#pragma unroll
        for (int m = 0; m < 4; ++m) { const size_t off = (size_t)(u.pm * BM + wr * 64 + m * 16 + fr) * ldc + col0;
#pragma unroll
            for (int bj = 0; bj < 2; ++bj)
#pragma unroll
                for (int n = 0; n < 2; ++n) pre[m][bj][n] = *(const f32x4*)(base + off + bj * HALF + n * 16); }
        const bool bad = st.run(acc, u, wr, wc, fr, fq, lds, wid, lane) || poison != 0u;
        const float qnan = __builtin_nanf("");
#pragma unroll
        for (int ai = 0; ai < 2; ++ai)
#pragma unroll
            for (int m = 0; m < 4; ++m) { const int r = ai * HALF + wr * 64 + m * 16 + fr; const f32x2v sr = S[r]; const size_t off = (size_t)(u.pm * BM + r) * ldc + col0;
#pragma unroll
                for (int bj = 0; bj < 2; ++bj)
#pragma unroll
                    for (int n = 0; n < 2; ++n) { const f32x4 bs = ai == 0 ? pre[m][bj][n] : *(const f32x4*)(base + off + bj * HALF + n * 16); f32x4 o = bs + (acc[ai][bj][m][n] - sr.x) * sr.y;
                        if (bad) o = (f32x4){qnan, qnan, qnan, qnan}; *(f32x4*)(out + off + bj * HALF + n * 16) = o; }
                if (m & 1) asm volatile("" ::: "memory"); }
    }
};
struct EpiLnResLn {
    static constexpr bool PERM = false, AFTER_DRAIN = true;
    const float* base; float* out; bf16_t* xn; int ldc; const float* bias; PanelStats st1, st2; unsigned poison;
    __device__ __forceinline__ void fused(f32x4 (&acc)[2][2][4][2], const Unit& u, int wr, int wc, int fr, int fq, PG8_LAS unsigned char* lds, int wid, int lane) const {
        typedef float f32x2v __attribute__((ext_vector_type(2))); typedef unsigned u32x2v __attribute__((ext_vector_type(2)));
        const PG8_LAS f32x2v* S = (const PG8_LAS f32x2v*)(lds + 8192);
        const int col0 = u.pn * BM + wc * 32 + 4 * fq;
#pragma unroll
        for (int bj = 0; bj < 2; ++bj)
#pragma unroll
            for (int n = 0; n < 2; ++n) { const f32x4 bv = bias ? *(const f32x4*)(bias + col0 + bj * HALF + n * 16) : (f32x4){0.f, 0.f, 0.f, 0.f};
#pragma unroll
                for (int ai = 0; ai < 2; ++ai)
#pragma unroll
                    for (int m = 0; m < 4; ++m) acc[ai][bj][m][n] += bv; }
        bool bad = st1.run(acc, u, wr, wc, fr, fq, lds, wid, lane) || poison != 0u;
        const float qnan = __builtin_nanf("");
#pragma unroll
        for (int ai = 0; ai < 2; ++ai)
#pragma unroll
            for (int m = 0; m < 4; ++m) { const int r = ai * HALF + wr * 64 + m * 16 + fr; const f32x2v sr = S[r]; const size_t off = (size_t)(u.pm * BM + r) * ldc + col0;
#pragma unroll
                for (int bj = 0; bj < 2; ++bj)
#pragma unroll
                    for (int n = 0; n < 2; ++n) { const f32x4 bs = *(const f32x4*)(base + off + bj * HALF + n * 16); acc[ai][bj][m][n] = bs + (acc[ai][bj][m][n] - sr.x) * sr.y; }
                asm volatile("" : "+v"(acc[ai][0][m][0]), "+v"(acc[ai][0][m][1]), "+v"(acc[ai][1][m][0]), "+v"(acc[ai][1][m][1]));
                if (m & 1) asm volatile("" ::: "memory"); }
        const bool bad1 = bad;
        bad = st2.run(acc, u, wr, wc, fr, fq, lds, wid, lane) || bad;
#pragma unroll
        for (int ai = 0; ai < 2; ++ai)
#pragma unroll
            for (int m = 0; m < 4; ++m) { const int r = ai * HALF + wr * 64 + m * 16 + fr; const f32x2v sr = S[r]; const size_t off = (size_t)(u.pm * BM + r) * ldc + col0;
#pragma unroll
                for (int bj = 0; bj < 2; ++bj)
#pragma unroll
                    for (int n = 0; n < 2; ++n) { const f32x4 x1 = acc[ai][bj][m][n]; *(f32x4*)(out + off + bj * HALF + n * 16) = bad1 ? (f32x4){qnan, qnan, qnan, qnan} : x1;
                        const f32x4 o = (x1 - sr.x) * sr.y; u32x2v w; w.x = cvt_pk_bf16(o[0], o[1]); w.y = cvt_pk_bf16(o[2], o[3]);
                        if (bad) { w.x = 0x7fc07fc0u; w.y = 0x7fc07fc0u; } *(u32x2v*)(xn + off + bj * HALF + n * 16) = w; }
                asm volatile("" ::: "memory"); }
    }
};

template <class Epi, class Sched, bool ALIGN_EPI = false, bool SP2 = false, bool MID = false  >
__device__ __forceinline__ void gemm_phase(PG8_LAS unsigned char* lds, const Gemm g, const Sched& S, const Epi& E) {
    int tid_ = threadIdx.x; asm volatile("" : "+v"(tid_));
    const int tid = tid_, wid = __builtin_amdgcn_readfirstlane(tid >> 6), lane = tid & 63, wr = wid >> 2, wc = wid & 3, fr = lane & 15, fq = lane >> 4;
    const int K = g.K, nt = K / BK;
    unsigned voffA[2], voffB[2];
#pragma unroll
    for (int i = 0; i < 2; ++i) { int R, C; stage_rc(tid * 16 + i * 8192, R, C); const int Rb = Epi::PERM ? ((R & ~31) + perm32(R & 31)) : R;
        voffA[i] = (unsigned)(R * K + C) * 2u; voffB[i] = (unsigned)(Rb * K + C) * 2u; }
    const size_t kstep = (size_t)(BK * 2);
    const size_t hstep = (size_t)HALF * K * 2;
    const size_t tstep = 2 * hstep;
    const unsigned ldsw = (unsigned)wid * 1024u;
    const int aoff = lds_byte(wr * 64 + fr, fq * 8), boff = lds_byte(wc * 32 + fr, fq * 8);
#define PG8_SA(b, h) (((b) * 2 + (h)) * HTB)
#define PG8_SB(b, h) ((4 + (b) * 2 + (h)) * HTB)
#define PG8_STAGE(bufoff, gbase, voff) do { _Pragma("unroll") for (int _i = 0; _i < 2; ++_i) \
        __builtin_amdgcn_global_load_lds((const unsigned*)((const char*)(gbase) + (voff)[_i]), (PG8_LAS unsigned*)(lds + (bufoff) + ldsw + _i * 8192), 16, 0, 0); } while (0)
#define PG8_LDA(dst, b, h) do { _Pragma("unroll") for (int m = 0; m < 4; ++m) _Pragma("unroll") for (int k = 0; k < 2; ++k) dst[m][k] = *(const PG8_LAS bf16x8*)(lds + PG8_SA(b, h) + aoff + m * 2048 + k * 1024); } while (0)
#define PG8_LDB(dst, b, h) do { _Pragma("unroll") for (int n = 0; n < 2; ++n) _Pragma("unroll") for (int k = 0; k < 2; ++k) dst[n][k] = *(const PG8_LAS bf16x8*)(lds + PG8_SB(b, h) + boff + n * 2048 + k * 1024); } while (0)
#define PG8_MMA(ai, bj, At, Bt) do { __builtin_amdgcn_s_setprio(1); _Pragma("unroll") for (int m = 0; m < 4; ++m) _Pragma("unroll") for (int n = 0; n < 2; ++n) _Pragma("unroll") for (int k = 0; k < 2; ++k) \
        acc[ai][bj][m][n] = __builtin_amdgcn_mfma_f32_16x16x32_bf16(Bt[n][k], At[m][k], acc[ai][bj][m][n], 0, 0, 0); __builtin_amdgcn_s_setprio(0); } while (0)
#define PG8_WAIT_V(n) asm volatile("s_waitcnt vmcnt(" #n ")" ::: "memory")
#define PG8_WAIT_L(n) asm volatile("s_waitcnt lgkmcnt(" #n ")" ::: "memory")
#define PG8_BAR __builtin_amdgcn_s_barrier()
#define PG8_SCHED __builtin_amdgcn_sched_barrier(0)
    Unit cur, nxt; int ui = 0;
    if (!S.next(0, cur)) return;
    f32x4 acc[2][2][4][2];
#pragma unroll
    for (int a = 0; a < 2; ++a)
#pragma unroll
        for (int b = 0; b < 2; ++b)
#pragma unroll
            for (int m = 0; m < 4; ++m)
#pragma unroll
                for (int n = 0; n < 2; ++n) acc[a][b][m][n] = (f32x4){0.f, 0.f, 0.f, 0.f};
    bf16x8 At[4][2], B0[2][2], B1[2][2];
    const char* cA = (const char*)g.A + (size_t)cur.pm * tstep; const char* cB = (const char*)g.Bt + (size_t)cur.pn * tstep;
    S.a_ready(cur);
    if constexpr (SP2) {
        PG8_STAGE(PG8_SB(0, 0), cB, voffB); PG8_STAGE(PG8_SB(0, 1), cB + hstep, voffB); PG8_STAGE(PG8_SA(0, 0), cA, voffA); PG8_STAGE(PG8_SA(0, 1), cA + hstep, voffA);
        if (wr == 1) PG8_BAR;
        PG8_WAIT_V(2); PG8_BAR;
        PG8_STAGE(PG8_SB(1, 0), cB + kstep, voffB); PG8_STAGE(PG8_SA(1, 0), cA + kstep, voffA); PG8_STAGE(PG8_SB(1, 1), cB + hstep + kstep, voffB);
        PG8_WAIT_V(6); PG8_BAR;
    } else {
        PG8_STAGE(PG8_SB(0, 0), cB, voffB); PG8_STAGE(PG8_SA(0, 0), cA, voffA); PG8_STAGE(PG8_SB(0, 1), cB + hstep, voffB); PG8_STAGE(PG8_SA(0, 1), cA + hstep, voffA);
        if (wr == 1) PG8_BAR;
        PG8_WAIT_V(4); PG8_BAR;
        PG8_STAGE(PG8_SB(1, 0), cB + kstep, voffB); PG8_STAGE(PG8_SA(1, 0), cA + kstep, voffA); PG8_STAGE(PG8_SB(1, 1), cB + hstep + kstep, voffB);
        PG8_WAIT_V(6); PG8_BAR;
    }
    for (;;) {
        const bool has_next = S.next(ui + 1, nxt);
        const char* nA = has_next ? (const char*)g.A + (size_t)nxt.pm * tstep : cA; const char* nB = has_next ? (const char*)g.Bt + (size_t)nxt.pn * tstep : cB;
        for (int t = 0; t < nt; t += 2) {
            if constexpr (MID) { if (t == (nt >> 1)) E.mid(acc, cur, wr, wc, fr, fq); }
            const bool last = (t == nt - 2);
            const char* a1 = cA + (size_t)(t + 1) * kstep;
            const char* a2 = last ? nA : cA + (size_t)(t + 2) * kstep; const char* b2 = last ? nB : cB + (size_t)(t + 2) * kstep;
            const char* a3 = a2 + kstep; const char* b3 = b2 + kstep;
            if (last && has_next) S.a_ready(nxt);
            if constexpr (SP2) {
            PG8_LDB(B0, 0, 0); PG8_LDB(B1, 0, 1); PG8_SCHED; PG8_LDA(At, 0, 0); PG8_STAGE(PG8_SA(1, 1), a1 + hstep, voffA);
            PG8_WAIT_V(8); PG8_WAIT_L(0); PG8_BAR; PG8_MMA(0, 0, At, B0); PG8_MMA(0, 1, At, B1); PG8_BAR; PG8_SCHED;
            PG8_LDA(At, 0, 1); PG8_STAGE(PG8_SB(0, 0), b2, voffB); PG8_STAGE(PG8_SB(0, 1), b2 + hstep, voffB); PG8_STAGE(PG8_SA(0, 0), a2, voffA);
            PG8_WAIT_V(8); PG8_WAIT_L(0); PG8_BAR; PG8_MMA(1, 0, At, B0); PG8_MMA(1, 1, At, B1); PG8_BAR; PG8_SCHED;
            PG8_LDB(B0, 1, 0); PG8_LDB(B1, 1, 1); PG8_SCHED; PG8_LDA(At, 1, 0); PG8_STAGE(PG8_SA(0, 1), a2 + hstep, voffA);
            PG8_WAIT_V(8); PG8_WAIT_L(0); PG8_BAR; PG8_MMA(0, 0, At, B0); PG8_MMA(0, 1, At, B1); PG8_BAR; PG8_SCHED;
            PG8_LDA(At, 1, 1); PG8_STAGE(PG8_SB(1, 0), b3, voffB); PG8_STAGE(PG8_SB(1, 1), b3 + hstep, voffB); PG8_STAGE(PG8_SA(1, 0), a3, voffA);
            PG8_WAIT_V(8); PG8_WAIT_L(0); PG8_BAR; PG8_MMA(1, 0, At, B0); PG8_MMA(1, 1, At, B1); PG8_BAR; PG8_SCHED;
            } else {
            PG8_LDB(B0, 0, 0); PG8_SCHED; PG8_LDA(At, 0, 0); PG8_STAGE(PG8_SA(1, 1), a1 + hstep, voffA);
            PG8_WAIT_L(8); PG8_BAR; PG8_WAIT_L(0); PG8_MMA(0, 0, At, B0); PG8_BAR; PG8_SCHED;
            PG8_LDB(B1, 0, 1); PG8_STAGE(PG8_SB(0, 0), b2, voffB);
            PG8_BAR; PG8_WAIT_L(0); PG8_MMA(0, 1, At, B1); PG8_BAR;
            PG8_LDA(At, 0, 1); PG8_STAGE(PG8_SA(0, 0), a2, voffA);
            PG8_BAR; PG8_WAIT_L(0); PG8_MMA(1, 0, At, B0); PG8_BAR; PG8_SCHED;
            PG8_STAGE(PG8_SB(0, 1), b2 + hstep, voffB);
            PG8_WAIT_V(6); PG8_BAR; PG8_MMA(1, 1, At, B1); PG8_BAR;
            PG8_LDB(B0, 1, 0); PG8_SCHED; PG8_LDA(At, 1, 0); PG8_STAGE(PG8_SA(0, 1), a2 + hstep, voffA);
            PG8_WAIT_L(8); PG8_BAR; PG8_WAIT_L(0); PG8_MMA(0, 0, At, B0); PG8_BAR; PG8_SCHED;
            PG8_LDB(B1, 1, 1); PG8_STAGE(PG8_SB(1, 0), b3, voffB);
            PG8_BAR; PG8_WAIT_L(0); PG8_MMA(0, 1, At, B1); PG8_BAR;
            PG8_LDA(At, 1, 1); PG8_STAGE(PG8_SA(1, 0), a3, voffA);
            PG8_BAR; PG8_WAIT_L(0); PG8_MMA(1, 0, At, B0); PG8_BAR; PG8_SCHED;
            PG8_STAGE(PG8_SB(1, 1), b3 + hstep, voffB);
            PG8_WAIT_V(6); PG8_BAR; PG8_MMA(1, 1, At, B1); PG8_BAR;
            }
        }
        if constexpr (ALIGN_EPI) { if (wr == 0) PG8_BAR; }
        if constexpr (!Epi::AFTER_DRAIN) { E(acc, cur, wr, wc, fr, fq); S.done(cur); }
        if (!has_next) break;
#pragma unroll
        for (int a = 0; a < 2; ++a)
#pragma unroll
            for (int b = 0; b < 2; ++b)
#pragma unroll
                for (int m = 0; m < 4; ++m)
#pragma unroll
                    for (int n = 0; n < 2; ++n) acc[a][b][m][n] = (f32x4){0.f, 0.f, 0.f, 0.f};
        cur = nxt; cA = nA; cB = nB; ++ui;
        if constexpr (ALIGN_EPI) { if (wr == 1) PG8_BAR; }
    }
    PG8_WAIT_V(0);
    if constexpr (!ALIGN_EPI) { if (wr == 0) PG8_BAR; }
    PG8_BAR;
    if constexpr (Epi::AFTER_DRAIN) { E.fused(acc, cur, wr, wc, fr, fq, lds, wid, lane); S.done(cur); }
#undef PG8_SA
#undef PG8_SB
#undef PG8_STAGE
#undef PG8_LDA
#undef PG8_LDB
#undef PG8_MMA
#undef PG8_WAIT_V
#undef PG8_WAIT_L
#undef PG8_BAR
#undef PG8_SCHED
}
}
#include <hip/hip_bf16.h>
#include <cmath>
namespace attn2 {
using bf16=__hip_bfloat16;
using bf16x8=__attribute__((ext_vector_type(8)))short;
using s16x4=__attribute__((ext_vector_type(4)))short;
using f32x16=__attribute__((ext_vector_type(16)))float;
using f32x4=__attribute__((ext_vector_type(4)))float;
using u32x4=__attribute__((ext_vector_type(4)))unsigned;
using u32x2=__attribute__((ext_vector_type(2)))unsigned;
constexpr int BATCH=4,NHEAD=8,SEQ=8192,D=64,DM=NHEAD*D;
constexpr int OPITCH=1024; constexpr int NW=8,QBLK=32,QB=QBLK*NW,KVBLK=64,NQB=SEQ/QB;
__device__ __forceinline__ int crow(int r,int hi){return (r&3)+8*(r>>2)+4*hi;}
#define SBAR() __builtin_amdgcn_sched_barrier(0)
constexpr int NSLOT=3, SLOTB=8192;
constexpr int TBN=1344, TBSTRIDE=1360, TBOFF=1087;
constexpr int LDS_K=0, LDS_V=NSLOT*SLOTB, LDS_WS=2*NSLOT*SLOTB, LDS_OST=LDS_WS+NW*64*4, LDS_MASK=LDS_OST+NW*4096, LDS_TB=LDS_MASK+NSLOT*2048, LDS_BYTES=LDS_TB+4*TBSTRIDE*4;
__device__ __forceinline__ void glds16(const void*gsrc,unsigned lds_dst){unsigned keep;
  asm volatile("s_mov_b32 %0, m0\n\ts_mov_b32 m0, %2\n\ts_nop 0\n\tglobal_load_lds_dwordx4 %1, off\n\ts_mov_b32 m0, %0":"=&s"(keep):"v"(gsrc),"s"(lds_dst):"memory");}
__device__ __forceinline__ void glds4(const void*gsrc,unsigned lds_dst){unsigned keep;
  asm volatile("s_mov_b32 %0, m0\n\ts_mov_b32 m0, %2\n\ts_nop 0\n\tglobal_load_lds_dword %1, off\n\ts_mov_b32 m0, %0":"=&s"(keep):"v"(gsrc),"s"(lds_dst):"memory");}
typedef float f32x2_t __attribute__((ext_vector_type(2))); typedef __bf16 bf16x2_t __attribute__((ext_vector_type(2)));
__device__ __forceinline__ unsigned cvtpk_s(float lo,float hi){f32x2_t v={lo,hi};bf16x2_t b=__builtin_convertvector(v,bf16x2_t);return __builtin_bit_cast(unsigned,b);}
#define WAIT_BAR(N) asm volatile("s_waitcnt vmcnt(" #N ") lgkmcnt(0)\n\ts_barrier":::"memory")
typedef __attribute__((address_space(3))) const char* lds_cptr;
typedef short v4i16_t __attribute__((ext_vector_type(4)));
__device__ __forceinline__ void kload8(bf16x8*kf,lds_cptr kp){
  kf[0]=*(const __attribute__((address_space(3))) bf16x8*)(kp);      kf[1]=*(const __attribute__((address_space(3))) bf16x8*)(kp+512);
  kf[2]=*(const __attribute__((address_space(3))) bf16x8*)(kp+2048); kf[3]=*(const __attribute__((address_space(3))) bf16x8*)(kp+2560);
  kf[4]=*(const __attribute__((address_space(3))) bf16x8*)(kp+4096); kf[5]=*(const __attribute__((address_space(3))) bf16x8*)(kp+4608);
  kf[6]=*(const __attribute__((address_space(3))) bf16x8*)(kp+6144); kf[7]=*(const __attribute__((address_space(3))) bf16x8*)(kp+6656);
}
__device__ __forceinline__ void kload2(bf16x8*kf,lds_cptr kp,int j){ kf[2*j]=*(const __attribute__((address_space(3))) bf16x8*)(kp+j*2048); kf[2*j+1]=*(const __attribute__((address_space(3))) bf16x8*)(kp+j*2048+512); }
__device__ __forceinline__ s16x4 vtr(lds_cptr p){ return __builtin_bit_cast(s16x4,__builtin_amdgcn_ds_read_tr16_b64_v4i16((__attribute__((address_space(3))) v4i16_t*)p)); }
__device__ __forceinline__ float exm(float x,unsigned w,int pos){ return __uint_as_float(__float_as_uint(__builtin_amdgcn_exp2f(x))&(unsigned)__builtin_amdgcn_sbfe((int)w,pos,1)); }
__device__ __forceinline__ void cinit_near(f32x16&c0,f32x16&c1,lds_cptr tb){
  #pragma unroll
  for(int g=0;g<4;++g){ const f32x4 a=*(const __attribute__((address_space(3))) f32x4*)(tb+32*g), b=*(const __attribute__((address_space(3))) f32x4*)(tb+128+32*g);
    c0[4*g]=a[0];c0[4*g+1]=a[1];c0[4*g+2]=a[2];c0[4*g+3]=a[3]; c1[4*g]=b[0];c1[4*g+1]=b[1];c1[4*g+2]=b[2];c1[4*g+3]=b[3]; }
}
__device__ __forceinline__ void pv(f32x16*o,int vb,bf16x8 pa0,bf16x8 pa1,bf16x8 pa2,bf16x8 pa3){
  #pragma unroll
  for(int d0=0;d0<2;++d0){s16x4 lo[4],hi[4];
    #pragma unroll
    for(int ks=0;ks<4;++ks){
      asm volatile("ds_read_b64_tr_b16 %0,%1 offset:%c2":"=&v"(lo[ks]):"v"(vb),"i"(d0*4096+ks*1024):"memory");
      asm volatile("ds_read_b64_tr_b16 %0,%1 offset:%c2":"=&v"(hi[ks]):"v"(vb),"i"(d0*4096+ks*1024+512):"memory");}
    asm volatile("s_waitcnt lgkmcnt(0)":::"memory");SBAR();
    #define PK(k) (bf16x8){lo[k][0],lo[k][1],lo[k][2],lo[k][3],hi[k][0],hi[k][1],hi[k][2],hi[k][3]}
    o[d0]=__builtin_amdgcn_mfma_f32_32x32x16_bf16(pa0,PK(0),o[d0],0,0,0);
    o[d0]=__builtin_amdgcn_mfma_f32_32x32x16_bf16(pa1,PK(1),o[d0],0,0,0);
    o[d0]=__builtin_amdgcn_mfma_f32_32x32x16_bf16(pa2,PK(2),o[d0],0,0,0);
    o[d0]=__builtin_amdgcn_mfma_f32_32x32x16_bf16(pa3,PK(3),o[d0],0,0,0);
    #undef PK
  }
}
#ifndef ATTN_STORE16
#define ATTN_STORE16(p,v) (*(u32x4*)(p)=(v))
#endif
__device__ __forceinline__ void attn_unit(int b,int h,int qb,const bf16*Q,const bf16*__restrict__ K,const bf16*__restrict__ V,bf16*O,const unsigned*__restrict__ bm,const float*__restrict__ tabh,float mb,char*shm){
  const int tid=threadIdx.x,lane=tid&63,r32=lane&31,hi=lane>>5; const int wid=__builtin_amdgcn_readfirstlane(tid>>6);
  const long rowbase=(long)b*SEQ; const int q0=qb*QB;
  const bf16*Qw=Q+(rowbase+q0+wid*QBLK)*DM+h*D;
  const bf16*Kh=K+rowbase*DM+h*D,*Vh=V+rowbase*DM+h*D;
  const unsigned lds0=(unsigned)(uintptr_t)shm;
  float*wsf=(float*)(shm+LDS_WS)+wid*64;
  { float*tb=(float*)(shm+LDS_TB);
    for(int i=tid;i<4*TBSTRIDE;i+=NW*64){ const int k=i/TBSTRIDE,j=i-k*TBSTRIDE; tb[i]=((j+k<TBN)?tabh[j+k]:0.f)-mb; } }
  const bf16*ksrc=Kh+(long)lane*DM+wid*8;
  const bf16*vsrc=Vh+(long)(16*(wid&3)+(lane>>2))*DM+(wid>>2)*32+(lane&3)*8;
  const unsigned*msrc=bm+(rowbase+q0+wid*QBLK+(lane>>1))*256+(lane&1);
  const unsigned kdst=lds0+LDS_K+wid*1024, vdst=lds0+LDS_V+wid*1024, mdst=lds0+LDS_MASK+wid*256;
  #define DMA_K(t,slot) glds16(ksrc+(long)(t)*KVBLK*DM,(unsigned)__builtin_amdgcn_readfirstlane(kdst+(slot)))
  #define DMA_V(t,slot) glds16(vsrc+(long)(t)*KVBLK*DM,(unsigned)__builtin_amdgcn_readfirstlane(vdst+(slot)))
  #define DMA_M(t,slot) glds4(msrc+2*(t),(unsigned)__builtin_amdgcn_readfirstlane(mdst+((slot)>>2)))
  const int vb0=(int)(lds0+LDS_V)+((lane>>4)&1)*32+(lane&3)*8+(4*hi+((lane&15)>>2))*64;
  bf16x8 kf[8];
  const lds_cptr shm3=(lds_cptr)shm; const lds_cptr kp0=shm3+LDS_K+hi*1024+r32*16; const lds_cptr vp0=shm3+LDS_V+((lane>>4)&1)*32+(lane&3)*8+(4*hi+((lane&15)>>2))*64;
  const lds_cptr mp0=shm3+LDS_MASK+wid*256+r32*8;
  const int NT=(q0+QB)/KVBLK;
  const int qw=q0+wid*QBLK; int tn=(qw-622>=0)?((qw-622)/64+1):0; tn&=~1;
  const int qpos=qw+r32, idx0=4*hi+TBOFF-qpos, kcp=idx0&3;
  const lds_cptr tb0=shm3+LDS_TB+(kcp*TBSTRIDE+(idx0-kcp))*4;
  DMA_K(0,0);DMA_M(0,0);DMA_V(0,0);DMA_K(1,SLOTB);DMA_M(1,SLOTB);
  bf16x8 qr[4];
  #pragma unroll
  for(int d0=0;d0<4;++d0)qr[d0]=*reinterpret_cast<const bf16x8*>(&Qw[(long)r32*DM+d0*16+hi*8]);
  float l_reg=0.f;f32x16 o[2];o[0]=f32x16{};o[1]=f32x16{};
  f32x16 negm; { const float nf=tabh[0]-mb;
    #pragma unroll
    for(int r=0;r<16;++r)negm[r]=nf; } asm volatile("":"+v"(negm));
  f32x16 pA0,pA1,pB0,pB1;
  int sl_prev=0,sl_cur=0,sl_next=SLOTB;
  #define ROT() do{sl_prev=sl_cur;sl_cur=sl_next;sl_next=(sl_next==(NSLOT-1)*SLOTB)?0:sl_next+SLOTB;}while(0)
  DMA_K(2,2*SLOTB);
  WAIT_BAR(3);
  { const char*kb=shm+LDS_K+hi*1024+r32*16;
    if(tn>0){pA0=negm;pA1=negm;} else cinit_near(pA0,pA1,tb0);
    #pragma unroll
    for(int d0=0;d0<4;++d0){
      const bf16x8 b0=*reinterpret_cast<const bf16x8*>(kb+d0*2048);
      const bf16x8 b1=*reinterpret_cast<const bf16x8*>(kb+d0*2048+512);
      pA0=__builtin_amdgcn_mfma_f32_32x32x16_bf16(b0,qr[d0],pA0,0,0,0);pA1=__builtin_amdgcn_mfma_f32_32x32x16_bf16(b1,qr[d0],pA1,0,0,0);}
    const u32x2 mw=*(const __attribute__((address_space(3))) u32x2*)(mp0); const unsigned w0=mw.x>>(4*hi),w1=mw.y>>(4*hi);
    #pragma unroll
    for(int r=0;r<16;++r){pA0[r]=exm(pA0[r],w0,(r&3)+8*(r>>2));pA1[r]=exm(pA1[r],w1,(r&3)+8*(r>>2));} }
  WAIT_BAR(0);
  DMA_K(3,0);DMA_V(1,SLOTB);DMA_M(2,2*SLOTB);
  ROT();
  kload8(kf,kp0+sl_cur);
  WAIT_BAR(3);
  s16x4 vlo[8],vhi[8]; u32x4 pw0,pw1,pw2,pw3;
  #define PKW(P,B) cvtpk_s(P[B],P[B+1])
  #define PAF(k) __builtin_bit_cast(bf16x8,pw##k)
  #define VFR(i) (bf16x8){vlo[i][0],vlo[i][1],vlo[i][2],vlo[i][3],vhi[i][0],vhi[i][1],vhi[i][2],vhi[i][3]}
  #define PIN(x) asm volatile("":"+v"(x))
  #define GAPA(MF,A0,A1,A2,A3,W0,W1,PW) do{ MF; sacc+=A0; sacc+=A1; sacc+=A2; sacc+=A3; PIN(sacc); W0; W1; PIN(PW); SBAR(); }while(0)
  #define EXB(x,T,I) __uint_as_float(__float_as_uint(__builtin_amdgcn_exp2f(x))&(unsigned)__builtin_amdgcn_sbfe((int)(T),8*(I),8))
  #define EXM4(X,A,T) do{ X[A]=EXB(X[A],T,0); X[(A)+4]=EXB(X[(A)+4],T,1); X[(A)+8]=EXB(X[(A)+8],T,2); X[(A)+12]=EXB(X[(A)+12],T,3); }while(0)
  #define GAPB(MF,X,A,TB) do{ MF; { unsigned t_=(TB)<<(3-(A)); asm("":"+v"(t_)); EXM4(X,A,t_); } PIN(X); SBAR(); }while(0)
  #define VRD(i) do{ vlo[i]=vtr(vp_+(((i)>>2)*4096+((i)&3)*1024)); vhi[i]=vtr(vp_+(((i)>>2)*4096+((i)&3)*1024+512)); }while(0)
  #define KRD(G,j) do{ if(G){ kload2(kf,kp0+sl_next,j); SBAR(); } }while(0)
  #define STEP(C0,C1,P0,P1,t,GK,GV,GM,GL,NEAR) do{ SBAR(); \
    const lds_cptr vp_=vp0+sl_prev; \
    if(NEAR){ cinit_near(C0,C1,tb0+256*(t)); SBAR(); } \
    VRD(0); SBAR(); float sacc=(P0[0]+P0[1]); \
    GAPA(C0=__builtin_amdgcn_mfma_f32_32x32x16_bf16(kf[0],qr[0],(NEAR)?C0:negm,0,0,0), P0[2],P0[3],P0[4],P0[5],     pw0[0]=PKW(P0,0), pw0[1]=PKW(P0,2), pw0); \
    VRD(4); SBAR(); GAPA(C1=__builtin_amdgcn_mfma_f32_32x32x16_bf16(kf[1],qr[0],(NEAR)?C1:negm,0,0,0), P0[6],P0[7],P0[8],P0[9],     pw0[2]=PKW(P0,4), pw0[3]=PKW(P0,6), pw0); \
    VRD(1); SBAR(); GAPA(C0=__builtin_amdgcn_mfma_f32_32x32x16_bf16(kf[2],qr[1],C0,0,0,0),   P0[10],P0[11],P0[12],P0[13], pw1[0]=PKW(P0,8), pw1[1]=PKW(P0,10), pw1); \
    VRD(5); SBAR(); GAPA(C1=__builtin_amdgcn_mfma_f32_32x32x16_bf16(kf[3],qr[1],C1,0,0,0),   P0[14],P0[15],P1[0],P1[1],   pw1[2]=PKW(P0,12),pw1[3]=PKW(P0,14), pw1); \
    VRD(2); SBAR(); GAPA(C0=__builtin_amdgcn_mfma_f32_32x32x16_bf16(kf[4],qr[2],C0,0,0,0),   P1[2],P1[3],P1[4],P1[5],     pw2[0]=PKW(P1,0), pw2[1]=PKW(P1,2), pw2); \
    VRD(6); SBAR(); GAPA(C1=__builtin_amdgcn_mfma_f32_32x32x16_bf16(kf[5],qr[2],C1,0,0,0),   P1[6],P1[7],P1[8],P1[9],     pw2[2]=PKW(P1,4), pw2[3]=PKW(P1,6), pw2); \
    VRD(3); SBAR(); GAPA(C0=__builtin_amdgcn_mfma_f32_32x32x16_bf16(kf[6],qr[3],C0,0,0,0),   P1[10],P1[11],P1[12],P1[13], pw3[0]=PKW(P1,8), pw3[1]=PKW(P1,10), pw3); \
    VRD(7); SBAR(); GAPA(C1=__builtin_amdgcn_mfma_f32_32x32x16_bf16(kf[7],qr[3],C1,0,0,0),   P1[14],P1[15],0.f,0.f,       pw3[2]=PKW(P1,12),pw3[3]=PKW(P1,14), pw3); \
    l_reg+=sacc; \
    if(GK){DMA_K((t)+3,sl_cur);} if(GV){DMA_V((t)+1,sl_next);} if(GM){DMA_M((t)+2,sl_prev);} \
    const u32x2 mw_=*(const __attribute__((address_space(3))) u32x2*)(mp0+(sl_cur>>2)); const unsigned w0_=mw_.x<<(4-4*hi),w1_=mw_.y<<(4-4*hi); \
    SBAR(); \
    GAPB(o[0]=__builtin_amdgcn_mfma_f32_32x32x16_bf16(PAF(0),VFR(0),o[0],0,0,0), C0,0,w0_); \
    GAPB(o[1]=__builtin_amdgcn_mfma_f32_32x32x16_bf16(PAF(0),VFR(4),o[1],0,0,0), C0,1,w0_); \
    KRD(GL,0); GAPB(o[0]=__builtin_amdgcn_mfma_f32_32x32x16_bf16(PAF(1),VFR(1),o[0],0,0,0), C0,2,w0_); \
    KRD(GL,1); GAPB(o[1]=__builtin_amdgcn_mfma_f32_32x32x16_bf16(PAF(1),VFR(5),o[1],0,0,0), C0,3,w0_); \
    KRD(GL,2); GAPB(o[0]=__builtin_amdgcn_mfma_f32_32x32x16_bf16(PAF(2),VFR(2),o[0],0,0,0), C1,0,w1_); \
    KRD(GL,3); GAPB(o[1]=__builtin_amdgcn_mfma_f32_32x32x16_bf16(PAF(2),VFR(6),o[1],0,0,0), C1,1,w1_); \
    GAPB(o[0]=__builtin_amdgcn_mfma_f32_32x32x16_bf16(PAF(3),VFR(3),o[0],0,0,0), C1,2,w1_); \
    GAPB(o[1]=__builtin_amdgcn_mfma_f32_32x32x16_bf16(PAF(3),VFR(7),o[1],0,0,0), C1,3,w1_); \
    }while(0)
  int t=1;
  for(;t+5<NT&&t+1<tn;t+=2){
    STEP(pB0,pB1,pA0,pA1,t,true,true,true,true,false);     WAIT_BAR(3); ROT();
    STEP(pA0,pA1,pB0,pB1,t+1,true,true,true,true,false);   WAIT_BAR(3); ROT();
  }
  for(;t+5<NT;t+=2){
    STEP(pB0,pB1,pA0,pA1,t,true,true,true,true,true);     WAIT_BAR(3); ROT();
    STEP(pA0,pA1,pB0,pB1,t+1,true,true,true,true,true);   WAIT_BAR(3); ROT();
  }
  #define ENDW(tt) do{ if((tt)+3<NT){WAIT_BAR(3);} else if((tt)+2<NT){WAIT_BAR(2);} else {WAIT_BAR(0);} }while(0)
  for(;t+1<NT;t+=2){
    STEP(pB0,pB1,pA0,pA1,t,(t+3<NT),(t+1<NT),(t+2<NT),(t+1<NT),true);       ENDW(t);   ROT();
    STEP(pA0,pA1,pB0,pB1,t+1,(t+4<NT),(t+2<NT),(t+3<NT),(t+2<NT),true);     ENDW(t+1); ROT();
  }
  STEP(pB0,pB1,pA0,pA1,NT-1,false,false,false,false,true);
  { float sacc=pB0[0]+pB0[1]; _Pragma("unroll") for(int r=2;r<16;++r)sacc+=pB0[r]; _Pragma("unroll") for(int r=0;r<16;++r)sacc+=pB1[r]; l_reg+=sacc;
    pw0=(u32x4){PKW(pB0,0),PKW(pB0,2),PKW(pB0,4),PKW(pB0,6)};pw1=(u32x4){PKW(pB0,8),PKW(pB0,10),PKW(pB0,12),PKW(pB0,14)};pw2=(u32x4){PKW(pB1,0),PKW(pB1,2),PKW(pB1,4),PKW(pB1,6)};pw3=(u32x4){PKW(pB1,8),PKW(pB1,10),PKW(pB1,12),PKW(pB1,14)};
    SBAR(); pv(o,vb0+sl_cur,PAF(0),PAF(1),PAF(2),PAF(3)); }
  #undef PKW
  #undef PAF
  #undef VFR
  #undef PIN
  #undef GAPA
  #undef GAPB
  #undef VRD
  #undef KRD
  #undef STEP
  #undef ENDW
  {auto rr=__builtin_amdgcn_permlane32_swap(__float_as_uint(l_reg),__float_as_uint(l_reg),false,false);l_reg=__uint_as_float(rr[0])+__uint_as_float(rr[1]);}
  if(hi==0)wsf[32+r32]=l_reg;asm volatile("s_waitcnt lgkmcnt(0)":::"memory");
  float rli[16];
  #pragma unroll
  for(int r=0;r<16;++r)rli[r]=__builtin_amdgcn_rcpf(wsf[32+crow(r,hi)]);
  bf16*Ow=O+(rowbase+q0+wid*QBLK)*OPITCH+h*D;
  { bf16*stg=(bf16*)(shm+LDS_OST)+wid*2048;
    #pragma unroll
    for(int r=0;r<16;++r){const int orow=crow(r,hi);
      #pragma unroll
      for(int d0=0;d0<2;++d0)stg[orow*64+d0*32+r32]=__float2bfloat16(o[d0][r]*rli[r]);}
    asm volatile("s_waitcnt lgkmcnt(0)":::"memory");
    #pragma unroll
    for(int i=0;i<4;++i){const int row=i*8+(lane>>3),ch=lane&7; const u32x4 v=*(const u32x4*)(stg+row*64+ch*8); ATTN_STORE16(Ow+(long)row*OPITCH+ch*8,v);} }
  asm volatile("s_waitcnt lgkmcnt(0)\n\ts_barrier":::"memory");
  #undef DMA_K
  #undef DMA_V
  #undef DMA_M
  #undef ROT
}
constexpr int ATTN_LDS_BYTES=LDS_BYTES;
struct AttnUnit { int bh; int qb; };
struct StaticOrder {
  int vcu,grid;
  __device__ __forceinline__ explicit StaticOrder(int g,int block):vcu((g%8==0)?(block%8)*(g/8)+block/8:block),grid(g){}
  __device__ __forceinline__ bool next(int i,AttnUnit&u)const{
    if(grid==256){ if(i>=4)return false; const int s=vcu&7; u.bh=vcu>>3; u.qb=(i==0)?s:(i==1)?15-s:(i==2)?16+s:31-s; return true; }
    const int L=i*grid+vcu; if(L>=BATCH*NHEAD*NQB)return false; u.bh=L/NQB; u.qb=L%NQB; return true; }
};
__device__ __forceinline__ void attn_phase(char*lds,const bf16*Q,const bf16*K,const bf16*V,bf16*O,const unsigned*bm,const float*tab,const float*mbp,const StaticOrder&S){
  AttnUnit u; const float mb=*mbp;
  for(int i=0;S.next(i,u);++i){ attn_unit(u.bh/NHEAD,u.bh%NHEAD,u.qb,Q,K,V,O,bm,tab+(u.bh%NHEAD)*TBN,mb,lds); }
}
#undef SBAR
#undef WAIT_BAR
}

constexpr int NWAVES = 8;
constexpr int BATCH = 4, SEQ = 8192, M = BATCH * SEQ, D = 1024;
constexpr int AW = 512, NH = 8, HD = 64, TOPK = 256;
constexpr int NIN = 5376;
constexpr int PEER_H = 8, NKEYS = 128, PTOPK = 16, PLE = 256, CONVW = 31;
constexpr float EPS = 1e-6f, LOG2E = 1.4426950408889634f;
constexpr float C2 = 0.125f * LOG2E;
constexpr float IDX_SCALE = 0.125f * 0.35355339059327373f;
constexpr int TABN = 1344, TABOFF = 1087;

constexpr size_t MiB = 1u << 20;
constexpr size_t WS_CTL = 0, CTL_ZERO_BYTES = 1 * MiB;
constexpr size_t WS_SS1 = 512 * 1024;
constexpr size_t WS_RSTD1 = 1 * MiB, WS_RSTD3 = 1 * MiB + 128 * 1024, WS_TAB = 1 * MiB + 256 * 1024;
constexpr size_t WS_WI = 2 * MiB, WS_KI = 3 * MiB;
constexpr size_t WS_WIN = 8 * MiB, WS_WA = 19 * MiB, WS_WC = 20 * MiB, WS_WOUT = 21 * MiB, WS_WQ = 23 * MiB, WS_WG = 27 * MiB, WS_WP = 29 * MiB, WS_SUBK = 29 * MiB + 512 * 1024;
constexpr size_t WS_EU = 30 * MiB, WS_EV = 62 * MiB, WS_PB = 94 * MiB;
constexpr size_t WS_RC = 110 * MiB;
constexpr size_t WS_RD = 174 * MiB;
constexpr size_t WS_RB = 238 * MiB;
constexpr size_t WS_RA = 366 * MiB;
constexpr size_t WS_END = 494 * MiB;
constexpr int CW_TMO = 0, CW_CODE = 1, CW_BAR = 4096;

constexpr int RING_OFF = 0, RING_BYTES = 131072;
constexpr int LDSCTL_OFF = RING_BYTES, MISC_OFF = LDSCTL_OFF + 320;
constexpr int LDS_BYTES = 147456;

#define GAS __attribute__((address_space(1)))
#define LAS __attribute__((address_space(3)))
typedef unsigned short bf16;
typedef unsigned v4u __attribute__((ext_vector_type(4)));
typedef unsigned v2u __attribute__((ext_vector_type(2)));
typedef float f32x4 __attribute__((ext_vector_type(4)));
typedef __bf16 bf2_t __attribute__((ext_vector_type(2)));
#define LDS_WAIT() asm volatile("s_waitcnt lgkmcnt(0)" ::: "memory")
#define VM_WAIT() asm volatile("s_waitcnt vmcnt(0)" ::: "memory")
typedef float f32x2cv __attribute__((ext_vector_type(2))); typedef __bf16 bf16x2cv __attribute__((ext_vector_type(2)));
__device__ __forceinline__ unsigned pk2(float lo, float hi) { return __builtin_bit_cast(unsigned, __builtin_convertvector((f32x2cv){lo, hi}, bf16x2cv)); }
__device__ __forceinline__ unsigned f2bf(float f) { return pk2(f, 0.f) & 0xffffu; }
__device__ __forceinline__ float bflo(unsigned w) { return __uint_as_float(w << 16); }
__device__ __forceinline__ float bfhi(unsigned w) { return __uint_as_float(w & 0xffff0000u); }
__device__ __forceinline__ float bf1(bf16 b) { return __uint_as_float((unsigned)b << 16); }
__device__ __forceinline__ float dot2(unsigned a, unsigned b, float c) { return __builtin_amdgcn_fdot2_f32_bf16(__builtin_bit_cast(bf2_t, a), __builtin_bit_cast(bf2_t, b), c, false); }
__device__ __forceinline__ float dot8(v4u a, v4u b, float c) { c = dot2(a.x, b.x, c); c = dot2(a.y, b.y, c); c = dot2(a.z, b.z, c); return dot2(a.w, b.w, c); }
__device__ __forceinline__ float sigmoidf_(float x) { return __builtin_amdgcn_rcpf(1.0f + __builtin_amdgcn_exp2f(-LOG2E * x)); }
__device__ __forceinline__ float sigmoid255(float x) { return __builtin_amdgcn_rcpf((1.0f / 255.0f) + __builtin_amdgcn_exp2f(__builtin_fmaf(x, -LOG2E, -7.99435343686f))); }
__device__ __forceinline__ float gelu_tanh(float x) { const float y = 0.7978845608028654f * (x + 0.044715f * x * x * x); return x * __builtin_amdgcn_rcpf(1.0f + __builtin_amdgcn_exp2f(-2.0f * LOG2E * y)); }
__device__ __forceinline__ unsigned sortable(float f) { const unsigned u = __float_as_uint(f); return (u & 0x80000000u) ? ~u : (u | 0x80000000u); }
__device__ __forceinline__ float wave_sum(float v);
#define DPP_F(V, CTRL) __uint_as_float((unsigned)__builtin_amdgcn_update_dpp(0, (int)__float_as_uint(V), CTRL, 0xF, 0xF, false))
__device__ __forceinline__ float lane_xor1(float v) { return DPP_F(v, 0xB1); }
__device__ __forceinline__ float lane_xor2(float v) { return DPP_F(v, 0x4E); }
__device__ __forceinline__ float lane_xor8(float v) { return DPP_F(v, 0x128); }
__device__ __forceinline__ float lane_xor4(float v, bool hi4) { const float up = DPP_F(v, 0x104), dn = DPP_F(v, 0x114); return hi4 ? dn : up; }
__device__ __forceinline__ float half_sum_f(float v) {
    v += DPP_F(v, 0xB1); v += DPP_F(v, 0x4E); v += DPP_F(v, 0x141); v += DPP_F(v, 0x140);
    const auto sw = __builtin_amdgcn_permlane16_swap(__float_as_uint(v), __float_as_uint(v), false, false); return __uint_as_float(sw[0]) + __uint_as_float(sw[1]); }
__device__ __forceinline__ float xor16_sum(float v) { const auto sw = __builtin_amdgcn_permlane16_swap(__float_as_uint(v), __float_as_uint(v), false, false); return __uint_as_float(sw[0]) + __uint_as_float(sw[1]); }
__device__ __forceinline__ float xor32_sum(float v) { const auto sw = __builtin_amdgcn_permlane32_swap(__float_as_uint(v), __float_as_uint(v), false, false); return __uint_as_float(sw[0]) + __uint_as_float(sw[1]); }
__device__ __forceinline__ float wave_sum(float v) { return xor32_sum(half_sum_f(v)); }
__device__ __forceinline__ float wave_max(float v) {
#pragma unroll
    for (int o = 1; o < 64; o <<= 1) v = fmaxf(v, __shfl_xor(v, o));
    return v;
}
__device__ __forceinline__ unsigned long long wave_max_u64(unsigned long long v) {
#pragma unroll
    for (int o = 1; o < 64; o <<= 1) { const unsigned lo = __shfl_xor((unsigned)v, o), hi = __shfl_xor((unsigned)(v >> 32), o); const unsigned long long w = ((unsigned long long)hi << 32) | lo; v = w > v ? w : v; }
    return v;
}

__device__ __forceinline__ int opaque_i(int v) { asm volatile("" : "+s"(v)); return v; }
#define XB_TMO      128
#define XB_XCNT(j)  (256  + 64 * (j))
#define XB_XSUB(j)  (1280 + 64 * (j))
#define XB_XGEN(j)  (2304 + 64 * (j))
#define XB_TOP      3328
#define XB_TOPGEN   3392
#define XCD_BAR_WORDS 3456
#define XB_SPIN_CAP (1u << 18)
__device__ __forceinline__ unsigned xb_ld(unsigned* p)              { return __hip_atomic_load(p, __ATOMIC_RELAXED, __HIP_MEMORY_SCOPE_AGENT); }
__device__ __forceinline__ unsigned xb_add(unsigned* p, unsigned v) { return __hip_atomic_fetch_add(p, v, __ATOMIC_RELAXED, __HIP_MEMORY_SCOPE_AGENT); }
__device__ __forceinline__ unsigned xb_xcc_id() { return (unsigned)__builtin_amdgcn_s_getreg((3 << 11) | 20) & 0xFu; }
#define XB_SPIN(cond, bar) do { unsigned _sp = 0; while (cond) { __builtin_amdgcn_s_sleep(1); \
    if ((++_sp & 255u) == 0u) { if (xb_ld(&(bar)[XB_TMO])) break; if (_sp > XB_SPIN_CAP) { atomicAdd(&(bar)[XB_TMO], 1u); break; } } } } while (0)
struct XcdBarrier { unsigned* bar; unsigned x; volatile LAS unsigned* st; };
__device__ __forceinline__ XcdBarrier xcd_barrier_post(unsigned* bar, volatile LAS unsigned* st) {
    XcdBarrier b; b.bar = bar; b.x = xb_xcc_id(); b.st = st;
    if (threadIdx.x == 0) (void)xb_add(&bar[XB_XCNT(b.x)], 1u);
    return b;
}
__device__ __forceinline__ void xcd_barrier_complete(unsigned* bar, unsigned x, unsigned& nloc, unsigned& nx) {
    const unsigned G = gridDim.x * gridDim.y * gridDim.z;
    unsigned sum, cnt, mine, sp = 0u;
    for (;;) {
        sum = 0u; cnt = 0u; mine = 0u;
#pragma unroll
        for (unsigned j = 0; j < 16; ++j) { const unsigned c = xb_ld(&bar[XB_XCNT(j)]); sum += c; cnt += (c > 0u) ? 1u : 0u; mine = (j == x) ? c : mine; }
        if (sum == G) break;
        __builtin_amdgcn_s_sleep(1);
        if ((++sp & 255u) == 0u) { if (xb_ld(&bar[XB_TMO])) break; if (sp > XB_SPIN_CAP) { atomicAdd(&bar[XB_TMO], 1u); break; } }
    }
    nloc = mine > 0u ? mine : 1u; nx = cnt > 0u ? cnt : 1u;
}
__device__ __forceinline__ void xcd_barrier(const XcdBarrier& b) {
    asm volatile("s_waitcnt vmcnt(0)" ::: "memory");
    __syncthreads();
    if (threadIdx.x == 0) {
        unsigned* bar = b.bar;
        __builtin_amdgcn_s_waitcnt(0);
        unsigned nloc = b.st[0], nx = b.st[1];
        if (nloc == 0u) { xcd_barrier_complete(bar, b.x, nloc, nx); b.st[0] = nloc; b.st[1] = nx; }
        const unsigned old = xb_add(&bar[XB_XSUB(b.x)], 1u);
        const unsigned gen = old / nloc;
        if (old + 1u == (gen + 1u) * nloc) {
            __builtin_amdgcn_fence(__ATOMIC_RELEASE, "agent");
            asm volatile("s_waitcnt vmcnt(0)" ::: "memory");
            const unsigned og = xb_add(&bar[XB_TOP], 1u);
            const unsigned tg = og / nx;
            if (og + 1u == (tg + 1u) * nx) xb_add(&bar[XB_TOPGEN], 1u);
            else XB_SPIN(xb_ld(&bar[XB_TOPGEN]) == tg, bar);
            __builtin_amdgcn_fence(__ATOMIC_ACQUIRE, "agent");
            xb_add(&bar[XB_XGEN(b.x)], 1u);
            asm volatile("s_waitcnt vmcnt(0)" ::: "memory");
        } else {
            XB_SPIN(xb_ld(&bar[XB_XGEN(b.x)]) == gen, bar);
            __builtin_amdgcn_fence(__ATOMIC_ACQUIRE, "agent");
            asm volatile("s_waitcnt vmcnt(0)" ::: "memory");
        }
    }
    __syncthreads();
}

struct Frame {
    LAS unsigned char* lds;
    volatile LAS unsigned* MISC;
    unsigned* ctl;
    int tid, lane, wave, G, gw, NGW;
    const float *x, *p, *rel_bias, *attn_g, *w_in, *b_gate, *q_g, *k_g, *w_att, *conv_w, *conv_b, *ln_g, *ln_b, *w_conv, *w_out, *ffn_g, *w_pq, *subk, *pu, *pv, *ple_g, *w_pg, *w_pp;
    float* out;
    float *ss1, *ss2, *rstd1, *rstd3, *tab, *mb, *WI;
    bf16 *KI, *Win_t, *Wa_t, *Wc_t, *Wout_t, *Wq_t, *Wg_t, *Wp_t, *SUBK, *EU, *EV, *PB;
    bf16 *XB, *ATT, *CV, *UB, *MIX, *PP, *Q, *K, *V, *QI, *GB, *QP;
    unsigned* bitmap;
};

namespace epi {
using pg8::f32x4; using pg8::u32x4; using pg8::Unit; using pg8::bf16_t;
__device__ __forceinline__ u32x4 pack8(const float* v) { u32x4 w; w.x = pk2(v[0], v[1]); w.y = pk2(v[2], v[3]); w.z = pk2(v[4], v[5]); w.w = pk2(v[6], v[7]); return w; }
__device__ __forceinline__ void unpack8(u32x4 w, float* v) { v[0] = bflo(w.x); v[1] = bfhi(w.x); v[2] = bflo(w.y); v[3] = bfhi(w.y); v[4] = bflo(w.z); v[5] = bfhi(w.z); v[6] = bflo(w.w); v[7] = bfhi(w.w); }

struct EpiInProj {
    static constexpr bool PERM = true, AFTER_DRAIN = false;
    const float* rstd; bf16_t *Q, *K, *V, *QI, *U, *G, *KI; float* WI; const float *qg, *kg, *bgate;
    __device__ __forceinline__ void operator()(const f32x4 (&acc)[2][2][4][2], const Unit& u, int wr, int wc, int fr, int fq) const {
        const int pn = u.pn, row0 = u.pm * 256 + wr * 64 + fr;
        if (pn < 4) {
            const bool isq = pn < 2; const float* g = isq ? qg : kg; bf16_t* O = isq ? Q : K; const float sc = isq ? C2 : 1.0f;
            const int head = (pn & 1) * 4 + wc;
            float gv[2][8];
#pragma unroll
            for (int bj = 0; bj < 2; ++bj)
#pragma unroll
                for (int j = 0; j < 8; ++j) gv[bj][j] = g[32 * bj + 8 * fq + j];
#pragma unroll
            for (int ai = 0; ai < 2; ++ai)
#pragma unroll
                for (int m = 0; m < 4; ++m) {
                    const int row = row0 + ai * 128 + m * 16; const float rs = rstd[row];
                    float v[2][8]; float ss = 0.f;
#pragma unroll
                    for (int bj = 0; bj < 2; ++bj)
#pragma unroll
                        for (int n = 0; n < 2; ++n)
#pragma unroll
                            for (int i = 0; i < 4; ++i) { const float xv = acc[ai][bj][m][n][i] * rs; v[bj][4 * n + i] = xv; ss += xv * xv; }
                    ss = xor32_sum(xor16_sum(ss));
                    const float inv = rsqrtf(ss * (1.0f / 64.0f) + EPS) * sc;
#pragma unroll
                    for (int bj = 0; bj < 2; ++bj) { float o[8];
#pragma unroll
                        for (int j = 0; j < 8; ++j) o[j] = v[bj][j] * inv * gv[bj][j];
                        *(u32x4*)(O + (size_t)row * AW + head * 64 + 32 * bj + 8 * fq) = pack8(o); }
                }
        } else if (pn < 8) {
            bf16_t* O = pn < 6 ? V : QI; const int cb = (pn & 1) * 256 + 32 * wc + 8 * fq;
#pragma unroll
            for (int ai = 0; ai < 2; ++ai)
#pragma unroll
                for (int m = 0; m < 4; ++m) {
                    const int row = row0 + ai * 128 + m * 16; const float rs = rstd[row];
#pragma unroll
                    for (int bj = 0; bj < 2; ++bj) { float o[8];
#pragma unroll
                        for (int n = 0; n < 2; ++n)
#pragma unroll
                            for (int i = 0; i < 4; ++i) o[4 * n + i] = acc[ai][bj][m][n][i] * rs;
                        *(u32x4*)(O + (size_t)row * AW + cb + 128 * bj) = pack8(o); }
                }
        } else if (pn < 12) {
            const int ch0 = (pn - 8) * 128 + 32 * wc + 8 * fq;
#pragma unroll
            for (int ai = 0; ai < 2; ++ai)
#pragma unroll
                for (int m = 0; m < 4; ++m) {
                    const int row = row0 + ai * 128 + m * 16; const float rs = rstd[row]; float o[8];
#pragma unroll
                    for (int n = 0; n < 2; ++n)
#pragma unroll
                        for (int i = 0; i < 4; ++i) { const float a = acc[ai][0][m][n][i] * rs, gg = acc[ai][1][m][n][i] * rs; o[4 * n + i] = a * sigmoidf_(gg); }
                    *(u32x4*)(U + (size_t)row * 512 + ch0) = pack8(o);
                }
        } else if (pn < 20) {
            const int cb = (pn - 12) * 256 + 32 * wc + 8 * fq;
            float bv[2][8];
#pragma unroll
            for (int bj = 0; bj < 2; ++bj)
#pragma unroll
                for (int j = 0; j < 8; ++j) bv[bj][j] = bgate[cb + 128 * bj + j];
#pragma unroll
            for (int ai = 0; ai < 2; ++ai)
#pragma unroll
                for (int m = 0; m < 4; ++m) {
                    const int row = row0 + ai * 128 + m * 16; const float rs = rstd[row];
#pragma unroll
                    for (int bj = 0; bj < 2; ++bj) { float o[8];
#pragma unroll
                        for (int n = 0; n < 2; ++n)
#pragma unroll
                            for (int i = 0; i < 4; ++i) o[4 * n + i] = sigmoid255(acc[ai][bj][m][n][i] * rs + bv[bj][4 * n + i]);
                        unsigned w0 = 0u, w1 = 0u;
#pragma unroll
                        for (int i = 0; i < 4; ++i) { w0 = __builtin_amdgcn_cvt_pk_u8_f32(fmaxf(o[i], 1.0f), i, w0); w1 = __builtin_amdgcn_cvt_pk_u8_f32(fmaxf(o[4 + i], 1.0f), i, w1); }
                        *(v2u*)((unsigned char*)G + (size_t)row * 2048 + cb + 128 * bj) = (v2u){w0, w1}; }
                }
        } else {
#pragma unroll
            for (int ai = 0; ai < 2; ++ai)
#pragma unroll
                for (int m = 0; m < 4; ++m) {
                    const int row = row0 + ai * 128 + m * 16; const float rs = rstd[row]; float o[8];
#pragma unroll
                    for (int n = 0; n < 2; ++n)
#pragma unroll
                        for (int i = 0; i < 4; ++i) o[4 * n + i] = acc[ai][0][m][n][i] * rs;
                    if (wc < 2) *(u32x4*)(KI + (size_t)row * 64 + 32 * wc + 8 * fq) = pack8(o);
                    else if (wc == 2 && fq == 0) {
                        *(f32x4*)(WI + (size_t)row * 8) = (f32x4){o[0] * IDX_SCALE, o[1] * IDX_SCALE, o[2] * IDX_SCALE, o[3] * IDX_SCALE};
                        *(f32x4*)(WI + (size_t)row * 8 + 4) = (f32x4){o[4] * IDX_SCALE, o[5] * IDX_SCALE, o[6] * IDX_SCALE, o[7] * IDX_SCALE}; }
                }
        }
    }
};
template <bool ADD> struct EpiGate {
    static constexpr bool PERM = true, AFTER_DRAIN = false;
    const bf16_t* G; int goff; bf16_t* O;
    __device__ __forceinline__ void operator()(const f32x4 (&acc)[2][2][4][2], const Unit& u, int wr, int wc, int fr, int fq) const {
        const int row0 = u.pm * 256 + wr * 64 + fr, col0 = u.pn * 256 + 32 * wc + 8 * fq;
#pragma unroll
        for (int ai = 0; ai < 2; ++ai)
#pragma unroll
            for (int m = 0; m < 4; ++m) { const int row = row0 + ai * 128 + m * 16;
#pragma unroll
                for (int bj = 0; bj < 2; ++bj) { const int col = col0 + 128 * bj; float gt[8], pv[8], o[8];
                    { const v2u gw = *(const v2u*)((const unsigned char*)G + (size_t)row * 2048 + goff + col);
#pragma unroll
                      for (int i = 0; i < 4; ++i) { gt[i] = (float)((gw.x >> (8 * i)) & 0xffu) * (1.0f / 255.0f); gt[4 + i] = (float)((gw.y >> (8 * i)) & 0xffu) * (1.0f / 255.0f); } }
                    if (ADD) unpack8(*(const u32x4*)(O + (size_t)row * D + col), pv);
#pragma unroll
                    for (int n = 0; n < 2; ++n)
#pragma unroll
                        for (int i = 0; i < 4; ++i) o[4 * n + i] = (ADD ? pv[4 * n + i] : 0.f) + gt[4 * n + i] * acc[ai][bj][m][n][i];
                    *(u32x4*)(O + (size_t)row * D + col) = pack8(o); } }
    }
};
struct EpiGate2 {
    static constexpr bool PERM = true, AFTER_DRAIN = false;
    const unsigned char* G; bf16_t* O;
    __device__ __forceinline__ void mid(f32x4 (&acc)[2][2][4][2], const Unit& u, int wr, int wc, int fr, int fq) const {
        const int row0 = u.pm * 256 + wr * 64 + fr, col0 = u.pn * 256 + 32 * wc + 8 * fq;
#pragma unroll
        for (int ai = 0; ai < 2; ++ai)
#pragma unroll
            for (int m = 0; m < 4; ++m) { const int row = row0 + ai * 128 + m * 16;
#pragma unroll
                for (int bj = 0; bj < 2; ++bj) { const int col = col0 + 128 * bj;
                    const v2u a = *(const v2u*)(G + (size_t)row * 2048 + col), b = *(const v2u*)(G + (size_t)row * 2048 + 1024 + col);
#pragma unroll
                    for (int i = 0; i < 4; ++i) {
                        acc[ai][bj][m][0][i] *= (float)((a.x >> (8 * i)) & 0xffu) * __builtin_amdgcn_rcpf((float)((b.x >> (8 * i)) & 0xffu));
                        acc[ai][bj][m][1][i] *= (float)((a.y >> (8 * i)) & 0xffu) * __builtin_amdgcn_rcpf((float)((b.y >> (8 * i)) & 0xffu)); } } }
    }
    __device__ __forceinline__ void operator()(const f32x4 (&acc)[2][2][4][2], const Unit& u, int wr, int wc, int fr, int fq) const {
        const int row0 = u.pm * 256 + wr * 64 + fr, col0 = u.pn * 256 + 32 * wc + 8 * fq;
#pragma unroll
        for (int ai = 0; ai < 2; ++ai)
#pragma unroll
            for (int m = 0; m < 4; ++m) { const int row = row0 + ai * 128 + m * 16;
#pragma unroll
                for (int bj = 0; bj < 2; ++bj) { const int col = col0 + 128 * bj; float o[8];
                    const v2u b = *(const v2u*)(G + (size_t)row * 2048 + 1024 + col);
#pragma unroll
                    for (int i = 0; i < 4; ++i) { o[i] = (float)((b.x >> (8 * i)) & 0xffu) * (1.0f / 255.0f) * acc[ai][bj][m][0][i]; o[4 + i] = (float)((b.y >> (8 * i)) & 0xffu) * (1.0f / 255.0f) * acc[ai][bj][m][1][i]; }
                    *(u32x4*)(O + (size_t)row * D + col) = pack8(o); } }
    }
};
struct EpiRes1 {
    static constexpr bool PERM = true, AFTER_DRAIN = false;
    const float* x; float* out; bf16_t* xb; float* ss;
    __device__ __forceinline__ void operator()(const f32x4 (&acc)[2][2][4][2], const Unit& u, int wr, int wc, int fr, int fq) const {
        const int row0 = u.pm * 256 + wr * 64 + fr, col0 = u.pn * 256 + 32 * wc + 8 * fq;
#pragma unroll
        for (int ai = 0; ai < 2; ++ai)
#pragma unroll
            for (int m = 0; m < 4; ++m) { const int row = row0 + ai * 128 + m * 16; float s = 0.f;
#pragma unroll
                for (int bj = 0; bj < 2; ++bj) { const size_t off = (size_t)row * D + col0 + 128 * bj;
                    float xv[8]; unpack8(*(const u32x4*)(xb + off), xv);
                    const f32x4 a = (f32x4){xv[0], xv[1], xv[2], xv[3]} + acc[ai][bj][m][0], b = (f32x4){xv[4], xv[5], xv[6], xv[7]} + acc[ai][bj][m][1];
                    u32x4 w; w.x = pk2(a[0], a[1]); w.y = pk2(a[2], a[3]); w.z = pk2(b[0], b[1]); w.w = pk2(b[2], b[3]); *(u32x4*)(xb + off) = w;
                    s += (a[0] * a[0] + a[1] * a[1]) + (a[2] * a[2] + a[3] * a[3]) + (b[0] * b[0] + b[1] * b[1]) + (b[2] * b[2] + b[3] * b[3]); }
                s = xor32_sum(xor16_sum(s));
                if (fq == 0) atomicAdd(ss + row, s); }
    }
};
struct EpiScaleRow {
    static constexpr bool PERM = true, AFTER_DRAIN = false;
    const float* ss; bf16_t* O; int ldc;
    __device__ __forceinline__ void operator()(const f32x4 (&acc)[2][2][4][2], const Unit& u, int wr, int wc, int fr, int fq) const {
        const int row0 = u.pm * 256 + wr * 64 + fr, col0 = u.pn * 256 + 32 * wc + 8 * fq;
#pragma unroll
        for (int ai = 0; ai < 2; ++ai)
#pragma unroll
            for (int m = 0; m < 4; ++m) { const int row = row0 + ai * 128 + m * 16; const float rs = rsqrtf(ss[row] * (1.0f / 1024.0f) + EPS);
#pragma unroll
                for (int bj = 0; bj < 2; ++bj) { float o[8];
#pragma unroll
                    for (int n = 0; n < 2; ++n)
#pragma unroll
                        for (int i = 0; i < 4; ++i) o[4 * n + i] = acc[ai][bj][m][n][i] * rs;
                    *(u32x4*)(O + (size_t)row * ldc + col0 + 128 * bj) = pack8(o); } }
    }
};
struct EpiPlain {
    static constexpr bool PERM = true, AFTER_DRAIN = false;
    bf16_t* O; int ldc;
    __device__ __forceinline__ void operator()(const f32x4 (&acc)[2][2][4][2], const Unit& u, int wr, int wc, int fr, int fq) const {
        const int row0 = u.pm * 256 + wr * 64 + fr, col0 = u.pn * 256 + 32 * wc + 8 * fq;
#pragma unroll
        for (int ai = 0; ai < 2; ++ai)
#pragma unroll
            for (int m = 0; m < 4; ++m) { const int row = row0 + ai * 128 + m * 16;
#pragma unroll
                for (int bj = 0; bj < 2; ++bj) { float o[8];
#pragma unroll
                    for (int n = 0; n < 2; ++n)
#pragma unroll
                        for (int i = 0; i < 4; ++i) o[4 * n + i] = acc[ai][bj][m][n][i];
                    *(u32x4*)(O + (size_t)row * ldc + col0 + 128 * bj) = pack8(o); } }
    }
};
struct EpiPle {
    static constexpr bool PERM = true, AFTER_DRAIN = false;
    const float* rstd; const bf16_t* pp; const bf16_t* xb; float* out;
    __device__ __forceinline__ void operator()(const f32x4 (&acc)[2][2][4][2], const Unit& u, int wr, int wc, int fr, int fq) const {
        const int row0 = u.pm * 256 + wr * 64 + fr, col0 = u.pn * 256 + 32 * wc + 8 * fq;
#pragma unroll
        for (int ai = 0; ai < 2; ++ai)
#pragma unroll
            for (int m = 0; m < 4; ++m) { const int row = row0 + ai * 128 + m * 16; const float rs = rsqrtf(rstd[row] * (1.0f / 1024.0f) + EPS);
#pragma unroll
                for (int bj = 0; bj < 2; ++bj) { const size_t off = (size_t)row * D + col0 + 128 * bj; float pv[8];
                    unpack8(*(const u32x4*)(pp + off), pv);
                    float xv[8]; unpack8(*(const u32x4*)(xb + off), xv);
                    f32x4 a = (f32x4){xv[0], xv[1], xv[2], xv[3]}, b = (f32x4){xv[4], xv[5], xv[6], xv[7]};
#pragma unroll
                    for (int i = 0; i < 4; ++i) { a[i] += sigmoidf_(acc[ai][bj][m][0][i] * rs) * pv[i]; b[i] += sigmoidf_(acc[ai][bj][m][1][i] * rs) * pv[4 + i]; }
                    *(f32x4*)(out + off) = a; *(f32x4*)(out + off + 4) = b; }
                asm volatile("" ::: "memory"); }
    }
};
}

__device__ __forceinline__ void tr_item(const float* W, int ldw, int K, int src_col0, int nvalid, bf16* WT, int dst_row0, const float* gain, LAS float* scr, int kb, int lane) {
    const int k0 = 64 * kb;
#pragma unroll
    for (int j = 0; j < 8; ++j) { const int kk = (lane >> 3) + 8 * j, c4 = (lane & 7) * 4; f32x4 v = (f32x4){0.f, 0.f, 0.f, 0.f};
        if (src_col0 >= 0 && c4 < nvalid) { v = *(const f32x4*)(W + (size_t)(k0 + kk) * ldw + src_col0 + c4); if (gain) v *= gain[k0 + kk]; }
        scr[kk * 33 + c4] = v[0]; scr[kk * 33 + c4 + 1] = v[1]; scr[kk * 33 + c4 + 2] = v[2]; scr[kk * 33 + c4 + 3] = v[3]; }
    LDS_WAIT(); asm volatile("" ::: "memory");
    const int c = lane & 7;
#pragma unroll
    for (int j = 0; j < 4; ++j) { const int n = (lane >> 3) + 8 * j; const LAS float* s = scr + (8 * c) * 33 + n;
        v4u o; o.x = pk2(s[0 * 33], s[1 * 33]); o.y = pk2(s[2 * 33], s[3 * 33]); o.z = pk2(s[4 * 33], s[5 * 33]); o.w = pk2(s[6 * 33], s[7 * 33]);
        *(v4u*)(WT + (size_t)(dst_row0 + n) * K + k0 + 8 * c) = o; }
    LDS_WAIT(); asm volatile("" ::: "memory");
}
__device__ __forceinline__ void win_src_col(int gidx, int& src, int& nvalid) {
    const int tile = gidx >> 3, gi = gidx & 7; nvalid = 32;
    if (tile < 2) src = (tile * 4 + (gi & 3)) * 64 + (gi >> 2) * 32;
    else if (tile < 4) src = 512 + ((tile - 2) * 4 + (gi & 3)) * 64 + (gi >> 2) * 32;
    else if (tile < 6) src = 1024 + (tile - 4) * 256 + gi * 32;
    else if (tile < 8) src = 1536 + (tile - 6) * 256 + gi * 32;
    else if (tile < 12) src = (gi < 4) ? 2120 + 128 * (tile - 8) + 32 * gi : 2632 + 128 * (tile - 8) + 32 * (gi - 4);
    else if (tile < 20) src = 3144 + (tile - 12) * 256 + 32 * gi;
    else { if (gi < 2) src = 2048 + 32 * gi; else if (gi == 2) { src = 2112; nvalid = 8; } else { src = -1; nvalid = 0; } }
}
__device__ __forceinline__ void cvt_bf16_stream(const float* src, bf16* dst, size_t n8, size_t start, size_t stride) {
    for (size_t i = start; i < n8; i += stride) { const f32x4 a = *(const f32x4*)(src + i * 8), b = *(const f32x4*)(src + i * 8 + 4);
        v4u o; o.x = pk2(a[0], a[1]); o.y = pk2(a[2], a[3]); o.z = pk2(b[0], b[1]); o.w = pk2(b[2], b[3]); *(v4u*)(dst + i * 8) = o; }
}
__device__ __forceinline__ void cvt_fp8_stream(const float* src, unsigned char* dst, size_t n16, size_t start, size_t stride, float scale) {
    for (size_t i = start; i < n16; i += stride) { v4u o;
#pragma unroll
        for (int j = 0; j < 4; ++j) { const f32x4 a = *(const f32x4*)(src + i * 16 + 4 * j) * scale; int pk = __builtin_amdgcn_cvt_pk_fp8_f32(a[0], a[1], 0, false); pk = __builtin_amdgcn_cvt_pk_fp8_f32(a[2], a[3], pk, true); o[j] = (unsigned)pk; }
        const size_t row = (i * 16) >> 10, col = (i * 16) & 1023;
        *(v4u*)(dst + ((col >> 7) * 16384 + row) * 128 + (col & 127)) = o; }
}
constexpr float EU_SCALE = 256.0f, EV_SCALE = 16.0f;
__device__ __forceinline__ int t5_bucket(int rel) {
    const int n = rel < 0 ? -rel : rel; int v;
    if (n < 8) v = n; else { v = 8 + (int)(logf((float)n / 8.0f) / logf(128.0f) * 8.0f); if (v > 15) v = 15; }
    return (rel > 0 ? 16 : 0) + v;
}
__device__ __forceinline__ void p0_prologue(Frame& F) {
    LAS float* scr = (LAS float*)(F.lds + RING_OFF + F.wave * 16384);
    const int gw = F.gw, NGW = F.NGW, lane = F.lane;
    constexpr int I_IN = 168 * 16, I_A = 32 * 8, I_C = 32 * 8, I_O = 32 * 16, I_Q = 64 * 16, I_G = 32 * 16, I_P = 32 * 4;
    constexpr int NITEMS = I_IN + I_A + I_C + I_O + I_Q + I_G + I_P;
    for (int it = gw; it < NITEMS; it += NGW) {
        int r = it;
        if (r < I_IN) { int src, nv; win_src_col(r / 16, src, nv); tr_item(F.w_in, 5192, D, src, nv, F.Win_t, (r / 16) * 32, F.attn_g, scr, r % 16, lane); continue; } r -= I_IN;
        if (r < I_A) { tr_item(F.w_att, D, 1024, (r / 8) * 32, 32, F.Wa_t, (r / 8) * 32, nullptr, scr, r % 8, lane); continue; } r -= I_A;
        if (r < I_C) { tr_item(F.w_conv, D, 1024, (r / 8) * 32, 32, F.Wa_t + 512, (r / 8) * 32, nullptr, scr, r % 8, lane);     continue; } r -= I_C;
        if (r < I_O) { tr_item(F.w_out, D, D, (r / 16) * 32, 32, F.Wout_t, (r / 16) * 32, nullptr, scr, r % 16, lane); continue; } r -= I_O;
        if (r < I_Q) { tr_item(F.w_pq, 2048, D, (r / 16) * 32, 32, F.Wq_t, (r / 16) * 32, F.ffn_g, scr, r % 16, lane); continue; } r -= I_Q;
        if (r < I_G) { tr_item(F.w_pg, D, D, (r / 16) * 32, 32, F.Wg_t, (r / 16) * 32, F.ple_g, scr, r % 16, lane); continue; } r -= I_G;
        tr_item(F.w_pp, D, PLE, (r / 4) * 32, 32, F.Wp_t, (r / 4) * 32, nullptr, scr, r % 4, lane);
    }
    const size_t gt = (size_t)blockIdx.x * (NWAVES * 64) + F.tid, GT = (size_t)F.G * NWAVES * 64;
    cvt_bf16_stream(F.subk, F.SUBK, (size_t)PEER_H * 2 * NKEYS * 128 / 8, gt, GT);
#ifdef NAIVE_P7
    cvt_bf16_stream(F.pu, F.EU, (size_t)16384 * D / 8, gt, GT);
    cvt_bf16_stream(F.pv, F.EV, (size_t)16384 * D / 8, gt, GT);
#else
    cvt_fp8_stream(F.pu, (unsigned char*)F.EU, (size_t)16384 * D / 16, gt, GT, EU_SCALE);
    cvt_fp8_stream(F.pv, (unsigned char*)F.EV, (size_t)16384 * D / 16, gt, GT, EV_SCALE);
#endif
    cvt_bf16_stream(F.p, F.PB, (size_t)M * PLE / 8, gt, GT);
    for (int m = gw; m < M; m += NGW) {
        const f32x4* xr = (const f32x4*)(F.x + (size_t)m * D) + lane; f32x4 v[4]; float s = 0.f;
#pragma unroll
        for (int j = 0; j < 4; ++j) { v[j] = xr[64 * j]; s += (v[j][0] * v[j][0] + v[j][1] * v[j][1]) + (v[j][2] * v[j][2] + v[j][3] * v[j][3]); }
        s = wave_sum(s);
        if (lane == 0) F.rstd1[m] = rsqrtf(s * (1.0f / D) + EPS);
        v2u* o8 = (v2u*)(F.XB + (size_t)m * D) + lane;
#pragma unroll
        for (int j = 0; j < 4; ++j) { v2u o; o.x = pk2(v[j][0], v[j][1]); o.y = pk2(v[j][2], v[j][3]); o8[64 * j] = o; }
    }
    if (blockIdx.x == 0 && F.wave == 0) { const float gq = wave_max(fabsf(F.q_g[lane])), gk = wave_max(fabsf(F.k_g[lane]));
        float bm = 0.f;
#pragma unroll
        for (int i = 0; i < 4; ++i) bm = fmaxf(bm, fabsf(F.rel_bias[lane + 64 * i]));
        bm = wave_max(bm);
        if (lane == 0) F.mb[0] = C2 * 64.0f * gq * gk + LOG2E * bm + 0.5f; }
    for (size_t i = gt; i < (size_t)NH * TABN; i += GT) { const int h = (int)(i / TABN), rel = (int)(i % TABN) - TABOFF; F.tab[i] = LOG2E * F.rel_bias[t5_bucket(rel) * NH + h]; }
}

__device__ __forceinline__ void p2_index_naive(Frame& F, float* scratch) {
    const int lane = F.lane;
    LAS unsigned* qi_l = (LAS unsigned*)(F.lds + F.wave * 1024);
    LAS unsigned* hist = (LAS unsigned*)(F.lds + 8192 + F.wave * 1024);
    float* scr = scratch + (size_t)F.gw * SEQ;
    const unsigned long long lt = __lanemask_lt();
    for (int t = F.gw; t < M; t += F.NGW) {
        const int b = t / SEQ, sq = t % SEQ, vis = (sq / 64 + 1) * 64, nst = vis / 64;
        unsigned* bm = F.bitmap + (size_t)t * 256;
        if (vis <= TOPK) { for (int wd = lane; wd < 256; wd += 64) bm[wd] = (wd * 32 < vis) ? 0xffffffffu : 0u; continue; }
        *(LAS v4u*)(qi_l + lane * 4) = *(const v4u*)(F.QI + (size_t)t * 512 + lane * 8);
        float w[8];
#pragma unroll
        for (int h = 0; h < 8; ++h) w[h] = F.WI[(size_t)t * 8 + h];
        LDS_WAIT();
        for (int st = 0; st < nst; ++st) {
            asm volatile("" ::: "memory");
            const int key = st * 64 + lane; const v4u* kr = (const v4u*)(F.KI + ((size_t)b * SEQ + key) * 64);
            v4u kk[8];
#pragma unroll
            for (int i = 0; i < 8; ++i) kk[i] = kr[i];
            float s = 0.f;
#pragma unroll
            for (int h = 0; h < 8; ++h) { float d = 0.f;
#pragma unroll
                for (int i = 0; i < 8; ++i) d = dot8(*(const LAS v4u*)(qi_l + h * 32 + i * 4), kk[i], d);
                s += w[h] * fmaxf(d, 0.f); }
            scr[key] = s;
        }
        unsigned prefix = 0u, remaining = TOPK;
        for (int pass = 0; pass < 4; ++pass) {
            const int shift = 24 - 8 * pass;
            *(LAS v4u*)(hist + lane * 4) = (v4u){0u, 0u, 0u, 0u};
            LDS_WAIT();
            for (int st = 0; st < nst; ++st) { const unsigned uu = sortable(scr[st * 64 + lane]);
                const bool ok = (pass == 0) || ((uu >> (shift + 8)) == prefix);
                if (ok) __hip_atomic_fetch_add(hist + ((uu >> shift) & 255u), 1u, __ATOMIC_RELAXED, __HIP_MEMORY_SCOPE_WORKGROUP); }
            LDS_WAIT();
            const v4u c = *(const LAS v4u*)(hist + lane * 4);
            const unsigned tot = c.x + c.y + c.z + c.w; unsigned incl = tot;
#pragma unroll
            for (int o = 1; o < 64; o <<= 1) { const unsigned v = __shfl_down(incl, o); incl += (lane + o < 64) ? v : 0u; }
            const unsigned excl = incl - tot;
            const bool mine = (excl < remaining) && (remaining <= incl);
            unsigned bsel = 0u, before = 0u;
            if (mine) { unsigned cum = excl;
                if (remaining <= cum + c.w) { bsel = 3u; before = cum; } else { cum += c.w;
                if (remaining <= cum + c.z) { bsel = 2u; before = cum; } else { cum += c.z;
                if (remaining <= cum + c.y) { bsel = 1u; before = cum; } else { cum += c.y; bsel = 0u; before = cum; } } }
                bsel += 4u * lane; }
            const unsigned long long mm = __ballot(mine);
            const int src = __ffsll((long long)mm) - 1;
            bsel = __shfl(bsel, src); before = __shfl(before, src);
            prefix = (prefix << 8) | bsel; remaining -= before;
            LDS_WAIT();
        }
        unsigned taken = 0u;
        for (int st = 0; st < nst; ++st) { const unsigned uu = sortable(scr[st * 64 + lane]);
            const bool gtb = uu > prefix, eq = uu == prefix; const unsigned long long meq = __ballot(eq);
            const unsigned rank = __popcll(meq & lt); const bool sel = gtb || (eq && (taken + rank < remaining)); taken += __popcll(meq);
            const unsigned long long ms = __ballot(sel);
            if (lane == 0) { bm[2 * st] = (unsigned)ms; bm[2 * st + 1] = (unsigned)(ms >> 32); } }
        for (int wd = 2 * nst + lane; wd < 256; wd += 64) bm[wd] = 0u;
    }
}
__device__ __forceinline__ void p2_conv_naive(Frame& F) {
    const int lane = F.lane, c0 = 8 * lane;
    for (int t = F.gw; t < M; t += F.NGW) {
        const int sq = t % SEQ; float y[8];
#pragma unroll
        for (int i = 0; i < 8; ++i) y[i] = F.conv_b[c0 + i];
        for (int j = 0; j < CONVW; ++j) { const int sp = sq - (CONVW - 1) + j; if (sp < 0) continue;
            float uv[8]; epi::unpack8(*(const v4u*)(F.UB + (size_t)(t - (CONVW - 1) + j) * 512 + c0), uv);
            const f32x4 w0 = *(const f32x4*)(F.conv_w + j * 512 + c0), w1 = *(const f32x4*)(F.conv_w + j * 512 + c0 + 4);
#pragma unroll
            for (int i = 0; i < 4; ++i) { y[i] += uv[i] * w0[i]; y[4 + i] += uv[4 + i] * w1[i]; } }
        float s = 0.f;
#pragma unroll
        for (int i = 0; i < 8; ++i) s += y[i];
        const float mean = wave_sum(s) * (1.0f / 512.0f); float q = 0.f;
#pragma unroll
        for (int i = 0; i < 8; ++i) { y[i] -= mean; q += y[i] * y[i]; }
        const float rstd = rsqrtf(wave_sum(q) * (1.0f / 512.0f) + EPS); float o[8];
#pragma unroll
        for (int i = 0; i < 8; ++i) { const float z = y[i] * rstd * F.ln_g[c0 + i] + F.ln_b[c0 + i]; o[i] = z * sigmoidf_(z); }
        *(v4u*)(F.CV + (size_t)t * 512 + c0) = epi::pack8(o);
    }
}
__device__ __forceinline__ void p3_attn_naive(Frame& F) {
    const int lane = F.lane;
    LAS int* sel = (LAS int*)(F.lds + F.wave * 2048);
    LAS float* pl = (LAS float*)(F.lds + F.wave * 2048 + 1024);
    const unsigned long long lt = __lanemask_lt();
    for (int t = F.gw; t < M; t += F.NGW) {
        const int b = t / SEQ, sq = t % SEQ, vis = (sq / 64 + 1) * 64, nst = vis / 64;
        const unsigned* bm = F.bitmap + (size_t)t * 256; int nsel = 0;
        for (int st = 0; st < nst; ++st) { const unsigned long long m = (unsigned long long)bm[2 * st] | ((unsigned long long)bm[2 * st + 1] << 32);
            const int pos = nsel + __popcll(m & lt); if (((m >> lane) & 1ull) && pos < TOPK) sel[pos] = st * 64 + lane;
            nsel += __popcll(m); nsel = nsel > TOPK ? TOPK : nsel; }
        LDS_WAIT();
        for (int h = 0; h < NH; ++h) {
            v4u qq[8]; const v4u* qr = (const v4u*)(F.Q + (size_t)t * AW + h * 64);
#pragma unroll
            for (int i = 0; i < 8; ++i) qq[i] = qr[i];
            float lg[4]; float mx = -INFINITY;
#pragma unroll
            for (int j = 0; j < 4; ++j) { const int idx = lane + 64 * j; lg[j] = -INFINITY;
                if (idx < nsel) { const int key = sel[idx]; const v4u* kr = (const v4u*)(F.K + ((size_t)b * SEQ + key) * AW + h * 64); float d = 0.f;
#pragma unroll
                    for (int i = 0; i < 8; ++i) d = dot8(qq[i], kr[i], d);
                    int ti = key - sq + TABOFF; ti = ti < 0 ? 0 : ti; d += F.tab[h * TABN + ti]; lg[j] = d; mx = fmaxf(mx, d); } }
            mx = wave_max(mx); float sm = 0.f;
#pragma unroll
            for (int j = 0; j < 4; ++j) { const int idx = lane + 64 * j; if (idx < nsel) { const float pj = exp2f(lg[j] - mx); sm += pj; pl[idx] = pj; } }
            sm = wave_sum(sm); LDS_WAIT();
            float o = 0.f; const bf16* vb = F.V + (size_t)b * SEQ * AW + h * 64 + lane;
            for (int j = 0; j < nsel; ++j) o += pl[j] * bf1(vb[(size_t)sel[j] * AW]);
            F.ATT[(size_t)t * AW + h * 64 + lane] = (bf16)f2bf(o / sm);
            LDS_WAIT();
        }
    }
}
__device__ __forceinline__ void p7_peer_naive(Frame& F) {
    const int lane = F.lane;
    LAS int* EI = (LAS int*)(F.lds + F.wave * 2048);
    LAS float* GT = (LAS float*)(F.lds + F.wave * 2048 + 512);
    LAS float* sv = (LAS float*)(F.lds + F.wave * 2048 + 1024);
    LAS int* si = (LAS int*)(F.lds + F.wave * 2048 + 1024 + 128);
    LAS float* ts = (LAS float*)(F.lds + F.wave * 2048 + 1024 + 256);
    for (int t = F.gw; t < M; t += F.NGW) {
        for (int h = 0; h < PEER_H; ++h) {
            for (int c = 0; c < 2; ++c) {
                v4u qv[16]; const v4u* qr = (const v4u*)(F.QP + (size_t)t * 2048 + h * 256 + c * 128);
#pragma unroll
                for (int i = 0; i < 16; ++i) qv[i] = qr[i];
                float s[2];
#pragma unroll
                for (int kk = 0; kk < 2; ++kk) { const v4u* kr = (const v4u*)(F.SUBK + ((size_t)(h * 2 + c) * NKEYS + lane + 64 * kk) * 128); float d = 0.f;
#pragma unroll
                    for (int i = 0; i < 16; ++i) d = dot8(qv[i], kr[i], d);
                    s[kk] = d; }
                unsigned long long k0 = ((unsigned long long)sortable(s[0]) << 32) | (0xffffffffu - (unsigned)lane), k1 = ((unsigned long long)sortable(s[1]) << 32) | (0xffffffffu - (unsigned)(lane + 64));
                for (int r = 0; r < PTOPK; ++r) {
                    const unsigned long long best = wave_max_u64(k0 > k1 ? k0 : k1);
                    const int bi = (int)(0xffffffffu - (unsigned)best);
                    if (k0 == best) { sv[c * 16 + r] = s[0]; si[c * 16 + r] = bi; k0 = 0ull; }
                    if (k1 == best) { sv[c * 16 + r] = s[1]; si[c * 16 + r] = bi; k1 = 0ull; }
                }
            }
            LDS_WAIT();
            unsigned long long ck[4]; float cs[4];
#pragma unroll
            for (int jj = 0; jj < 4; ++jj) { const int n = lane + 64 * jj; cs[jj] = sv[n >> 4] + sv[16 + (n & 15)]; ck[jj] = ((unsigned long long)sortable(cs[jj]) << 32) | (0xffffffffu - (unsigned)n); }
            for (int r = 0; r < PTOPK; ++r) {
                unsigned long long loc = ck[0] > ck[1] ? ck[0] : ck[1]; const unsigned long long loc2 = ck[2] > ck[3] ? ck[2] : ck[3]; loc = loc > loc2 ? loc : loc2;
                const unsigned long long best = wave_max_u64(loc);
                const int n = (int)(0xffffffffu - (unsigned)best);
#pragma unroll
                for (int jj = 0; jj < 4; ++jj) if (ck[jj] == best) { ts[r] = cs[jj]; EI[h * 16 + r] = si[n >> 4] * NKEYS + si[16 + (n & 15)]; ck[jj] = 0ull; }
            }
            LDS_WAIT();
            { const float t0 = ts[0]; float e = (lane < 16) ? __expf(ts[lane & 15] - t0) : 0.f; const float sum = wave_sum(e); if (lane < 16) GT[h * 16 + lane] = e / sum; }
            LDS_WAIT();
        }
        const float rs2 = rsqrtf(F.ss1[t] * (1.0f / D) + EPS);
        f32x4 x1[4]; float hx[16], oa[16];
#pragma unroll
        for (int j = 0; j < 4; ++j) { x1[j] = *((const f32x4*)(F.out + (size_t)t * D) + lane + 64 * j); const f32x4 g = *((const f32x4*)F.ffn_g + lane + 64 * j);
#pragma unroll
            for (int i = 0; i < 4; ++i) { hx[4 * j + i] = x1[j][i] * rs2 * g[i]; oa[4 * j + i] = 0.f; } }
        for (int n = 0; n < PEER_H * PTOPK; ++n) {
            const int e = EI[n]; const float g = GT[n];
            const v2u* ur = (const v2u*)(F.EU + (size_t)e * D) + lane; const v2u* vr = (const v2u*)(F.EV + (size_t)e * D) + lane; float d = 0.f; v2u vv[4];
#pragma unroll
            for (int j = 0; j < 4; ++j) { const v2u uu = ur[64 * j]; vv[j] = vr[64 * j];
                d += bflo(uu.x) * hx[4 * j] + bfhi(uu.x) * hx[4 * j + 1] + bflo(uu.y) * hx[4 * j + 2] + bfhi(uu.y) * hx[4 * j + 3]; }
            d = wave_sum(d); const float a = gelu_tanh(d) * g;
#pragma unroll
            for (int j = 0; j < 4; ++j) { oa[4 * j] += a * bflo(vv[j].x); oa[4 * j + 1] += a * bfhi(vv[j].x); oa[4 * j + 2] += a * bflo(vv[j].y); oa[4 * j + 3] += a * bfhi(vv[j].y); }
        }
        float s = 0.f;
#pragma unroll
        for (int j = 0; j < 4; ++j) { f32x4 o;
#pragma unroll
            for (int i = 0; i < 4; ++i) { o[i] = x1[j][i] + oa[4 * j + i]; s += o[i] * o[i]; }
            *((f32x4*)(F.out + (size_t)t * D) + lane + 64 * j) = o;
            v2u w; w.x = pk2(o[0], o[1]); w.y = pk2(o[2], o[3]); *((v2u*)(F.XB + (size_t)t * D) + lane + 64 * j) = w; }
        s = wave_sum(s); if (lane == 0) F.rstd3[t] = rsqrtf(s * (1.0f / D) + EPS);
        LDS_WAIT();
    }
}


__device__ __forceinline__ void p2_conv(Frame& F) {
    const int tid = F.tid, lane = F.lane, wave = F.wave;
    LAS bf16* UT = (LAS bf16*)(F.lds + RING_OFF);
    LAS float* YT = (LAS float*)(F.lds + RING_OFF + 63488);
    float w[CONVW];
#pragma unroll
    for (int j = 0; j < CONVW; ++j) w[j] = F.conv_w[j * 512 + tid];
    const float cb = F.conv_b[tid];
    for (int tile = blockIdx.x; tile < M / 32; tile += F.G) {
        const int t0 = tile * 32, s0 = t0 % SEQ;
        __syncthreads();
#pragma unroll
        for (int i = 0; i < 8; ++i) { const int p = tid + 512 * i, row = p >> 6, c16 = p & 63;
            if (row < 62) { v4u v = (v4u){0u, 0u, 0u, 0u}; if (s0 - 30 + row >= 0) v = *(const v4u*)(F.UB + (size_t)(t0 - 30 + row) * 512 + c16 * 8); *(LAS v4u*)(UT + row * 512 + c16 * 8) = v; } }
        __syncthreads();
        { float u[62];
#pragma unroll
          for (int k = 0; k < 62; ++k) u[k] = bf1(UT[k * 512 + tid]);
#pragma unroll
          for (int o = 0; o < 32; ++o) { float y0 = cb, y1 = 0.f;
#pragma unroll
              for (int j = 0; j < CONVW - 1; j += 2) { y0 += w[j] * u[o + j]; y1 += w[j + 1] * u[o + j + 1]; }
              y0 += w[CONVW - 1] * u[o + CONVW - 1];
              YT[o * 512 + tid] = y0 + y1; } }
        __syncthreads();
#pragma unroll
        for (int i = 0; i < 4; ++i) { const int tk = wave * 4 + i; const f32x4 a = *(const LAS f32x4*)(YT + tk * 512 + 8 * lane), b = *(const LAS f32x4*)(YT + tk * 512 + 8 * lane + 4);
            float y[8] = {a[0], a[1], a[2], a[3], b[0], b[1], b[2], b[3]}; float s = 0.f;
#pragma unroll
            for (int e = 0; e < 8; ++e) s += y[e];
            const float mean = wave_sum(s) * (1.0f / 512.0f); float q = 0.f;
#pragma unroll
            for (int e = 0; e < 8; ++e) { y[e] -= mean; q += y[e] * y[e]; }
            const float rstd = rsqrtf(wave_sum(q) * (1.0f / 512.0f) + EPS); float o[8];
            const f32x4 g0 = *(const f32x4*)(F.ln_g + 8 * lane), g1 = *(const f32x4*)(F.ln_g + 8 * lane + 4), b0 = *(const f32x4*)(F.ln_b + 8 * lane), b1 = *(const f32x4*)(F.ln_b + 8 * lane + 4);
#pragma unroll
            for (int e = 0; e < 8; ++e) { const float z = y[e] * rstd * (e < 4 ? g0[e & 3] : g1[e & 3]) + (e < 4 ? b0[e & 3] : b1[e & 3]); o[e] = z * sigmoidf_(z); }
            *(v4u*)(F.ATT + (size_t)(t0 + tk) * 1024 + 512 + 8 * lane) = epi::pack8(o); }
    }
}
typedef short bf16x8_t __attribute__((ext_vector_type(8)));
typedef short s16x2 __attribute__((ext_vector_type(2)));
typedef unsigned short u16x2 __attribute__((ext_vector_type(2)));
constexpr int KT_BYTES = 512 * 128;
constexpr unsigned SC_INVALID = 0x80008000u;
__device__ __forceinline__ unsigned score_key16(float f) { const _Float16 hv = (_Float16)f; const unsigned short b = __builtin_bit_cast(unsigned short, hv); return (unsigned)(unsigned short)(b ^ (unsigned short)(((short)b >> 15) & 0x7FFF)); }
__device__ __forceinline__ unsigned pk_lt_count(unsigned acc, unsigned v, unsigned cpk) {
    const s16x2 d = __builtin_elementwise_sub_sat(__builtin_bit_cast(s16x2, v), __builtin_bit_cast(s16x2, cpk));
    const u16x2 m = __builtin_bit_cast(u16x2, d) >> (u16x2){15, 15};
    return __builtin_bit_cast(unsigned, (u16x2)(__builtin_bit_cast(u16x2, acc) + m));
}
__device__ __forceinline__ unsigned pk_ne_count(unsigned acc, unsigned v, unsigned cpk) {
    const u16x2 e = __builtin_elementwise_min(__builtin_bit_cast(u16x2, v ^ cpk), (u16x2){1, 1});
    return __builtin_bit_cast(unsigned, (u16x2)(__builtin_bit_cast(u16x2, acc) + e));
}
__device__ __forceinline__ int half_sum_i(int v) {
    v += __builtin_amdgcn_update_dpp(0, v, 0xB1, 0xF, 0xF, false); v += __builtin_amdgcn_update_dpp(0, v, 0x4E, 0xF, 0xF, false);
    v += __builtin_amdgcn_update_dpp(0, v, 0x141, 0xF, 0xF, false); v += __builtin_amdgcn_update_dpp(0, v, 0x140, 0xF, 0xF, false);
    const auto sw = __builtin_amdgcn_permlane16_swap((unsigned)v, (unsigned)v, false, false); return (int)(sw[0] + sw[1]); }
#define P2_WRITELANE2(WA, WB, VA, VB, LN) asm volatile("s_nop 1\n\tv_writelane_b32 %0, %2, %4\n\tv_writelane_b32 %1, %3, %4" : "+v"(WA), "+v"(WB) : "s"(VA), "s"(VB), "n"(LN))
__device__ __forceinline__ void p2_index(Frame& F) {
    const int lane = F.lane, wave = F.wave, tid = F.tid, B = (int)blockIdx.x;
    LAS unsigned char* KT = F.lds + RING_OFF;
    for (int it = 0;; ++it) {
        const int L = it * F.G + B; if (L >= M / 16) break;
        const int b = L / 512, r512 = L % 512, j = (r512 < 256) ? r512 : 767 - r512;
        const int q0 = 16 * j, vis = (q0 / 64 + 1) * 64;
        const size_t row0 = (size_t)b * SEQ;
        unsigned* bm0 = F.bitmap + (row0 + q0 + 2 * wave) * 256; unsigned* bm1 = bm0 + 256;
        if (vis <= TOPK) {
#pragma unroll
            for (int g = 0; g < 4; ++g) { const unsigned w = ((64 * g + lane) * 32 < vis) ? 0xffffffffu : 0u; bm0[64 * g + lane] = w; bm1[64 * g + lane] = w; }
            continue;
        }
        bf16x8_t af[2];
        { const int rw = lane & 15, tq = rw >> 3, hh = rw & 7; const bf16* qp = F.QI + (row0 + q0 + 2 * wave + tq) * 512 + hh * 64 + 8 * (lane >> 4);
          const float wrow = F.WI[(row0 + q0 + 2 * wave + tq) * 8 + hh];
          v4u a0 = *(const v4u*)qp, a1 = *(const v4u*)(qp + 32);
#pragma unroll
          for (int i = 0; i < 4; ++i) { a0[i] = pk2(bflo(a0[i]) * wrow, bfhi(a0[i]) * wrow); a1[i] = pk2(bflo(a1[i]) * wrow, bfhi(a1[i]) * wrow); }
          af[0] = __builtin_bit_cast(bf16x8_t, a0); af[1] = __builtin_bit_cast(bf16x8_t, a1); }
        const f32x4 w4 = *(const f32x4*)(F.WI + (row0 + q0 + 2 * wave + (lane >> 5)) * 8 + ((lane >> 4) & 1) * 4);
        float clo[4], chi[4];
#pragma unroll
        for (int i = 0; i < 4; ++i) { clo[i] = (w4[i] >= 0.f) ? 0.f : -INFINITY; chi[i] = (w4[i] >= 0.f) ? INFINITY : 0.f; }
        typedef unsigned u32x16_t __attribute__((ext_vector_type(16)));
        u32x16_t scv[8];
#pragma unroll
        for (int i = 0; i < 8; ++i)
#pragma unroll
            for (int j = 0; j < 16; ++j) scv[i][j] = SC_INVALID;
        const int nt2 = (vis + 511) / 512;
        const int srow = 64 * wave + (lane >> 3), schunk = (lane & 7) ^ (lane >> 3);
        const bf16* gsrc = F.KI + (row0 + srow) * 64 + schunk * 8;
#define P2_STAGE(BUF, TILEBASE) do { _Pragma("unroll") for (int i_ = 0; i_ < 8; ++i_) \
            __builtin_amdgcn_global_load_lds((const unsigned*)(gsrc + (size_t)(TILEBASE) * 64 + i_ * 512), (LAS unsigned*)((BUF) + wave * 8192 + i_ * 1024), 16, 0, 0); } while (0)
        __syncthreads();
        P2_STAGE(KT, 0);
        VM_WAIT(); __syncthreads();
        const int brow = lane & 15, q4 = lane >> 4;
        const int fo0 = brow * 128 + ((q4 ^ (brow & 7)) << 4), fo1 = brow * 128 + (((4 + q4) ^ (brow & 7)) << 4);
#define P2_LOADF(DST, BUF, R) do { const unsigned a0_ = (unsigned)(uintptr_t)((BUF) + 4 * (R) * 2048 + fo0), a1_ = (unsigned)(uintptr_t)((BUF) + 4 * (R) * 2048 + fo1); \
            asm volatile("ds_read_b128 %0, %8\n\tds_read_b128 %1, %9\n\tds_read_b128 %2, %8 offset:2048\n\tds_read_b128 %3, %9 offset:2048\n\tds_read_b128 %4, %8 offset:4096\n\tds_read_b128 %5, %9 offset:4096\n\tds_read_b128 %6, %8 offset:6144\n\tds_read_b128 %7, %9 offset:6144" \
                : "=&v"(DST[0][0]), "=&v"(DST[0][1]), "=&v"(DST[1][0]), "=&v"(DST[1][1]), "=&v"(DST[2][0]), "=&v"(DST[2][1]), "=&v"(DST[3][0]), "=&v"(DST[3][1]) : "v"(a0_), "v"(a1_)); } while (0)
#define P2_WAITF(FR, N) asm volatile("s_waitcnt lgkmcnt(" #N ")" : "+v"(FR[0][0]), "+v"(FR[0][1]), "+v"(FR[1][0]), "+v"(FR[1][1]), "+v"(FR[2][0]), "+v"(FR[2][1]), "+v"(FR[3][0]), "+v"(FR[3][1]))
        for (int T = 0; T < nt2; ++T) {
            const int base = 512 * T;
            LAS unsigned char* buf = KT + (T & 1) * KT_BYTES; LAS unsigned char* nbuf = KT + ((T + 1) & 1) * KT_BYTES;
            if (T + 1 < nt2) P2_STAGE(nbuf, base + 512);
            bf16x8_t fA[4][2], fB[4][2];
#ifndef P2_SCREP
#define P2_SCREP 1
#endif
            for (int srep_ = 0; srep_ < P2_SCREP; ++srep_) {
            P2_LOADF(fA, buf, 0);
            f32x4 accA[4], accB[4];
#define P2_MMA(ACC, FR) do { _Pragma("unroll") for (int kb_ = 0; kb_ < 4; ++kb_) ACC[kb_] = __builtin_amdgcn_mfma_f32_16x16x32_bf16(af[0], FR[kb_][0], (f32x4){0.f, 0.f, 0.f, 0.f}, 0, 0, 0); \
                              _Pragma("unroll") for (int kb_ = 0; kb_ < 4; ++kb_) ACC[kb_] = __builtin_amdgcn_mfma_f32_16x16x32_bf16(af[1], FR[kb_][1], ACC[kb_], 0, 0, 0); } while (0)
#define P2_ADDF(A, B) ({ float r_; asm("v_add_f32 %0, %1, %2" : "=v"(r_) : "v"(A), "v"(B)); r_; })
#define P2_FIN(ACC, R) do { float ps_[4]; \
                _Pragma("unroll") for (int kb_ = 0; kb_ < 4; ++kb_) ps_[kb_] = P2_ADDF(P2_ADDF(__builtin_amdgcn_fmed3f(ACC[kb_][0], clo[0], chi[0]), __builtin_amdgcn_fmed3f(ACC[kb_][1], clo[1], chi[1])), P2_ADDF(__builtin_amdgcn_fmed3f(ACC[kb_][2], clo[2], chi[2]), __builtin_amdgcn_fmed3f(ACC[kb_][3], clo[3], chi[3]))); \
                const auto swa_ = __builtin_amdgcn_permlane16_swap(__float_as_uint(ps_[0]), __float_as_uint(ps_[1]), false, false); \
                const auto swb_ = __builtin_amdgcn_permlane16_swap(__float_as_uint(ps_[2]), __float_as_uint(ps_[3]), false, false); \
                const float s0_ = P2_ADDF(__uint_as_float(swa_[0]), __uint_as_float(swa_[1])), s1_ = P2_ADDF(__uint_as_float(swb_[0]), __uint_as_float(swb_[1])); \
                typedef _Float16 h16x2_ __attribute__((ext_vector_type(2))); \
                const h16x2_ hv_ = {(_Float16)s0_, (_Float16)s1_}; const unsigned hb_ = __builtin_bit_cast(unsigned, hv_); \
                const unsigned kk_ = hb_ ^ (__builtin_bit_cast(unsigned, (s16x2)(__builtin_bit_cast(s16x2, hb_) >> (s16x2){15, 15})) & 0x7FFF7FFFu); \
                scv[R][T] = (base + 64 * (R) < vis) ? kk_ : SC_INVALID; } while (0)
            P2_LOADF(fB, buf, 1);
            P2_WAITF(fA, 8);
            P2_MMA(accA, fA);
            __builtin_amdgcn_sched_barrier(0);
            P2_WAITF(fB, 0); P2_MMA(accB, fB);
            __builtin_amdgcn_sched_barrier(0);
            P2_LOADF(fA, buf, 2); P2_FIN(accA, 0);
            __builtin_amdgcn_sched_barrier(0);
#pragma unroll
            for (int r = 2; r < 8; ++r) {
                bf16x8_t (&cur)[4][2] = (r & 1) ? fB : fA; bf16x8_t (&nxt)[4][2] = (r & 1) ? fA : fB;
                if (r < 7) { P2_LOADF(nxt, buf, r + 1); P2_WAITF(cur, 8); } else { P2_WAITF(cur, 0); }
                __builtin_amdgcn_sched_barrier(0);
                if (r & 1) { P2_MMA(accB, cur); } else { P2_MMA(accA, cur); }
                __builtin_amdgcn_sched_barrier(0);
                if (r & 1) { P2_FIN(accA, r - 1); } else { P2_FIN(accB, r - 1); }
                __builtin_amdgcn_sched_barrier(0);
            }
            P2_FIN(accB, 7);
#undef P2_MMA
#undef P2_FIN
            }
            VM_WAIT(); __syncthreads();
        }
#undef P2_STAGE
#undef P2_LOADF
#undef P2_WAITF
        int Tu, lastrej, eqc;
        { const int ltfix = (128 - 8 * nt2) * 2;
#define P2_SS(V, CPK) __builtin_bit_cast(unsigned, __builtin_elementwise_sub_sat(__builtin_bit_cast(s16x2, (unsigned)(V)), __builtin_bit_cast(s16x2, CPK)))
#define P2_COUNT_GE(CU, GE, LTL) do { const unsigned cs_ = (unsigned)((CU) - 32768) & 0xffffu, cpk_ = cs_ | (cs_ << 16); \
            unsigned a0_ = 0u, a1_ = 0u, a2_ = 0u, a3_ = 0u; \
            _Pragma("unroll") for (int c = 0; c < 16; ++c) if (c < nt2) { \
                const unsigned d0_ = P2_SS(scv[0][c], cpk_), d1_ = P2_SS(scv[1][c], cpk_), d2_ = P2_SS(scv[2][c], cpk_), d3_ = P2_SS(scv[3][c], cpk_), \
                               d4_ = P2_SS(scv[4][c], cpk_), d5_ = P2_SS(scv[5][c], cpk_), d6_ = P2_SS(scv[6][c], cpk_), d7_ = P2_SS(scv[7][c], cpk_); \
                const unsigned p0_ = __builtin_amdgcn_perm(d0_, d1_, 0x07050301u), p1_ = __builtin_amdgcn_perm(d2_, d3_, 0x07050301u), p2_ = __builtin_amdgcn_perm(d4_, d5_, 0x07050301u), p3_ = __builtin_amdgcn_perm(d6_, d7_, 0x07050301u); \
                a0_ += (unsigned)__builtin_popcount(p0_ & 0x80808080u); a1_ += (unsigned)__builtin_popcount(p1_ & 0x80808080u); a2_ += (unsigned)__builtin_popcount(p2_ & 0x80808080u); a3_ += (unsigned)__builtin_popcount(p3_ & 0x80808080u); \
                asm volatile("" : "+v"(a0_), "+v"(a1_), "+v"(a2_), "+v"(a3_)); } \
            LTL = (int)((a0_ + a1_) + (a2_ + a3_)); GE = 8192 - half_sum_i(LTL + ltfix); } while (0)
          int est = 0;
          { const int nvs = vis < 512 ? vis : 512, ks = (TOPK * nvs) / vis;
            for (int bit = 15; bit >= 5; --bit) {
                const int cu = est | (1 << bit); const unsigned cs = (unsigned)(cu - 32768) & 0xffffu, cpk = cs | (cs << 16);
                unsigned a = 0u;
#pragma unroll
                for (int r = 0; r < 8; ++r) a = pk_lt_count(a, scv[r][0], cpk);
                const int lt = half_sum_i((int)(a & 0xffffu) + (int)(a >> 16));
                if (512 - lt >= ks) est = cu; } }
          int lo = 0, hi = 65536, chi = 0, ge, ltl, step = 64; bool kl = false, kh = false;
          int ltlo = 0, lthi = 16 * nt2;
          for (;;) {
              const bool fin = kl && kh && (hi - lo <= 1);
              if (__ballot(!fin) == 0ull) break;
              const bool gal = kl != kh;
              int cand = (kl && kh) ? lo + ((hi - lo) >> 1) : kl ? lo + step : kh ? hi - step : est;
              cand = cand < 0 ? 0 : (cand > 65535 ? 65535 : cand);
              P2_COUNT_GE(cand, ge, ltl);
              if (ge >= TOPK) { if (cand >= lo) { lo = cand; ltlo = ltl; } kl = true; if (cand == 65535) kh = true; }
              else { if (cand < hi) { hi = cand; chi = ge; lthi = ltl; } kh = true; }
              if (gal) step <<= 1;
          }
#undef P2_COUNT_GE
#undef P2_SS
          Tu = lo; lastrej = chi; eqc = lthi - ltlo; }
        const unsigned ts16 = (unsigned)(Tu - 32768) & 0xffffu, tpk = ts16 | (ts16 << 16);
        const int need = TOPK - lastrej;
        int quota;
        { const int eq = eqc;
          int incl = eq;
#pragma unroll
          for (int o = 1; o < 32; o <<= 1) { const int v = __shfl_up(incl, o, 32); incl += ((lane & 31) >= o) ? v : 0; }
          const int excl = incl - eq; quota = need - excl; quota = quota < 0 ? 0 : (quota > eq ? eq : quota); }
        const int Ts = (int)(short)ts16;
#ifndef P2_FINREP
#define P2_FINREP 1
#endif
        int run = 0;
        const bool simple = __ballot((quota > 0) && (quota < eqc)) == 0ull;
        const short te = (short)((quota > 0) ? Ts - 1 : Ts);
        for (int frep_ = 0; frep_ < P2_FINREP; ++frep_) { run = 0;
        for (int g = 0; g < 4; ++g) {
            unsigned W0 = 0u, W1 = 0u;
            if (4 * g < nt2) {
                if (simple) {
#pragma unroll
                  for (int s = 0; s < 64; ++s) {
                    const unsigned v = scv[(s >> 1) & 7][4 * g + (s >> 4)];
                    const short key = (s & 1) ? (short)(v >> 16) : (short)(v & 0xffffu);
                    const unsigned long long msk = __ballot(key > te);
                    const unsigned mlo = (unsigned)msk, mhi = (unsigned)(msk >> 32);
                    P2_WRITELANE2(W0, W1, mlo, mhi, s);
                  }
                } else {
#pragma unroll
                  for (int s = 0; s < 64; ++s) {
                    const unsigned v = scv[(s >> 1) & 7][4 * g + (s >> 4)];
                    const int key = (s & 1) ? ((int)v >> 16) : (int)(short)(v & 0xffffu);
                    const bool eq = key == Ts; const bool take = eq && (run < quota); run += eq ? 1 : 0;
                    const unsigned long long msk = __ballot((key > Ts) || take);
                    const unsigned mlo = (unsigned)msk, mhi = (unsigned)(msk >> 32);
                    P2_WRITELANE2(W0, W1, mlo, mhi, s);
                  }
                }
            }
            bm0[64 * g + lane] = W0; bm1[64 * g + lane] = W1;
        }
        }
    }
}
__device__ __forceinline__ float unsort_mid(unsigned m, unsigned lowmask, unsigned mid) { const unsigned u = (m & ~lowmask) | mid; return __uint_as_float((u & 0x80000000u) ? (u ^ 0x80000000u) : ~u); }
__device__ __forceinline__ unsigned umax3(unsigned a, unsigned b, unsigned c) { return max(max(a, b), c); }
__device__ __forceinline__ void ce_desc(unsigned& a, unsigned& b) { const unsigned hi = max(a, b), lo = min(a, b); a = hi; b = lo; }
__device__ __forceinline__ void merge16_desc(unsigned (&v)[16]) {
#pragma unroll
    for (int j = 8; j >= 1; j >>= 1)
#pragma unroll
        for (int i = 0; i < 16; ++i) { const int l = i ^ j; if (l > i) ce_desc(v[i], v[l]); }
}
__device__ __forceinline__ void sort16_desc(unsigned (&v)[16]) {
#pragma unroll
    for (int k = 2; k <= 16; k <<= 1)
#pragma unroll
        for (int j = k >> 1; j >= 1; j >>= 1)
#pragma unroll
            for (int i = 0; i < 16; ++i) { const int l = i ^ j; if (l > i) { if ((i & k) == 0) ce_desc(v[i], v[l]); else ce_desc(v[l], v[i]); } }
}
constexpr int SK_PITCH = 272;
__device__ __forceinline__ void p7_peer(Frame& F, unsigned* keys1, unsigned short* eig, float* gtg) {
    const int lane = F.lane, wave = F.wave, tid = F.tid;
    LAS unsigned char* SK = F.lds + RING_OFF;
    LAS int* EI = (LAS int*)(F.lds + RING_OFF);
    LAS float* GT = (LAS float*)(F.lds + RING_OFF + 32768);
    const int nunits = M / 64;
    for (int unit = blockIdx.x; unit < nunits; unit += F.G) {
        const int t0 = unit * 64;
        const int c = wave >> 2, tok = t0 + (wave & 3) * 16 + (lane & 15), q4 = lane >> 4;
        v4u stg[8]; bf16x8_t qn[4];
#define P7_PREF(H) do { const v4u* src_ = (const v4u*)(F.SUBK + (size_t)(H) * 2 * NKEYS * 128);     \
            _Pragma("unroll") for (int i = 0; i < 8; ++i) stg[i] = src_[tid + 512 * i]; \
            _Pragma("unroll") for (int s_ = 0; s_ < 4; ++s_) qn[s_] = *(const bf16x8_t*)(F.QP + (size_t)tok * 2048 + (H) * 256 + c * 128 + 32 * s_ + 8 * q4); } while (0)
        P7_PREF(0);
        for (int h = 0; h < PEER_H; ++h) {
            __syncthreads();
#pragma unroll
            for (int i = 0; i < 8; ++i) { const int p = tid + 512 * i, row = p >> 4, c16 = p & 15; *(LAS v4u*)(SK + row * SK_PITCH + c16 * 16) = stg[i]; }
            bf16x8_t qf[4];
#pragma unroll
            for (int s = 0; s < 4; ++s) qf[s] = qn[s];
            __syncthreads();
            if (h + 1 < PEER_H) P7_PREF(h + 1);
            unsigned pk[32];
#pragma unroll
            for (int kb = 0; kb < 8; ++kb) { f32x4 acc = (f32x4){0.f, 0.f, 0.f, 0.f};
#pragma unroll
                for (int s = 0; s < 4; ++s) { const bf16x8_t a = *(const LAS bf16x8_t*)(SK + (c * 128 + 16 * kb + (lane & 15)) * SK_PITCH + (32 * s + 8 * q4) * 2);
                    acc = __builtin_amdgcn_mfma_f32_16x16x32_bf16(a, qf[s], acc, 0, 0, 0); }
#pragma unroll
                for (int i = 0; i < 4; ++i) pk[kb * 4 + i] = (sortable(acc[i]) & ~0x7Fu) | (unsigned)(127 - (16 * kb + 4 * q4 + i)); }
            unsigned Mr[16];
            { unsigned A[16], B[16];
#pragma unroll
              for (int i = 0; i < 16; ++i) { A[i] = pk[i]; B[i] = pk[16 + i]; }
              sort16_desc(A); sort16_desc(B);
#pragma unroll
              for (int i = 0; i < 16; ++i) Mr[i] = max(A[i], B[15 - i]);
              merge16_desc(Mr);
              unsigned P[16];
#pragma unroll
              for (int i = 0; i < 16; ++i) { const auto sw = __builtin_amdgcn_permlane16_swap(Mr[15 - i], Mr[i], false, false); P[i] = sw[1]; }
#pragma unroll
              for (int i = 0; i < 16; ++i) Mr[i] = max(Mr[i], P[i]);
              merge16_desc(Mr);
#pragma unroll
              for (int i = 0; i < 16; ++i) { const auto sw = __builtin_amdgcn_permlane32_swap(Mr[15 - i], Mr[15 - i], false, false); P[i] = sw[1]; }
#pragma unroll
              for (int i = 0; i < 16; ++i) Mr[i] = max(Mr[i], P[i]);
              merge16_desc(Mr); }
            if (q4 == 0) { v4u* dst = (v4u*)(keys1 + (((size_t)tok * 8 + h) * 2 + c) * 16);
#pragma unroll
                for (int i = 0; i < 4; ++i) dst[i] = (v4u){Mr[4 * i], Mr[4 * i + 1], Mr[4 * i + 2], Mr[4 * i + 3]}; }
        }
#undef P7_PREF
        VM_WAIT(); __syncthreads();
        { const int tl = tid & 63, h = tid >> 6, tok = t0 + tl;
          const unsigned* kp = keys1 + ((size_t)tok * 8 + h) * 32;
          unsigned kk[32];
#pragma unroll
          for (int i = 0; i < 8; ++i) { const v4u w = ((const v4u*)kp)[i]; kk[4 * i] = w.x; kk[4 * i + 1] = w.y; kk[4 * i + 2] = w.z; kk[4 * i + 3] = w.w; }
          float s0[16], s1[16];
#pragma unroll
          for (int i = 0; i < 16; ++i) { s0[i] = unsort_mid(kk[i], 0x7Fu, 0x40u); s1[i] = unsort_mid(kk[16 + i], 0x7Fu, 0x40u); }
          unsigned x0[16], x1[16];
#pragma unroll
          for (int i = 0; i < 16; ++i) { x0[i] = (127u - (kk[i] & 0x7Fu)) * NKEYS; x1[i] = 127u - (kk[16 + i] & 0x7Fu); }
          unsigned ck[50]; { int k = 0;
#pragma unroll
            for (int i = 0; i < 16; ++i)
#pragma unroll
                for (int j = 0; j < 16; ++j) if ((i + 1) * (j + 1) <= 16) { ck[k] = (sortable(s0[i] + s1[j]) & ~0x3FFFu) | (x0[i] + x1[j]); ++k; } }
          unsigned G1[16], G2[16], G3[16], Fw[16];
#pragma unroll
          for (int i = 0; i < 16; ++i) { G1[i] = ck[i]; G2[i] = ck[16 + i]; G3[i] = ck[32 + i]; }
          sort16_desc(G2); sort16_desc(G3);
          { unsigned g40 = ck[48], g41 = ck[49]; ce_desc(g40, g41);
#pragma unroll
            for (int i = 0; i < 16; ++i) G1[i] = max(G1[i], G2[15 - i]);
            merge16_desc(G1);
            G3[15] = max(G3[15], g40); G3[14] = max(G3[14], g41);
            merge16_desc(G3); }
#pragma unroll
          for (int i = 0; i < 16; ++i) Fw[i] = max(G1[i], G3[15 - i]);
          merge16_desc(Fw);
          float ts[16];
#pragma unroll
          for (int r = 0; r < 16; ++r) { ts[r] = unsort_mid(Fw[r], 0x3FFFu, 0x2000u); EI[tl * 128 + h * 16 + r] = (int)(Fw[r] & 0x3FFFu); }
          float ex[16]; float sum = 0.f;
#pragma unroll
          for (int r = 0; r < 16; ++r) { ex[r] = __expf(ts[r] - ts[0]); sum += ex[r]; }
          const float inv = 1.0f / sum;
#pragma unroll
          for (int r = 0; r < 16; ++r) GT[tl * 128 + h * 16 + r] = ex[r] * inv;
        }
        __syncthreads();
        { v2u* de = (v2u*)(eig + (size_t)t0 * 128); v4u* dg = (v4u*)(gtg + (size_t)t0 * 128); const LAS v4u* se = (const LAS v4u*)EI; const LAS v4u* sg = (const LAS v4u*)GT;
#pragma unroll
          for (int i = 0; i < 4; ++i) { const v4u e4 = se[tid + 512 * i]; v2u o; o.x = e4.x | (e4.y << 16); o.y = e4.z | (e4.w << 16); de[tid + 512 * i] = o; dg[tid + 512 * i] = sg[tid + 512 * i]; } }
    }
}
constexpr int CW_UCNT = 8192, CW_VCNT = 9216;
__device__ __forceinline__ int p7_next_unit(Frame& F, unsigned* cnt, int myp, int& pq, int ntiles) {
    for (;;) {
        if (pq >= 8) return -1;
        const int p = (myp + pq) & 7;
        if (F.tid == 0) F.MISC[16] = __hip_atomic_fetch_add(cnt + 64 * p, 1u, __ATOMIC_RELAXED, __HIP_MEMORY_SCOPE_AGENT);
        __syncthreads(); const unsigned idx = F.MISC[16]; __syncthreads();
        if (idx < (unsigned)ntiles) return p * ntiles + (int)idx;
        ++pq;
    }
}
typedef float f32x2_ __attribute__((ext_vector_type(2)));
__device__ __forceinline__ void p7_uphase(Frame& F, const unsigned short* eig, bf16* part, int cntoff) {
    const int lane = F.lane, wave = F.wave;
    const int myp = (int)(xb_xcc_id() & 7u); int pq = 0;
    LAS int* EL = (LAS int*)(F.lds + RING_OFF + wave * 4096);
    const unsigned char* EU8 = (const unsigned char*)F.EU;
    const int g = lane >> 3, c = lane & 7;
    for (;;) {
        const int unit = p7_next_unit(F, F.ctl + CW_UCNT + cntoff, myp, pq, M / 256); if (unit < 0) break;
        const int p = unit / (M / 256), tw = (unit % (M / 256)) * 256 + wave * 32;
        const unsigned char* ubase = EU8 + (size_t)p * (16384 * 128) + 16 * c;
        bf16* pp = part + (size_t)p * M * 128;
        f32x4 g2[4];
#pragma unroll
        for (int q = 0; q < 4; ++q) g2[q] = *(const f32x4*)(F.ffn_g + 128 * p + 16 * c + 4 * q);
        int e0, e1;
#define PU_FETCH(T) do { e0 = __builtin_nontemporal_load(eig + (size_t)(T) * 128 + lane); e1 = __builtin_nontemporal_load(eig + (size_t)(T) * 128 + 64 + lane); } while (0)
#define PU_STASH(BUF) do { EL[(BUF) * 128 + lane] = e0; EL[(BUF) * 128 + 64 + lane] = e1; LDS_WAIT(); } while (0)
#define PU_XLOAD(S, T) do { xa##S = __builtin_nontemporal_load((const v4u*)(F.XB + (size_t)(T) * D + 128 * p + 16 * c)); xb##S = __builtin_nontemporal_load((const v4u*)(F.XB + (size_t)(T) * D + 128 * p + 16 * c + 8)); ss##S = F.ss1[T]; } while (0)
#define PU_XCVT(S) do { xv[0] = (f32x4){bflo(xa##S.x), bfhi(xa##S.x), bflo(xa##S.y), bfhi(xa##S.y)}; xv[1] = (f32x4){bflo(xa##S.z), bfhi(xa##S.z), bflo(xa##S.w), bfhi(xa##S.w)}; \
            xv[2] = (f32x4){bflo(xb##S.x), bfhi(xb##S.x), bflo(xb##S.y), bfhi(xb##S.y)}; xv[3] = (f32x4){bflo(xb##S.z), bfhi(xb##S.z), bflo(xb##S.w), bfhi(xb##S.w)}; rs2 = rsqrtf(ss##S * (1.0f / D) + EPS); } while (0)
#define PU_GATHER(VR, BUF) do { _Pragma("unroll") for (int i_ = 0; i_ < 16; ++i_) { const int e_ = EL[(BUF) * 128 + 8 * i_ + g]; VR[i_] = *(const v4u*)(ubase + (size_t)e_ * 128); } } while (0)
#define PU_REDUCE(VR, S, T) do { \
            PU_XCVT(S); f32x2_ hx2[8]; \
            _Pragma("unroll") for (int q_ = 0; q_ < 4; ++q_) { const f32x4 h_ = xv[q_] * g2[q_] * rs2; hx2[2 * q_] = (f32x2_){h_[0], h_[1]}; hx2[2 * q_ + 1] = (f32x2_){h_[2], h_[3]}; } \
            float v16[16]; \
            _Pragma("unroll") for (int i_ = 0; i_ < 16; ++i_) { f32x2_ d2_ = (f32x2_){0.f, 0.f}; \
                _Pragma("unroll") for (int j_ = 0; j_ < 4; ++j_) { const f32x2_ lo_ = __builtin_amdgcn_cvt_pk_f32_fp8((int)VR[i_][j_], false), hi_ = __builtin_amdgcn_cvt_pk_f32_fp8((int)VR[i_][j_], true); \
                    d2_ = __builtin_elementwise_fma(lo_, hx2[2 * j_], d2_); d2_ = __builtin_elementwise_fma(hi_, hx2[2 * j_ + 1], d2_); } \
                v16[i_] = d2_.x + d2_.y; } \
              \
            float w8[8], w4[4], w2[2]; \
              \
            _Pragma("unroll") for (int j_ = 0; j_ < 8; ++j_) { const float a_ = v16[2 * j_], b_ = v16[2 * j_ + 1]; w8[j_] = ((lane & 1) ? b_ : a_) + lane_xor1((lane & 1) ? a_ : b_); } \
            _Pragma("unroll") for (int j_ = 0; j_ < 4; ++j_) { const float a_ = w8[2 * j_], b_ = w8[2 * j_ + 1]; w4[j_] = ((lane & 2) ? b_ : a_) + lane_xor2((lane & 2) ? a_ : b_); } \
            _Pragma("unroll") for (int j_ = 0; j_ < 2; ++j_) { const float a_ = w4[2 * j_], b_ = w4[2 * j_ + 1]; w2[j_] = ((lane & 4) ? b_ : a_) + lane_xor4((lane & 4) ? a_ : b_, (lane & 4) != 0); } \
            pp[(size_t)(T) * 128 + 8 * c + g] = (bf16)f2bf(w2[0]); pp[(size_t)(T) * 128 + 64 + 8 * c + g] = (bf16)f2bf(w2[1]); } while (0)
        v4u vA[16], vB[16]; f32x4 xv[4]; float rs2; v4u xaA, xbA, xaB, xbB; float ssA, ssB;
        PU_FETCH(tw); PU_STASH(0); PU_GATHER(vA, 0); PU_FETCH(tw + 1); PU_STASH(1); PU_XLOAD(A, tw);
        for (int ti = 0; ti < 32; ti += 2) {
            PU_XLOAD(B, tw + ti + 1);
            if (ti + 2 < 32) PU_FETCH(tw + ti + 2);
            PU_GATHER(vB, 1);
            PU_REDUCE(vA, A, tw + ti);
            if (ti + 2 < 32) PU_STASH(0);
            PU_XLOAD(A, tw + (ti + 2 < 32 ? ti + 2 : 31));
            if (ti + 3 < 32) PU_FETCH(tw + ti + 3);
            if (ti + 2 < 32) PU_GATHER(vA, 0);
            PU_REDUCE(vB, B, tw + ti + 1);
            if (ti + 3 < 32) PU_STASH(1);
        }
#undef PU_FETCH
#undef PU_STASH
#undef PU_XLOAD
#undef PU_XCVT
#undef PU_GATHER
#undef PU_REDUCE
    }
}
__device__ __forceinline__ void p7_reduce(Frame& F, const bf16* part, const float* gtg, float* actg) {
    const int lane = F.lane;
    for (int t = F.gw; t < M; t += F.NGW) {
        float s0 = 0.f, s1 = 0.f;
#pragma unroll
        for (int q = 0; q < 8; ++q) { s0 += bf1(__builtin_nontemporal_load(part + ((size_t)q * M + t) * 128 + lane)); s1 += bf1(__builtin_nontemporal_load(part + ((size_t)q * M + t) * 128 + 64 + lane)); }
        actg[(size_t)t * 128 + lane] = gelu_tanh(s0 * (1.0f / EU_SCALE)) * gtg[(size_t)t * 128 + lane];
        actg[(size_t)t * 128 + 64 + lane] = gelu_tanh(s1 * (1.0f / EU_SCALE)) * gtg[(size_t)t * 128 + 64 + lane];
    }
}
__device__ __forceinline__ void p7_vphase(Frame& F, const unsigned short* eig, const float* actg, float* ss2, int cntoff, bool dry) {
    const int lane = F.lane, wave = F.wave;
    const int myp = (int)(xb_xcc_id() & 7u); int pq = 0;
    LAS int* EL = (LAS int*)(F.lds + RING_OFF + wave * 4096);
    LAS float* AL = (LAS float*)(F.lds + RING_OFF + wave * 4096 + 1024);
    LAS float* OS = (LAS float*)(F.lds + RING_OFF + wave * 4096 + 2048);
    const unsigned char* EV8 = (const unsigned char*)F.EV;
    const int g = lane >> 3, c = lane & 7;
    const int b3 = (lane >> 3) & 1, b4 = (lane >> 4) & 1, b5 = (lane >> 5) & 1;
    const int colp = 16 * (lane & 7) + 8 * b5 + 4 * b4 + 2 * b3;
    for (;;) {
        const int unit = p7_next_unit(F, F.ctl + CW_VCNT + cntoff, myp, pq, M / 256); if (unit < 0) break;
        const int p = unit / (M / 256), tw = (unit % (M / 256)) * 256 + wave * 32;
        const unsigned char* vbase = EV8 + (size_t)p * (16384 * 128) + 16 * c;
        int e0, e1; float a0, a1;
#define PV_FETCH(T) do { e0 = __builtin_nontemporal_load(eig + (size_t)(T) * 128 + lane); e1 = __builtin_nontemporal_load(eig + (size_t)(T) * 128 + 64 + lane); \
                         a0 = __builtin_nontemporal_load(actg + (size_t)(T) * 128 + lane); a1 = __builtin_nontemporal_load(actg + (size_t)(T) * 128 + 64 + lane); } while (0)
#define PV_STASH(BUF) do { EL[(BUF) * 128 + lane] = e0; EL[(BUF) * 128 + 64 + lane] = e1; AL[(BUF) * 128 + lane] = a0 * (1.0f / EV_SCALE); AL[(BUF) * 128 + 64 + lane] = a1 * (1.0f / EV_SCALE); LDS_WAIT(); } while (0)
#define PV_GATHER(VR, BUF) do { _Pragma("unroll") for (int i_ = 0; i_ < 16; ++i_) { const int e_ = EL[(BUF) * 128 + 8 * i_ + g]; VR[i_] = *(const v4u*)(vbase + (size_t)e_ * 128); } } while (0)
#define PV_XLOAD(T) do { xw = *(const unsigned*)(F.XB + (size_t)(T) * D + 128 * p + colp); } while (0)
#define PV_REDUCE(VR, BUF, T) do { \
            const size_t off_ = (size_t)(T) * D + 128 * p + colp; \
            f32x2_ ac2[8]; \
            _Pragma("unroll") for (int k_ = 0; k_ < 8; ++k_) ac2[k_] = (f32x2_){0.f, 0.f}; \
            _Pragma("unroll") for (int i_ = 0; i_ < 16; ++i_) { const float a_ = AL[(BUF) * 128 + 8 * i_ + g]; const f32x2_ aa_ = (f32x2_){a_, a_}; \
                _Pragma("unroll") for (int j_ = 0; j_ < 4; ++j_) { const f32x2_ lo_ = __builtin_amdgcn_cvt_pk_f32_fp8((int)VR[i_][j_], false), hi_ = __builtin_amdgcn_cvt_pk_f32_fp8((int)VR[i_][j_], true); \
                    ac2[2 * j_] = __builtin_elementwise_fma(aa_, lo_, ac2[2 * j_]); ac2[2 * j_ + 1] = __builtin_elementwise_fma(aa_, hi_, ac2[2 * j_ + 1]); } } \
            float acc[16]; \
            _Pragma("unroll") for (int k_ = 0; k_ < 8; ++k_) { acc[2 * k_] = ac2[k_].x; acc[2 * k_ + 1] = ac2[k_].y; } \
            float a8[8], a4[4], c2[2]; \
              \
            _Pragma("unroll") for (int j_ = 0; j_ < 8; ++j_) { const auto sw_ = __builtin_amdgcn_permlane32_swap(__float_as_uint(acc[j_]), __float_as_uint(acc[j_ + 8]), false, false); a8[j_] = __uint_as_float(sw_[0]) + __uint_as_float(sw_[1]); } \
            _Pragma("unroll") for (int j_ = 0; j_ < 4; ++j_) { const auto sw_ = __builtin_amdgcn_permlane16_swap(__float_as_uint(a8[j_]), __float_as_uint(a8[j_ + 4]), false, false); a4[j_] = __uint_as_float(sw_[0]) + __uint_as_float(sw_[1]); } \
            _Pragma("unroll") for (int j_ = 0; j_ < 2; ++j_) { const float a_ = a4[j_], b_ = a4[j_ + 2]; c2[j_] = (b3 ? b_ : a_) + lane_xor8(b3 ? a_ : b_); } \
            const float x0_ = bflo(xw) + c2[0], x1_ = bfhi(xw) + c2[1]; \
            if (!dry) *(unsigned*)(F.XB + off_) = pk2(x0_, x1_); \
            const float ssq_ = wave_sum(x0_ * x0_ + x1_ * x1_); if (lane == 0) atomicAdd(ss2 + (T), dry ? 0.f : ssq_); } while (0)
        v4u vA[16], vB[16]; unsigned xw;
        PV_FETCH(tw); PV_STASH(0); PV_GATHER(vA, 0); PV_FETCH(tw + 1); PV_STASH(1);
        for (int ti = 0; ti < 32; ti += 2) {
            PV_XLOAD(tw + ti);
            if (ti + 2 < 32) PV_FETCH(tw + ti + 2);
            PV_GATHER(vB, 1);
            PV_REDUCE(vA, 0, tw + ti);
            if (ti + 2 < 32) PV_STASH(0);
            PV_XLOAD(tw + ti + 1);
            if (ti + 3 < 32) PV_FETCH(tw + ti + 3);
            if (ti + 2 < 32) PV_GATHER(vA, 0);
            PV_REDUCE(vB, 1, tw + ti + 1);
            if (ti + 3 < 32) PV_STASH(1);
        }
#undef PV_XLOAD
#undef PV_FETCH
#undef PV_STASH
#undef PV_GATHER
#undef PV_REDUCE
    }
}
constexpr int NPHASE = 12;
struct Args { const float* in[23]; float* out; unsigned char* ws; int ph_lo, ph_hi; };
__global__ void __launch_bounds__(NWAVES * 64, 2) fwd(Args args) {
    extern __shared__ __attribute__((aligned(16))) unsigned char lds[];
    Frame F;
    F.lds = (LAS unsigned char*)lds; F.MISC = (volatile LAS unsigned*)(F.lds + MISC_OFF);
    F.tid = threadIdx.x; F.lane = F.tid & 63; F.wave = __builtin_amdgcn_readfirstlane(F.tid >> 6); F.G = gridDim.x;
    F.gw = blockIdx.x * NWAVES + F.wave; F.NGW = F.G * NWAVES;
    unsigned char* ws = args.ws;
    F.ctl = (unsigned*)(ws + WS_CTL);
    F.x = args.in[0]; F.p = args.in[1]; F.rel_bias = args.in[2]; F.attn_g = args.in[3]; F.w_in = args.in[4]; F.b_gate = args.in[5]; F.q_g = args.in[6]; F.k_g = args.in[7];
    F.w_att = args.in[8]; F.conv_w = args.in[9]; F.conv_b = args.in[10]; F.ln_g = args.in[11]; F.ln_b = args.in[12]; F.w_conv = args.in[13]; F.w_out = args.in[14]; F.ffn_g = args.in[15];
    F.w_pq = args.in[16]; F.subk = args.in[17]; F.pu = args.in[18]; F.pv = args.in[19]; F.ple_g = args.in[20]; F.w_pg = args.in[21]; F.w_pp = args.in[22]; F.out = args.out;
    F.ss1 = (float*)(ws + WS_SS1); F.ss2 = (float*)(ws + WS_SS1 + 128 * 1024); F.rstd1 = (float*)(ws + WS_RSTD1); F.rstd3 = (float*)(ws + WS_RSTD3); F.tab = (float*)(ws + WS_TAB); F.mb = (float*)(ws + WS_TAB + 64 * 1024); F.WI = (float*)(ws + WS_WI); F.KI = (bf16*)(ws + WS_KI);
    F.Win_t = (bf16*)(ws + WS_WIN); F.Wa_t = (bf16*)(ws + WS_WA); F.Wc_t = (bf16*)(ws + WS_WC); F.Wout_t = (bf16*)(ws + WS_WOUT); F.Wq_t = (bf16*)(ws + WS_WQ); F.Wg_t = (bf16*)(ws + WS_WG); F.Wp_t = (bf16*)(ws + WS_WP);
    F.SUBK = (bf16*)(ws + WS_SUBK); F.EU = (bf16*)(ws + WS_EU); F.EV = (bf16*)(ws + WS_EV); F.PB = (bf16*)(ws + WS_PB);
    F.XB = (bf16*)(ws + WS_RC); F.ATT = (bf16*)(ws + WS_RA + 64 * MiB); F.CV = (bf16*)(ws + WS_RA + 96 * MiB);
    F.UB = (bf16*)(ws + WS_RD); F.bitmap = (unsigned*)(ws + WS_RD + 32 * MiB); F.MIX = (bf16*)(ws + WS_RD); F.PP = (bf16*)(ws + WS_RD);
    F.Q = (bf16*)(ws + WS_RB); F.K = (bf16*)(ws + WS_RB + 32 * MiB); F.V = (bf16*)(ws + WS_RB + 64 * MiB); F.QI = (bf16*)(ws + WS_RB + 96 * MiB);
    F.GB = (bf16*)(ws + WS_RA); F.QP = (bf16*)(ws + WS_RA);
    for (int u = F.tid; u < (LDS_BYTES - LDSCTL_OFF) / 4; u += NWAVES * 64) ((LAS unsigned*)(F.lds + LDSCTL_OFF))[u] = 0u;
    __syncthreads();
    const int lo = args.ph_lo, hi = args.ph_hi;
    XcdBarrier bar; bar.bar = F.ctl + CW_BAR; bar.x = 0; bar.st = nullptr;
    if (hi - lo > 1) bar = xcd_barrier_post(F.ctl + CW_BAR, F.MISC + 8);
#ifndef PH_MASK
#define PH_MASK 0xfff
#endif
#define IN(k) (((PH_MASK >> (k)) & 1) && lo <= (k) && (k) < hi)
#define SEAM(k) do { if (IN(k) && IN((k) + 1)) xcd_barrier(bar); } while (0)
#ifndef REP_MASK
#define REP_MASK 0
#endif
#define NREP(k) (((REP_MASK >> (k)) & 1) ? 2 : 1)
    const int bid = (int)blockIdx.x;

    if (IN(0)) for (int rep_ = 0; rep_ < NREP(0); ++rep_) { p0_prologue(F); } SEAM(0);
    if (IN(1)) for (int rep_ = 0; rep_ < NREP(1); ++rep_) {
        pg8::Gemm g{F.XB, F.Win_t, M, NIN, opaque_i(D)}; pg8::StaticOrder S; S.init(M, NIN, F.G, bid);
        epi::EpiInProj E{F.rstd1, F.Q, F.K, F.V, F.QI, F.UB, F.GB, F.KI, F.WI, F.q_g, F.k_g, F.b_gate};
        pg8::gemm_phase<epi::EpiInProj, pg8::StaticOrder, true, true>(F.lds + RING_OFF, g, S, E);
    } SEAM(1);
#ifdef NAIVE_P2
    if (IN(2)) for (int rep_ = 0; rep_ < NREP(2); ++rep_) { p2_index_naive(F, F.out); p2_conv_naive(F); } SEAM(2);
#else
    if (IN(2)) for (int rep_ = 0; rep_ < NREP(2); ++rep_) { for (int r2_ = 0; r2_ < NREP(9); ++r2_) p2_index(F); for (int r2_ = 0; r2_ < NREP(10); ++r2_) p2_conv(F); } SEAM(2);
#endif
#ifdef NAIVE_P3
    if (IN(3)) for (int rep_ = 0; rep_ < NREP(3); ++rep_) { p3_attn_naive(F); } SEAM(3);
#else
    if (IN(3)) for (int rep_ = 0; rep_ < NREP(3); ++rep_) { static_assert(attn2::ATTN_LDS_BYTES <= RING_BYTES && attn2::TBN == TABN && attn2::TBOFF == TABOFF, "attention body vs frame");
        const attn2::StaticOrder S((int)F.G, bid);
        attn2::attn_phase((char*)lds + RING_OFF, (const attn2::bf16*)F.Q, (const attn2::bf16*)F.K, (const attn2::bf16*)F.V, (attn2::bf16*)F.ATT, F.bitmap, F.tab, F.mb, S); } SEAM(3);
#endif
    if (IN(4)) for (int rep_ = 0; rep_ < NREP(4); ++rep_) {
        { pg8::Gemm g{F.ATT, F.Wa_t, M, D, opaque_i(1024)}; pg8::StaticOrder S; S.init(M, D, F.G, bid); epi::EpiGate2 E{(const unsigned char*)F.GB, F.MIX};
          pg8::gemm_phase<epi::EpiGate2, pg8::StaticOrder, true, true, true>(F.lds + RING_OFF, g, S, E); }
    } SEAM(4);
    if (IN(5)) for (int rep_ = 0; rep_ < NREP(5); ++rep_) {
        pg8::Gemm g{F.MIX, F.Wout_t, M, D, opaque_i(D)}; pg8::StaticOrder S; S.init(M, D, F.G, bid); epi::EpiRes1 E{F.x, F.out, F.XB, F.ss1};
        pg8::gemm_phase<epi::EpiRes1, pg8::StaticOrder, true, true>(F.lds + RING_OFF, g, S, E);
    } SEAM(5);
    if (IN(6)) for (int rep_ = 0; rep_ < NREP(6); ++rep_) {
        pg8::Gemm g{F.XB, F.Wq_t, M, 2048, opaque_i(D)}; pg8::StaticOrder S; S.init(M, 2048, F.G, bid); epi::EpiScaleRow E{F.ss1, F.QP, 2048};
        pg8::gemm_phase<epi::EpiScaleRow, pg8::StaticOrder, true, true>(F.lds + RING_OFF, g, S, E);
    } SEAM(6);
#ifdef NAIVE_P7
    if (IN(7)) for (int rep_ = 0; rep_ < NREP(7); ++rep_) { p7_peer_naive(F); } SEAM(7);
#else
    if (IN(7)) for (int rep_ = 0; rep_ < NREP(7); ++rep_) { p7_peer(F, (unsigned*)(ws + WS_RB), (unsigned short*)(ws + WS_RB + 40 * MiB), (float*)(ws + WS_RB + 56 * MiB)); } SEAM(7);
    if (IN(8)) for (int rep_ = 0; rep_ < NREP(11); ++rep_) { p7_uphase(F, (const unsigned short*)(ws + WS_RB + 40 * MiB), (bf16*)(ws + WS_RA), rep_ * 2048); } SEAM(8);
    if (IN(9)) for (int rep_ = 0; rep_ < NREP(13); ++rep_) { p7_reduce(F, (const bf16*)(ws + WS_RA), (const float*)(ws + WS_RB + 56 * MiB), (float*)(ws + WS_RB + 72 * MiB)); } SEAM(9);
    if (IN(10)) for (int rep_ = 0; rep_ < NREP(12); ++rep_) { p7_vphase(F, (const unsigned short*)(ws + WS_RB + 40 * MiB), (const float*)(ws + WS_RB + 72 * MiB), F.ss2, rep_ * 2048, rep_ + 1 < NREP(12)); } SEAM(10);
#endif
    if (IN(11)) for (int rep_ = 0; rep_ < NREP(8); ++rep_) {
#ifndef NO8A
        { pg8::Gemm g{F.PB, F.Wp_t, M, D, opaque_i(PLE)}; pg8::StaticOrder S; S.init(M, D, F.G, bid); epi::EpiPlain E{F.PP, D};
          pg8::gemm_phase<epi::EpiPlain, pg8::StaticOrder, true, true>(F.lds + RING_OFF, g, S, E); }
#endif
#ifndef NO8B
        { pg8::Gemm g{F.XB, F.Wg_t, M, D, opaque_i(D)}; pg8::StaticOrder S; S.init(M, D, F.G, bid); epi::EpiPle E{F.ss2, F.PP, F.XB, F.out};
          pg8::gemm_phase<epi::EpiPle, pg8::StaticOrder, true, true>(F.lds + RING_OFF, g, S, E); }
#endif
    }
#undef IN
#undef SEAM
}

#ifndef MK_MULTI
#define MK_MULTI 0
#endif
extern "C" void kernel_launch(void* const* d_in, const int* in_sizes, int n_in, void* d_out, int out_size, void* d_ws, size_t ws_size, hipStream_t stream) {
    static int grid = 0;
    if (grid == 0) {
        if (n_in != 23 || in_sizes[0] != M * D || out_size != M * D || ws_size < WS_END) { fprintf(stderr, "kernel_launch: unexpected problem: n_in %d in0 %d out %d ws %zu (need %zu)\n", n_in, n_in > 0 ? in_sizes[0] : -1, out_size, ws_size, (size_t)WS_END); grid = -1; return; }
        int dev = 0, cus = 0;
        if (hipGetDevice(&dev) != hipSuccess || hipDeviceGetAttribute(&cus, hipDeviceAttributeMultiprocessorCount, dev) != hipSuccess) { grid = -1; return; }
        if (hipFuncSetAttribute((const void*)fwd, hipFuncAttributeMaxDynamicSharedMemorySize, LDS_BYTES) != hipSuccess) { fprintf(stderr, "kernel_launch: hipFuncSetAttribute failed\n"); grid = -1; return; }
        int per_cu = 0;
        if (hipOccupancyMaxActiveBlocksPerMultiprocessor(&per_cu, (const void*)fwd, NWAVES * 64, LDS_BYTES) != hipSuccess || per_cu < 1) fprintf(stderr, "kernel_launch: occupancy query says %d\n", per_cu);
        (void)hipGetLastError();
        grid = cus;
    }
    if (grid < 0) return;
    if (hipMemsetAsync((char*)d_ws + WS_CTL, 0, CTL_ZERO_BYTES, stream) != hipSuccess) return;
    Args a{};
    for (int i = 0; i < 23; ++i) a.in[i] = (const float*)d_in[i];
    a.out = (float*)d_out; a.ws = (unsigned char*)d_ws;
#if MK_MULTI
    for (int ph = 0; ph < NPHASE; ++ph) { a.ph_lo = ph; a.ph_hi = ph + 1; hipLaunchKernelGGL(fwd, dim3(grid), dim3(NWAVES * 64), LDS_BYTES, stream, a); }
#else
    a.ph_lo = 0; a.ph_hi = NPHASE; hipLaunchKernelGGL(fwd, dim3(grid), dim3(NWAVES * 64), LDS_BYTES, stream, a);
#endif
}
```

```cpp
#include <hip/hip_runtime.h>
#include <cstdio>
#include <cstdint>
namespace pg8 {
#define PG8_LAS __attribute__((address_space(3)))
typedef unsigned short bf16_t;
typedef short bf16x8 __attribute__((ext_vector_type(8)));
typedef float f32x4 __attribute__((ext_vector_type(4)));
typedef unsigned u32x4 __attribute__((ext_vector_type(4)));
constexpr int BM = 256, BK = 64, HALF = 128, HTB = HALF * BK * 2  , STAGE_BYTES = 8 * HTB, NXCD = 8, WGM = 8;

__host__ __device__ __forceinline__ int lds_byte(int r, int c) { const int st = (r >> 4) * 2 + (c >> 5), rr = r & 15, cc = c & 31, ob = rr * 64 + cc * 2; return st * 1024 + (ob ^ (((ob >> 9) & 1) << 5)); }
__host__ __device__ __forceinline__ void stage_rc(int b, int& R, int& C) { const int st = b / 1024, sb = b % 1024, swz = sb ^ (((sb >> 9) & 1) << 5); R = (st >> 1) * 16 + swz / 64; C = (st & 1) * 32 + (swz % 64) / 2; }
__host__ __device__ __forceinline__ int perm32(int rho) { const int n = rho >> 4, i = rho & 15; return 8 * (i >> 2) + 4 * n + (i & 3); }

struct Unit { int pm, pn; };
struct Gemm { const bf16_t* A; const bf16_t* Bt; int M, N, K; };

struct StaticOrder {
    int nM, nN, nwg, G, c;
    __host__ __device__ void init(int M, int N, int G_, int c_) { nM = M / BM; nN = N / BM; nwg = nM * nN; G = G_; c = c_; }
    __host__ __device__ bool next(int i, Unit& u) const {
        const long L = (long)i * G + c; if (L >= nwg) return false;
        int wgid = (int)L; { const int q = nwg / NXCD, r = nwg % NXCD, xcd = wgid % NXCD, off = wgid / NXCD; wgid = (xcd < r ? xcd * (q + 1) : r * (q + 1) + (xcd - r) * q) + off; }
        const int nig = WGM * nN, gid = wgid / nig, fm = gid * WGM, gsz = (nM - fm) < WGM ? (nM - fm) : WGM;
        u.pm = fm + ((wgid % nig) % gsz); u.pn = (wgid % nig) / gsz; return true;
    }
    __device__ __forceinline__ void a_ready(const Unit&) const {}
    __device__ __forceinline__ void done(const Unit&) const {}
};

__device__ __forceinline__ unsigned cvt_pk_bf16(float lo, float hi) { unsigned r; asm volatile("v_cvt_pk_bf16_f32 %0, %1, %2" : "=v"(r) : "v"(lo), "v"(hi)); return r; }
typedef float f32x2 __attribute__((ext_vector_type(2)));
__device__ __forceinline__ f32x2 gelu_pk(f32x2 v) {
    const f32x2 av = __builtin_elementwise_abs(v), d = av * 0.2316418882f + 1.0f;
    f32x2 t; t.x = __builtin_amdgcn_rcpf(d.x); t.y = __builtin_amdgcn_rcpf(d.y);
    f32x2 q = t * 0.5307027145f + (-0.7265760135f); q = q * t + 0.7107068705f; q = q * t + (-0.142248368f); q = q * t + 0.127414796f; q = q * t;
    const f32x2 s = (v * v) * (-0.72134752044f);
    f32x2 e; e.x = __builtin_amdgcn_exp2f(s.x); e.y = __builtin_amdgcn_exp2f(s.y);
    const f32x2 m = v * (q * e), r = v - m;
    f32x2 o; o.x = v.x < 0.f ? m.x : r.x; o.y = v.y < 0.f ? m.y : r.y; return o;
}

template <int ACT  > struct EpiBf16 {
    static constexpr bool PERM = true, AFTER_DRAIN = false; static_assert(ACT == 0 || ACT == 1, "EpiBf16: ACT is 0 (none) or 1 (gelu_pk)");
    bf16_t* O; int ldc; const float* bias; int split_cols; size_t split_stride; float scale0;
    __device__ __forceinline__ void operator()(const f32x4 (&acc)[2][2][4][2], const Unit& u, int wr, int wc, int fr, int fq) const {
        const int row0 = u.pm * BM + wr * 64 + fr; int colt = u.pn * BM; bf16_t* base = O;
        float sc = 1.f; if (split_cols) { const int t = colt / split_cols; base += (size_t)t * split_stride; colt -= t * split_cols; if (t == 0) sc = scale0; }
        const int col0 = colt + wc * 32 + 8 * fq, bcol0 = u.pn * BM + wc * 32 + 8 * fq;
        f32x4 bv[2][2];
#pragma unroll
        for (int bj = 0; bj < 2; ++bj)
#pragma unroll
            for (int n = 0; n < 2; ++n) bv[bj][n] = bias ? *(const f32x4*)(bias + bcol0 + bj * HALF + 4 * n) : (f32x4){0.f, 0.f, 0.f, 0.f};
#pragma unroll
        for (int ai = 0; ai < 2; ++ai)
#pragma unroll
            for (int m = 0; m < 4; ++m) { bf16_t* rowp = base + (size_t)(row0 + ai * HALF + m * 16) * ldc + col0;
#pragma unroll
                for (int bj = 0; bj < 2; ++bj) { f32x4 v0 = acc[ai][bj][m][0] + bv[bj][0], v1 = acc[ai][bj][m][1] + bv[bj][1];
                    if (ACT == 1) { f32x2 a = gelu_pk((f32x2){v0[0], v0[1]}), b = gelu_pk((f32x2){v0[2], v0[3]}), c = gelu_pk((f32x2){v1[0], v1[1]}), d = gelu_pk((f32x2){v1[2], v1[3]});
                        v0 = (f32x4){a.x, a.y, b.x, b.y}; v1 = (f32x4){c.x, c.y, d.x, d.y}; }
                    v0 = v0 * sc; v1 = v1 * sc; u32x4 w; w.x = cvt_pk_bf16(v0[0], v0[1]); w.y = cvt_pk_bf16(v0[2], v0[3]); w.z = cvt_pk_bf16(v1[0], v1[1]); w.w = cvt_pk_bf16(v1[2], v1[3]);
                    *(u32x4*)(rowp + bj * HALF) = w; } }
    }
};

struct PanelStats {
    unsigned* xbuf;
    unsigned* cnt;
    unsigned* tmo;
    int ntn; float eps;
    unsigned code;
    __device__ __forceinline__ bool run(const f32x4 (&v)[2][2][4][2], const Unit& u, int wr, int wc, int fr, int fq, PG8_LAS unsigned char* lds, int wid, int lane) const {
        typedef float f32x2v __attribute__((ext_vector_type(2)));
        PG8_LAS f32x2v* P = (PG8_LAS f32x2v*)lds;
        PG8_LAS f32x2v* S = (PG8_LAS f32x2v*)(lds + 8192);
        PG8_LAS unsigned* flag = (PG8_LAS unsigned*)(lds + 8192 + 2048);
#pragma unroll
        for (int ai = 0; ai < 2; ++ai)
#pragma unroll
            for (int m = 0; m < 4; ++m) {
                float s = 0.f;
#pragma unroll
                for (int bj = 0; bj < 2; ++bj)
#pragma unroll
                    for (int n = 0; n < 2; ++n) { const f32x4 x = v[ai][bj][m][n]; s += (x[0] + x[1]) + (x[2] + x[3]); }
                s += __shfl_xor(s, 16); s += __shfl_xor(s, 32);
                const float mw = s * (1.0f / 64.0f); float q = 0.f;
#pragma unroll
                for (int bj = 0; bj < 2; ++bj)
#pragma unroll
                    for (int n = 0; n < 2; ++n) { const f32x4 d = v[ai][bj][m][n] - mw; q += (d[0] * d[0] + d[1] * d[1]) + (d[2] * d[2] + d[3] * d[3]); }
                q += __shfl_xor(q, 16); q += __shfl_xor(q, 32);
                if (fq == 0) P[(ai * HALF + wr * 64 + m * 16 + fr) * 4 + wc] = (f32x2v){mw, q};
            }
        asm volatile("s_waitcnt lgkmcnt(0)" ::: "memory"); __builtin_amdgcn_s_barrier(); asm volatile("" ::: "memory");
#if defined(BROKEN_EXCHANGE_NO_WAIT)
#warning BROKEN CONTROL BUILD: the row-statistics exchange does not wait; results are wrong by design
        if (blockIdx.x >= 64) { const long long t0_ = clock64(); while (clock64() - t0_ < 60000) __builtin_amdgcn_s_sleep(8); }
#endif
        const int row = wid * 32 + (lane & 31);
        if (lane < 32) {
            const f32x2v a = P[row * 4 + 0], b = P[row * 4 + 1], c = P[row * 4 + 2], d = P[row * 4 + 3];
            const float mt = (a.x + b.x + c.x + d.x) * 0.25f;
            const float da = a.x - mt, db = b.x - mt, dc = c.x - mt, dd = d.x - mt;
            const float m2 = (a.y + b.y) + (c.y + d.y) + 64.0f * ((da * da + db * db) + (dc * dc + dd * dd));
            unsigned long long* slot = (unsigned long long*)xbuf + ((size_t)(u.pm * BM + row) * 4 + u.pn);
            __hip_atomic_store(slot, ((unsigned long long)__float_as_uint(m2) << 32) | __float_as_uint(mt), __ATOMIC_RELAXED, __HIP_MEMORY_SCOPE_AGENT);
        }
        asm volatile("s_waitcnt vmcnt(0)" ::: "memory");
        if (lane == 0) __hip_atomic_fetch_add(cnt + 64 * u.pm, 1u, __ATOMIC_RELAXED, __HIP_MEMORY_SCOPE_AGENT);
        if (wid == 0) {
            bool dead = false; const unsigned long long t0 = __builtin_amdgcn_s_memrealtime(); const unsigned want = 8u * (unsigned)ntn;
            for (;;) {
#if defined(BROKEN_EXCHANGE_NO_WAIT)
                break;
#endif
                if ((unsigned)__builtin_amdgcn_readfirstlane(__hip_atomic_load(cnt + 64 * u.pm, __ATOMIC_RELAXED, __HIP_MEMORY_SCOPE_AGENT)) >= want) break;
                if (__builtin_amdgcn_s_memrealtime() - t0 > 2000000ull) {
                    if (lane == 0) { unsigned expect = 0u; __hip_atomic_compare_exchange_strong(tmo + 1, &expect, code | (unsigned)(u.pm & 0xff), __ATOMIC_RELAXED, __ATOMIC_RELAXED, __HIP_MEMORY_SCOPE_AGENT);
                                     __hip_atomic_store(tmo, 1u, __ATOMIC_RELAXED, __HIP_MEMORY_SCOPE_AGENT); }
                    dead = true; break; }
                __builtin_amdgcn_s_sleep(2);
            }
            __builtin_amdgcn_fence(__ATOMIC_ACQUIRE, "agent");
            if (lane == 0) flag[0] = dead ? 1u : 0u;
        }
        asm volatile("s_waitcnt vmcnt(0) lgkmcnt(0)" ::: "memory"); __builtin_amdgcn_s_barrier(); asm volatile("" ::: "memory");
        const bool bad = flag[0] != 0u;
        if (lane < 32) {
            const unsigned long long* slot = (const unsigned long long*)xbuf + (size_t)(u.pm * BM + row) * 4; float mt[4], m2[4]; float ms = 0.f;
#pragma unroll
            for (int t = 0; t < 4; ++t) { if (t < ntn) { const unsigned long long w = __hip_atomic_load(slot + t, __ATOMIC_RELAXED, __HIP_MEMORY_SCOPE_AGENT); mt[t] = __uint_as_float((unsigned)w); m2[t] = __uint_as_float((unsigned)(w >> 32)); } else { mt[t] = 0.f; m2[t] = 0.f; } ms += mt[t]; }
            const float mean = ms / (float)ntn; float q = 0.f;
#pragma unroll
            for (int t = 0; t < 4; ++t) if (t < ntn) { const float dm = mt[t] - mean; q += m2[t] + 256.0f * dm * dm; }
            S[row] = (f32x2v){mean, 1.0f / sqrtf(q / (256.0f * (float)ntn) + eps)};
        }
        asm volatile("s_waitcnt lgkmcnt(0)" ::: "memory"); __builtin_amdgcn_s_barrier(); asm volatile("" ::: "memory");
        return bad;
    }
};
struct EpiLnRes {
    static constexpr bool PERM = false, AFTER_DRAIN = true;
    const float* base; float* out; int ldc; const float* bias; PanelStats st; unsigned poison;
    __device__ __forceinline__ void fused(f32x4 (&acc)[2][2][4][2], const Unit& u, int wr, int wc, int fr, int fq, PG8_LAS unsigned char* lds, int wid, int lane) const {
        typedef float f32x2v __attribute__((ext_vector_type(2)));
        const PG8_LAS f32x2v* S = (const PG8_LAS f32x2v*)(lds + 8192);
        const int col0 = u.pn * BM + wc * 32 + 4 * fq;
#pragma unroll
        for (int bj = 0; bj < 2; ++bj)
#pragma unroll
            for (int n = 0; n < 2; ++n) { const f32x4 bv = bias ? *(const f32x4*)(bias + col0 + bj * HALF + n * 16) : (f32x4){0.f, 0.f, 0.f, 0.f};
#pragma unroll
                for (int ai = 0; ai < 2; ++ai)
#pragma unroll
                    for (int m = 0; m < 4; ++m) acc[ai][bj][m][n] += bv; }
        f32x4 pre[4][2][2];
#pragma unroll
        for (int m = 0; m < 4; ++m) { const size_t off = (size_t)(u.pm * BM + wr * 64 + m * 16 + fr) * ldc + col0;
#pragma unroll
            for (int bj = 0; bj < 2; ++bj)
#pragma unroll
                for (int n = 0; n < 2; ++n) pre[m][bj][n] = *(const f32x4*)(base + off + bj * HALF + n * 16); }
        const bool bad = st.run(acc, u, wr, wc, fr, fq, lds, wid, lane) || poison != 0u;
        const float qnan = __builtin_nanf("");
#pragma unroll
        for (int ai = 0; ai < 2; ++ai)
#pragma unroll
            for (int m = 0; m < 4; ++m) { const int r = ai * HALF + wr * 64 + m * 16 + fr; const f32x2v sr = S[r]; const size_t off = (size_t)(u.pm * BM + r) * ldc + col0;
#pragma unroll
                for (int bj = 0; bj < 2; ++bj)
#pragma unroll
                    for (int n = 0; n < 2; ++n) { const f32x4 bs = ai == 0 ? pre[m][bj][n] : *(const f32x4*)(base + off + bj * HALF + n * 16); f32x4 o = bs + (acc[ai][bj][m][n] - sr.x) * sr.y;
                        if (bad) o = (f32x4){qnan, qnan, qnan, qnan}; *(f32x4*)(out + off + bj * HALF + n * 16) = o; }
                if (m & 1) asm volatile("" ::: "memory"); }
    }
};
struct EpiLnResLn {
    static constexpr bool PERM = false, AFTER_DRAIN = true;
    const float* base; float* out; bf16_t* xn; int ldc; const float* bias; PanelStats st1, st2; unsigned poison;
    __device__ __forceinline__ void fused(f32x4 (&acc)[2][2][4][2], const Unit& u, int wr, int wc, int fr, int fq, PG8_LAS unsigned char* lds, int wid, int lane) const {
        typedef float f32x2v __attribute__((ext_vector_type(2))); typedef unsigned u32x2v __attribute__((ext_vector_type(2)));
        const PG8_LAS f32x2v* S = (const PG8_LAS f32x2v*)(lds + 8192);
        const int col0 = u.pn * BM + wc * 32 + 4 * fq;
#pragma unroll
        for (int bj = 0; bj < 2; ++bj)
#pragma unroll
            for (int n = 0; n < 2; ++n) { const f32x4 bv = bias ? *(const f32x4*)(bias + col0 + bj * HALF + n * 16) : (f32x4){0.f, 0.f, 0.f, 0.f};
#pragma unroll
                for (int ai = 0; ai < 2; ++ai)
#pragma unroll
                    for (int m = 0; m < 4; ++m) acc[ai][bj][m][n] += bv; }
        bool bad = st1.run(acc, u, wr, wc, fr, fq, lds, wid, lane) || poison != 0u;
        const float qnan = __builtin_nanf("");
#pragma unroll
        for (int ai = 0; ai < 2; ++ai)
#pragma unroll
            for (int m = 0; m < 4; ++m) { const int r = ai * HALF + wr * 64 + m * 16 + fr; const f32x2v sr = S[r]; const size_t off = (size_t)(u.pm * BM + r) * ldc + col0;
#pragma unroll
                for (int bj = 0; bj < 2; ++bj)
#pragma unroll
                    for (int n = 0; n < 2; ++n) { const f32x4 bs = *(const f32x4*)(base + off + bj * HALF + n * 16); acc[ai][bj][m][n] = bs + (acc[ai][bj][m][n] - sr.x) * sr.y; }
                asm volatile("" : "+v"(acc[ai][0][m][0]), "+v"(acc[ai][0][m][1]), "+v"(acc[ai][1][m][0]), "+v"(acc[ai][1][m][1]));
                if (m & 1) asm volatile("" ::: "memory"); }
        const bool bad1 = bad;
        bad = st2.run(acc, u, wr, wc, fr, fq, lds, wid, lane) || bad;
#pragma unroll
        for (int ai = 0; ai < 2; ++ai)
#pragma unroll
            for (int m = 0; m < 4; ++m) { const int r = ai * HALF + wr * 64 + m * 16 + fr; const f32x2v sr = S[r]; const size_t off = (size_t)(u.pm * BM + r) * ldc + col0;
#pragma unroll
                for (int bj = 0; bj < 2; ++bj)
#pragma unroll
                    for (int n = 0; n < 2; ++n) { const f32x4 x1 = acc[ai][bj][m][n]; *(f32x4*)(out + off + bj * HALF + n * 16) = bad1 ? (f32x4){qnan, qnan, qnan, qnan} : x1;
                        const f32x4 o = (x1 - sr.x) * sr.y; u32x2v w; w.x = cvt_pk_bf16(o[0], o[1]); w.y = cvt_pk_bf16(o[2], o[3]);
                        if (bad) { w.x = 0x7fc07fc0u; w.y = 0x7fc07fc0u; } *(u32x2v*)(xn + off + bj * HALF + n * 16) = w; }
                asm volatile("" ::: "memory"); }
    }
};

template <class Epi, class Sched, bool ALIGN_EPI = false, bool SP2 = false, bool MID = false  >
__device__ __forceinline__ void gemm_phase(PG8_LAS unsigned char* lds, const Gemm g, const Sched& S, const Epi& E) {
    int tid_ = threadIdx.x; asm volatile("" : "+v"(tid_));
    const int tid = tid_, wid = __builtin_amdgcn_readfirstlane(tid >> 6), lane = tid & 63, wr = wid >> 2, wc = wid & 3, fr = lane & 15, fq = lane >> 4;
    const int K = g.K, nt = K / BK;
    unsigned voffA[2], voffB[2];
#pragma unroll
    for (int i = 0; i < 2; ++i) { int R, C; stage_rc(tid * 16 + i * 8192, R, C); const int Rb = Epi::PERM ? ((R & ~31) + perm32(R & 31)) : R;
        voffA[i] = (unsigned)(R * K + C) * 2u; voffB[i] = (unsigned)(Rb * K + C) * 2u; }
    const size_t kstep = (size_t)(BK * 2);
    const size_t hstep = (size_t)HALF * K * 2;
    const size_t tstep = 2 * hstep;
    const unsigned ldsw = (unsigned)wid * 1024u;
    const int aoff = lds_byte(wr * 64 + fr, fq * 8), boff = lds_byte(wc * 32 + fr, fq * 8);
#define PG8_SA(b, h) (((b) * 2 + (h)) * HTB)
#define PG8_SB(b, h) ((4 + (b) * 2 + (h)) * HTB)
#define PG8_STAGE(bufoff, gbase, voff) do { _Pragma("unroll") for (int _i = 0; _i < 2; ++_i) \
        __builtin_amdgcn_global_load_lds((const unsigned*)((const char*)(gbase) + (voff)[_i]), (PG8_LAS unsigned*)(lds + (bufoff) + ldsw + _i * 8192), 16, 0, 0); } while (0)
#define PG8_LDA(dst, b, h) do { _Pragma("unroll") for (int m = 0; m < 4; ++m) _Pragma("unroll") for (int k = 0; k < 2; ++k) dst[m][k] = *(const PG8_LAS bf16x8*)(lds + PG8_SA(b, h) + aoff + m * 2048 + k * 1024); } while (0)
#define PG8_LDB(dst, b, h) do { _Pragma("unroll") for (int n = 0; n < 2; ++n) _Pragma("unroll") for (int k = 0; k < 2; ++k) dst[n][k] = *(const PG8_LAS bf16x8*)(lds + PG8_SB(b, h) + boff + n * 2048 + k * 1024); } while (0)
#define PG8_MMA(ai, bj, At, Bt) do { __builtin_amdgcn_s_setprio(1); _Pragma("unroll") for (int m = 0; m < 4; ++m) _Pragma("unroll") for (int n = 0; n < 2; ++n) _Pragma("unroll") for (int k = 0; k < 2; ++k) \
        acc[ai][bj][m][n] = __builtin_amdgcn_mfma_f32_16x16x32_bf16(Bt[n][k], At[m][k], acc[ai][bj][m][n], 0, 0, 0); __builtin_amdgcn_s_setprio(0); } while (0)
#define PG8_WAIT_V(n) asm volatile("s_waitcnt vmcnt(" #n ")" ::: "memory")
#define PG8_WAIT_L(n) asm volatile("s_waitcnt lgkmcnt(" #n ")" ::: "memory")
#define PG8_BAR __builtin_amdgcn_s_barrier()
#define PG8_SCHED __builtin_amdgcn_sched_barrier(0)
    Unit cur, nxt; int ui = 0;
    if (!S.next(0, cur)) return;
    f32x4 acc[2][2][4][2];
#pragma unroll
    for (int a = 0; a < 2; ++a)
#pragma unroll
        for (int b = 0; b < 2; ++b)
#pragma unroll
            for (int m = 0; m < 4; ++m)
#pragma unroll
                for (int n = 0; n < 2; ++n) acc[a][b][m][n] = (f32x4){0.f, 0.f, 0.f, 0.f};
    bf16x8 At[4][2], B0[2][2], B1[2][2];
    const char* cA = (const char*)g.A + (size_t)cur.pm * tstep; const char* cB = (const char*)g.Bt + (size_t)cur.pn * tstep;
    S.a_ready(cur);
    if constexpr (SP2) {
        PG8_STAGE(PG8_SB(0, 0), cB, voffB); PG8_STAGE(PG8_SB(0, 1), cB + hstep, voffB); PG8_STAGE(PG8_SA(0, 0), cA, voffA); PG8_STAGE(PG8_SA(0, 1), cA + hstep, voffA);
        if (wr == 1) PG8_BAR;
        PG8_WAIT_V(2); PG8_BAR;
        PG8_STAGE(PG8_SB(1, 0), cB + kstep, voffB); PG8_STAGE(PG8_SA(1, 0), cA + kstep, voffA); PG8_STAGE(PG8_SB(1, 1), cB + hstep + kstep, voffB);
        PG8_WAIT_V(6); PG8_BAR;
    } else {
        PG8_STAGE(PG8_SB(0, 0), cB, voffB); PG8_STAGE(PG8_SA(0, 0), cA, voffA); PG8_STAGE(PG8_SB(0, 1), cB + hstep, voffB); PG8_STAGE(PG8_SA(0, 1), cA + hstep, voffA);
        if (wr == 1) PG8_BAR;
        PG8_WAIT_V(4); PG8_BAR;
        PG8_STAGE(PG8_SB(1, 0), cB + kstep, voffB); PG8_STAGE(PG8_SA(1, 0), cA + kstep, voffA); PG8_STAGE(PG8_SB(1, 1), cB + hstep + kstep, voffB);
        PG8_WAIT_V(6); PG8_BAR;
    }
    for (;;) {
        const bool has_next = S.next(ui + 1, nxt);
        const char* nA = has_next ? (const char*)g.A + (size_t)nxt.pm * tstep : cA; const char* nB = has_next ? (const char*)g.Bt + (size_t)nxt.pn * tstep : cB;
        for (int t = 0; t < nt; t += 2) {
            if constexpr (MID) { if (t == (nt >> 1)) E.mid(acc, cur, wr, wc, fr, fq); }
            const bool last = (t == nt - 2);
            const char* a1 = cA + (size_t)(t + 1) * kstep;
            const char* a2 = last ? nA : cA + (size_t)(t + 2) * kstep; const char* b2 = last ? nB : cB + (size_t)(t + 2) * kstep;
            const char* a3 = a2 + kstep; const char* b3 = b2 + kstep;
            if (last && has_next) S.a_ready(nxt);
            if constexpr (SP2) {
            PG8_LDB(B0, 0, 0); PG8_LDB(B1, 0, 1); PG8_SCHED; PG8_LDA(At, 0, 0); PG8_STAGE(PG8_SA(1, 1), a1 + hstep, voffA);
            PG8_WAIT_V(8); PG8_WAIT_L(0); PG8_BAR; PG8_MMA(0, 0, At, B0); PG8_MMA(0, 1, At, B1); PG8_BAR; PG8_SCHED;
            PG8_LDA(At, 0, 1); PG8_STAGE(PG8_SB(0, 0), b2, voffB); PG8_STAGE(PG8_SB(0, 1), b2 + hstep, voffB); PG8_STAGE(PG8_SA(0, 0), a2, voffA);
            PG8_WAIT_V(8); PG8_WAIT_L(0); PG8_BAR; PG8_MMA(1, 0, At, B0); PG8_MMA(1, 1, At, B1); PG8_BAR; PG8_SCHED;
            PG8_LDB(B0, 1, 0); PG8_LDB(B1, 1, 1); PG8_SCHED; PG8_LDA(At, 1, 0); PG8_STAGE(PG8_SA(0, 1), a2 + hstep, voffA);
            PG8_WAIT_V(8); PG8_WAIT_L(0); PG8_BAR; PG8_MMA(0, 0, At, B0); PG8_MMA(0, 1, At, B1); PG8_BAR; PG8_SCHED;
            PG8_LDA(At, 1, 1); PG8_STAGE(PG8_SB(1, 0), b3, voffB); PG8_STAGE(PG8_SB(1, 1), b3 + hstep, voffB); PG8_STAGE(PG8_SA(1, 0), a3, voffA);
            PG8_WAIT_V(8); PG8_WAIT_L(0); PG8_BAR; PG8_MMA(1, 0, At, B0); PG8_MMA(1, 1, At, B1); PG8_BAR; PG8_SCHED;
            } else {
            PG8_LDB(B0, 0, 0); PG8_SCHED; PG8_LDA(At, 0, 0); PG8_STAGE(PG8_SA(1, 1), a1 + hstep, voffA);
            PG8_WAIT_L(8); PG8_BAR; PG8_WAIT_L(0); PG8_MMA(0, 0, At, B0); PG8_BAR; PG8_SCHED;
            PG8_LDB(B1, 0, 1); PG8_STAGE(PG8_SB(0, 0), b2, voffB);
            PG8_BAR; PG8_WAIT_L(0); PG8_MMA(0, 1, At, B1); PG8_BAR;
            PG8_LDA(At, 0, 1); PG8_STAGE(PG8_SA(0, 0), a2, voffA);
            PG8_BAR; PG8_WAIT_L(0); PG8_MMA(1, 0, At, B0); PG8_BAR; PG8_SCHED;
            PG8_STAGE(PG8_SB(0, 1), b2 + hstep, voffB);
            PG8_WAIT_V(6); PG8_BAR; PG8_MMA(1, 1, At, B1); PG8_BAR;
            PG8_LDB(B0, 1, 0); PG8_SCHED; PG8_LDA(At, 1, 0); PG8_STAGE(PG8_SA(0, 1), a2 + hstep, voffA);
            PG8_WAIT_L(8); PG8_BAR; PG8_WAIT_L(0); PG8_MMA(0, 0, At, B0); PG8_BAR; PG8_SCHED;
            PG8_LDB(B1, 1, 1); PG8_STAGE(PG8_SB(1, 0), b3, voffB);
            PG8_BAR; PG8_WAIT_L(0); PG8_MMA(0, 1, At, B1); PG8_BAR;
            PG8_LDA(At, 1, 1); PG8_STAGE(PG8_SA(1, 0), a3, voffA);
            PG8_BAR; PG8_WAIT_L(0); PG8_MMA(1, 0, At, B0); PG8_BAR; PG8_SCHED;
            PG8_STAGE(PG8_SB(1, 1), b3 + hstep, voffB);
            PG8_WAIT_V(6); PG8_BAR; PG8_MMA(1, 1, At, B1); PG8_BAR;
            }
        }
        if constexpr (ALIGN_EPI) { if (wr == 0) PG8_BAR; }
        if constexpr (!Epi::AFTER_DRAIN) { E(acc, cur, wr, wc, fr, fq); S.done(cur); }
        if (!has_next) break;
#pragma unroll
        for (int a = 0; a < 2; ++a)
#pragma unroll
            for (int b = 0; b < 2; ++b)
#pragma unroll
                for (int m = 0; m < 4; ++m)
#pragma unroll
                    for (int n = 0; n < 2; ++n) acc[a][b][m][n] = (f32x4){0.f, 0.f, 0.f, 0.f};
        cur = nxt; cA = nA; cB = nB; ++ui;
        if constexpr (ALIGN_EPI) { if (wr == 1) PG8_BAR; }
    }
    PG8_WAIT_V(0);
    if constexpr (!ALIGN_EPI) { if (wr == 0) PG8_BAR; }
    PG8_BAR;
    if constexpr (Epi::AFTER_DRAIN) { E.fused(acc, cur, wr, wc, fr, fq, lds, wid, lane); S.done(cur); }
#undef PG8_SA
#undef PG8_SB
#undef PG8_STAGE
#undef PG8_LDA
#undef PG8_LDB
#undef PG8_MMA
#undef PG8_WAIT_V
#undef PG8_WAIT_L
#undef PG8_BAR
#undef PG8_SCHED
}
}
#include <hip/hip_bf16.h>
#include <cmath>
namespace attn2 {
using bf16=__hip_bfloat16;
using bf16x8=__attribute__((ext_vector_type(8)))short;
using s16x4=__attribute__((ext_vector_type(4)))short;
using f32x16=__attribute__((ext_vector_type(16)))float;
using f32x4=__attribute__((ext_vector_type(4)))float;
using u32x4=__attribute__((ext_vector_type(4)))unsigned;
using u32x2=__attribute__((ext_vector_type(2)))unsigned;
constexpr int BATCH=4,NHEAD=8,SEQ=8192,D=64,DM=NHEAD*D;
constexpr int OPITCH=1024; constexpr int NW=8,QBLK=32,QB=QBLK*NW,KVBLK=64,NQB=SEQ/QB;
__device__ __forceinline__ int crow(int r,int hi){return (r&3)+8*(r>>2)+4*hi;}
#define SBAR() __builtin_amdgcn_sched_barrier(0)
constexpr int NSLOT=3, SLOTB=8192;
constexpr int TBN=1344, TBSTRIDE=1360, TBOFF=1087;
constexpr int LDS_K=0, LDS_V=NSLOT*SLOTB, LDS_WS=2*NSLOT*SLOTB, LDS_OST=LDS_WS+NW*64*4, LDS_MASK=LDS_OST+NW*4096, LDS_TB=LDS_MASK+NSLOT*2048, LDS_BYTES=LDS_TB+4*TBSTRIDE*4;
__device__ __forceinline__ void glds16(const void*gsrc,unsigned lds_dst){unsigned keep;
  asm volatile("s_mov_b32 %0, m0\n\ts_mov_b32 m0, %2\n\ts_nop 0\n\tglobal_load_lds_dwordx4 %1, off\n\ts_mov_b32 m0, %0":"=&s"(keep):"v"(gsrc),"s"(lds_dst):"memory");}
__device__ __forceinline__ void glds4(const void*gsrc,unsigned lds_dst){unsigned keep;
  asm volatile("s_mov_b32 %0, m0\n\ts_mov_b32 m0, %2\n\ts_nop 0\n\tglobal_load_lds_dword %1, off\n\ts_mov_b32 m0, %0":"=&s"(keep):"v"(gsrc),"s"(lds_dst):"memory");}
typedef float f32x2_t __attribute__((ext_vector_type(2))); typedef __bf16 bf16x2_t __attribute__((ext_vector_type(2)));
__device__ __forceinline__ unsigned cvtpk_s(float lo,float hi){f32x2_t v={lo,hi};bf16x2_t b=__builtin_convertvector(v,bf16x2_t);return __builtin_bit_cast(unsigned,b);}
#define WAIT_BAR(N) asm volatile("s_waitcnt vmcnt(" #N ") lgkmcnt(0)\n\ts_barrier":::"memory")
typedef __attribute__((address_space(3))) const char* lds_cptr;
typedef short v4i16_t __attribute__((ext_vector_type(4)));
__device__ __forceinline__ void kload8(bf16x8*kf,lds_cptr kp){
  kf[0]=*(const __attribute__((address_space(3))) bf16x8*)(kp);      kf[1]=*(const __attribute__((address_space(3))) bf16x8*)(kp+512);
  kf[2]=*(const __attribute__((address_space(3))) bf16x8*)(kp+2048); kf[3]=*(const __attribute__((address_space(3))) bf16x8*)(kp+2560);
  kf[4]=*(const __attribute__((address_space(3))) bf16x8*)(kp+4096); kf[5]=*(const __attribute__((address_space(3))) bf16x8*)(kp+4608);
  kf[6]=*(const __attribute__((address_space(3))) bf16x8*)(kp+6144); kf[7]=*(const __attribute__((address_space(3))) bf16x8*)(kp+6656);
}
__device__ __forceinline__ void kload2(bf16x8*kf,lds_cptr kp,int j){ kf[2*j]=*(const __attribute__((address_space(3))) bf16x8*)(kp+j*2048); kf[2*j+1]=*(const __attribute__((address_space(3))) bf16x8*)(kp+j*2048+512); }
__device__ __forceinline__ s16x4 vtr(lds_cptr p){ return __builtin_bit_cast(s16x4,__builtin_amdgcn_ds_read_tr16_b64_v4i16((__attribute__((address_space(3))) v4i16_t*)p)); }
__device__ __forceinline__ float exm(float x,unsigned w,int pos){ return __uint_as_float(__float_as_uint(__builtin_amdgcn_exp2f(x))&(unsigned)__builtin_amdgcn_sbfe((int)w,pos,1)); }
__device__ __forceinline__ void cinit_near(f32x16&c0,f32x16&c1,lds_cptr tb){
  #pragma unroll
  for(int g=0;g<4;++g){ const f32x4 a=*(const __attribute__((address_space(3))) f32x4*)(tb+32*g), b=*(const __attribute__((address_space(3))) f32x4*)(tb+128+32*g);
    c0[4*g]=a[0];c0[4*g+1]=a[1];c0[4*g+2]=a[2];c0[4*g+3]=a[3]; c1[4*g]=b[0];c1[4*g+1]=b[1];c1[4*g+2]=b[2];c1[4*g+3]=b[3]; }
}
__device__ __forceinline__ void pv(f32x16*o,int vb,bf16x8 pa0,bf16x8 pa1,bf16x8 pa2,bf16x8 pa3){
  #pragma unroll
  for(int d0=0;d0<2;++d0){s16x4 lo[4],hi[4];
    #pragma unroll
    for(int ks=0;ks<4;++ks){
      asm volatile("ds_read_b64_tr_b16 %0,%1 offset:%c2":"=&v"(lo[ks]):"v"(vb),"i"(d0*4096+ks*1024):"memory");
      asm volatile("ds_read_b64_tr_b16 %0,%1 offset:%c2":"=&v"(hi[ks]):"v"(vb),"i"(d0*4096+ks*1024+512):"memory");}
    asm volatile("s_waitcnt lgkmcnt(0)":::"memory");SBAR();
    #define PK(k) (bf16x8){lo[k][0],lo[k][1],lo[k][2],lo[k][3],hi[k][0],hi[k][1],hi[k][2],hi[k][3]}
    o[d0]=__builtin_amdgcn_mfma_f32_32x32x16_bf16(pa0,PK(0),o[d0],0,0,0);
    o[d0]=__builtin_amdgcn_mfma_f32_32x32x16_bf16(pa1,PK(1),o[d0],0,0,0);
    o[d0]=__builtin_amdgcn_mfma_f32_32x32x16_bf16(pa2,PK(2),o[d0],0,0,0);
    o[d0]=__builtin_amdgcn_mfma_f32_32x32x16_bf16(pa3,PK(3),o[d0],0,0,0);
    #undef PK
  }
}
#ifndef ATTN_STORE16
#define ATTN_STORE16(p,v) (*(u32x4*)(p)=(v))
#endif
__device__ __forceinline__ void attn_unit(int b,int h,int qb,const bf16*Q,const bf16*__restrict__ K,const bf16*__restrict__ V,bf16*O,const unsigned*__restrict__ bm,const float*__restrict__ tabh,float mb,char*shm){
  const int tid=threadIdx.x,lane=tid&63,r32=lane&31,hi=lane>>5; const int wid=__builtin_amdgcn_readfirstlane(tid>>6);
  const long rowbase=(long)b*SEQ; const int q0=qb*QB;
  const bf16*Qw=Q+(rowbase+q0+wid*QBLK)*DM+h*D;
  const bf16*Kh=K+rowbase*DM+h*D,*Vh=V+rowbase*DM+h*D;
  const unsigned lds0=(unsigned)(uintptr_t)shm;
  float*wsf=(float*)(shm+LDS_WS)+wid*64;
  { float*tb=(float*)(shm+LDS_TB);
    for(int i=tid;i<4*TBSTRIDE;i+=NW*64){ const int k=i/TBSTRIDE,j=i-k*TBSTRIDE; tb[i]=((j+k<TBN)?tabh[j+k]:0.f)-mb; } }
  const bf16*ksrc=Kh+(long)lane*DM+wid*8;
  const bf16*vsrc=Vh+(long)(16*(wid&3)+(lane>>2))*DM+(wid>>2)*32+(lane&3)*8;
  const unsigned*msrc=bm+(rowbase+q0+wid*QBLK+(lane>>1))*256+(lane&1);
  const unsigned kdst=lds0+LDS_K+wid*1024, vdst=lds0+LDS_V+wid*1024, mdst=lds0+LDS_MASK+wid*256;
  #define DMA_K(t,slot) glds16(ksrc+(long)(t)*KVBLK*DM,(unsigned)__builtin_amdgcn_readfirstlane(kdst+(slot)))
  #define DMA_V(t,slot) glds16(vsrc+(long)(t)*KVBLK*DM,(unsigned)__builtin_amdgcn_readfirstlane(vdst+(slot)))
  #define DMA_M(t,slot) glds4(msrc+2*(t),(unsigned)__builtin_amdgcn_readfirstlane(mdst+((slot)>>2)))
  const int vb0=(int)(lds0+LDS_V)+((lane>>4)&1)*32+(lane&3)*8+(4*hi+((lane&15)>>2))*64;
  bf16x8 kf[8];
  const lds_cptr shm3=(lds_cptr)shm; const lds_cptr kp0=shm3+LDS_K+hi*1024+r32*16; const lds_cptr vp0=shm3+LDS_V+((lane>>4)&1)*32+(lane&3)*8+(4*hi+((lane&15)>>2))*64;
  const lds_cptr mp0=shm3+LDS_MASK+wid*256+r32*8;
  const int NT=(q0+QB)/KVBLK;
  const int qw=q0+wid*QBLK; int tn=(qw-622>=0)?((qw-622)/64+1):0; tn&=~1;
  const int qpos=qw+r32, idx0=4*hi+TBOFF-qpos, kcp=idx0&3;
  const lds_cptr tb0=shm3+LDS_TB+(kcp*TBSTRIDE+(idx0-kcp))*4;
  DMA_K(0,0);DMA_M(0,0);DMA_V(0,0);DMA_K(1,SLOTB);DMA_M(1,SLOTB);
  bf16x8 qr[4];
  #pragma unroll
  for(int d0=0;d0<4;++d0)qr[d0]=*reinterpret_cast<const bf16x8*>(&Qw[(long)r32*DM+d0*16+hi*8]);
  float l_reg=0.f;f32x16 o[2];o[0]=f32x16{};o[1]=f32x16{};
  f32x16 negm; { const float nf=tabh[0]-mb;
    #pragma unroll
    for(int r=0;r<16;++r)negm[r]=nf; } asm volatile("":"+v"(negm));
  f32x16 pA0,pA1,pB0,pB1;
  int sl_prev=0,sl_cur=0,sl_next=SLOTB;
  #define ROT() do{sl_prev=sl_cur;sl_cur=sl_next;sl_next=(sl_next==(NSLOT-1)*SLOTB)?0:sl_next+SLOTB;}while(0)
  DMA_K(2,2*SLOTB);
  WAIT_BAR(3);
  { const char*kb=shm+LDS_K+hi*1024+r32*16;
    if(tn>0){pA0=negm;pA1=negm;} else cinit_near(pA0,pA1,tb0);
    #pragma unroll
    for(int d0=0;d0<4;++d0){
      const bf16x8 b0=*reinterpret_cast<const bf16x8*>(kb+d0*2048);
      const bf16x8 b1=*reinterpret_cast<const bf16x8*>(kb+d0*2048+512);
      pA0=__builtin_amdgcn_mfma_f32_32x32x16_bf16(b0,qr[d0],pA0,0,0,0);pA1=__builtin_amdgcn_mfma_f32_32x32x16_bf16(b1,qr[d0],pA1,0,0,0);}
    const u32x2 mw=*(const __attribute__((address_space(3))) u32x2*)(mp0); const unsigned w0=mw.x>>(4*hi),w1=mw.y>>(4*hi);
    #pragma unroll
    for(int r=0;r<16;++r){pA0[r]=exm(pA0[r],w0,(r&3)+8*(r>>2));pA1[r]=exm(pA1[r],w1,(r&3)+8*(r>>2));} }
  WAIT_BAR(0);
  DMA_K(3,0);DMA_V(1,SLOTB);DMA_M(2,2*SLOTB);
  ROT();
  kload8(kf,kp0+sl_cur);
  WAIT_BAR(3);
  s16x4 vlo[8],vhi[8]; u32x4 pw0,pw1,pw2,pw3;
  #define PKW(P,B) cvtpk_s(P[B],P[B+1])
  #define PAF(k) __builtin_bit_cast(bf16x8,pw##k)
  #define VFR(i) (bf16x8){vlo[i][0],vlo[i][1],vlo[i][2],vlo[i][3],vhi[i][0],vhi[i][1],vhi[i][2],vhi[i][3]}
  #define PIN(x) asm volatile("":"+v"(x))
  #define GAPA(MF,A0,A1,A2,A3,W0,W1,PW) do{ MF; sacc+=A0; sacc+=A1; sacc+=A2; sacc+=A3; PIN(sacc); W0; W1; PIN(PW); SBAR(); }while(0)
  #define EXB(x,T,I) __uint_as_float(__float_as_uint(__builtin_amdgcn_exp2f(x))&(unsigned)__builtin_amdgcn_sbfe((int)(T),8*(I),8))
  #define EXM4(X,A,T) do{ X[A]=EXB(X[A],T,0); X[(A)+4]=EXB(X[(A)+4],T,1); X[(A)+8]=EXB(X[(A)+8],T,2); X[(A)+12]=EXB(X[(A)+12],T,3); }while(0)
  #define GAPB(MF,X,A,TB) do{ MF; { unsigned t_=(TB)<<(3-(A)); asm("":"+v"(t_)); EXM4(X,A,t_); } PIN(X); SBAR(); }while(0)
  #define VRD(i) do{ vlo[i]=vtr(vp_+(((i)>>2)*4096+((i)&3)*1024)); vhi[i]=vtr(vp_+(((i)>>2)*4096+((i)&3)*1024+512)); }while(0)
  #define KRD(G,j) do{ if(G){ kload2(kf,kp0+sl_next,j); SBAR(); } }while(0)
  #define STEP(C0,C1,P0,P1,t,GK,GV,GM,GL,NEAR) do{ SBAR(); \
    const lds_cptr vp_=vp0+sl_prev; \
    if(NEAR){ cinit_near(C0,C1,tb0+256*(t)); SBAR(); } \
    VRD(0); SBAR(); float sacc=(P0[0]+P0[1]); \
    GAPA(C0=__builtin_amdgcn_mfma_f32_32x32x16_bf16(kf[0],qr[0],(NEAR)?C0:negm,0,0,0), P0[2],P0[3],P0[4],P0[5],     pw0[0]=PKW(P0,0), pw0[1]=PKW(P0,2), pw0); \
    VRD(4); SBAR(); GAPA(C1=__builtin_amdgcn_mfma_f32_32x32x16_bf16(kf[1],qr[0],(NEAR)?C1:negm,0,0,0), P0[6],P0[7],P0[8],P0[9],     pw0[2]=PKW(P0,4), pw0[3]=PKW(P0,6), pw0); \
    VRD(1); SBAR(); GAPA(C0=__builtin_amdgcn_mfma_f32_32x32x16_bf16(kf[2],qr[1],C0,0,0,0),   P0[10],P0[11],P0[12],P0[13], pw1[0]=PKW(P0,8), pw1[1]=PKW(P0,10), pw1); \
    VRD(5); SBAR(); GAPA(C1=__builtin_amdgcn_mfma_f32_32x32x16_bf16(kf[3],qr[1],C1,0,0,0),   P0[14],P0[15],P1[0],P1[1],   pw1[2]=PKW(P0,12),pw1[3]=PKW(P0,14), pw1); \
    VRD(2); SBAR(); GAPA(C0=__builtin_amdgcn_mfma_f32_32x32x16_bf16(kf[4],qr[2],C0,0,0,0),   P1[2],P1[3],P1[4],P1[5],     pw2[0]=PKW(P1,0), pw2[1]=PKW(P1,2), pw2); \
    VRD(6); SBAR(); GAPA(C1=__builtin_amdgcn_mfma_f32_32x32x16_bf16(kf[5],qr[2],C1,0,0,0),   P1[6],P1[7],P1[8],P1[9],     pw2[2]=PKW(P1,4), pw2[3]=PKW(P1,6), pw2); \
    VRD(3); SBAR(); GAPA(C0=__builtin_amdgcn_mfma_f32_32x32x16_bf16(kf[6],qr[3],C0,0,0,0),   P1[10],P1[11],P1[12],P1[13], pw3[0]=PKW(P1,8), pw3[1]=PKW(P1,10), pw3); \
    VRD(7); SBAR(); GAPA(C1=__builtin_amdgcn_mfma_f32_32x32x16_bf16(kf[7],qr[3],C1,0,0,0),   P1[14],P1[15],0.f,0.f,       pw3[2]=PKW(P1,12),pw3[3]=PKW(P1,14), pw3); \
    l_reg+=sacc; \
    if(GK){DMA_K((t)+3,sl_cur);} if(GV){DMA_V((t)+1,sl_next);} if(GM){DMA_M((t)+2,sl_prev);} \
    const u32x2 mw_=*(const __attribute__((address_space(3))) u32x2*)(mp0+(sl_cur>>2)); const unsigned w0_=mw_.x<<(4-4*hi),w1_=mw_.y<<(4-4*hi); \
    SBAR(); \
    GAPB(o[0]=__builtin_amdgcn_mfma_f32_32x32x16_bf16(PAF(0),VFR(0),o[0],0,0,0), C0,0,w0_); \
    GAPB(o[1]=__builtin_amdgcn_mfma_f32_32x32x16_bf16(PAF(0),VFR(4),o[1],0,0,0), C0,1,w0_); \
    KRD(GL,0); GAPB(o[0]=__builtin_amdgcn_mfma_f32_32x32x16_bf16(PAF(1),VFR(1),o[0],0,0,0), C0,2,w0_); \
    KRD(GL,1); GAPB(o[1]=__builtin_amdgcn_mfma_f32_32x32x16_bf16(PAF(1),VFR(5),o[1],0,0,0), C0,3,w0_); \
    KRD(GL,2); GAPB(o[0]=__builtin_amdgcn_mfma_f32_32x32x16_bf16(PAF(2),VFR(2),o[0],0,0,0), C1,0,w1_); \
    KRD(GL,3); GAPB(o[1]=__builtin_amdgcn_mfma_f32_32x32x16_bf16(PAF(2),VFR(6),o[1],0,0,0), C1,1,w1_); \
    GAPB(o[0]=__builtin_amdgcn_mfma_f32_32x32x16_bf16(PAF(3),VFR(3),o[0],0,0,0), C1,2,w1_); \
    GAPB(o[1]=__builtin_amdgcn_mfma_f32_32x32x16_bf16(PAF(3),VFR(7),o[1],0,0,0), C1,3,w1_); \
    }while(0)
  int t=1;
  for(;t+5<NT&&t+1<tn;t+=2){
    STEP(pB0,pB1,pA0,pA1,t,true,true,true,true,false);     WAIT_BAR(3); ROT();
    STEP(pA0,pA1,pB0,pB1,t+1,true,true,true,true,false);   WAIT_BAR(3); ROT();
  }
  for(;t+5<NT;t+=2){
    STEP(pB0,pB1,pA0,pA1,t,true,true,true,true,true);     WAIT_BAR(3); ROT();
    STEP(pA0,pA1,pB0,pB1,t+1,true,true,true,true,true);   WAIT_BAR(3); ROT();
  }
  #define ENDW(tt) do{ if((tt)+3<NT){WAIT_BAR(3);} else if((tt)+2<NT){WAIT_BAR(2);} else {WAIT_BAR(0);} }while(0)
  for(;t+1<NT;t+=2){
    STEP(pB0,pB1,pA0,pA1,t,(t+3<NT),(t+1<NT),(t+2<NT),(t+1<NT),true);       ENDW(t);   ROT();
    STEP(pA0,pA1,pB0,pB1,t+1,(t+4<NT),(t+2<NT),(t+3<NT),(t+2<NT),true);     ENDW(t+1); ROT();
  }
  STEP(pB0,pB1,pA0,pA1,NT-1,false,false,false,false,true);
  { float sacc=pB0[0]+pB0[1]; _Pragma("unroll") for(int r=2;r<16;++r)sacc+=pB0[r]; _Pragma("unroll") for(int r=0;r<16;++r)sacc+=pB1[r]; l_reg+=sacc;
    pw0=(u32x4){PKW(pB0,0),PKW(pB0,2),PKW(pB0,4),PKW(pB0,6)};pw1=(u32x4){PKW(pB0,8),PKW(pB0,10),PKW(pB0,12),PKW(pB0,14)};pw2=(u32x4){PKW(pB1,0),PKW(pB1,2),PKW(pB1,4),PKW(pB1,6)};pw3=(u32x4){PKW(pB1,8),PKW(pB1,10),PKW(pB1,12),PKW(pB1,14)};
    SBAR(); pv(o,vb0+sl_cur,PAF(0),PAF(1),PAF(2),PAF(3)); }
  #undef PKW
  #undef PAF
  #undef VFR
  #undef PIN
  #undef GAPA
  #undef GAPB
  #undef VRD
  #undef KRD
  #undef STEP
  #undef ENDW
  {auto rr=__builtin_amdgcn_permlane32_swap(__float_as_uint(l_reg),__float_as_uint(l_reg),false,false);l_reg=__uint_as_float(rr[0])+__uint_as_float(rr[1]);}
  if(hi==0)wsf[32+r32]=l_reg;asm volatile("s_waitcnt lgkmcnt(0)":::"memory");
  float rli[16];
  #pragma unroll
  for(int r=0;r<16;++r)rli[r]=__builtin_amdgcn_rcpf(wsf[32+crow(r,hi)]);
  bf16*Ow=O+(rowbase+q0+wid*QBLK)*OPITCH+h*D;
  { bf16*stg=(bf16*)(shm+LDS_OST)+wid*2048;
    #pragma unroll
    for(int r=0;r<16;++r){const int orow=crow(r,hi);
      #pragma unroll
      for(int d0=0;d0<2;++d0)stg[orow*64+d0*32+r32]=__float2bfloat16(o[d0][r]*rli[r]);}
    asm volatile("s_waitcnt lgkmcnt(0)":::"memory");
    #pragma unroll
    for(int i=0;i<4;++i){const int row=i*8+(lane>>3),ch=lane&7; const u32x4 v=*(const u32x4*)(stg+row*64+ch*8); ATTN_STORE16(Ow+(long)row*OPITCH+ch*8,v);} }
  asm volatile("s_waitcnt lgkmcnt(0)\n\ts_barrier":::"memory");
  #undef DMA_K
  #undef DMA_V
  #undef DMA_M
  #undef ROT
}
constexpr int ATTN_LDS_BYTES=LDS_BYTES;
struct AttnUnit { int bh; int qb; };
struct StaticOrder {
  int vcu,grid;
  __device__ __forceinline__ explicit StaticOrder(int g,int block):vcu((g%8==0)?(block%8)*(g/8)+block/8:block),grid(g){}
  __device__ __forceinline__ bool next(int i,AttnUnit&u)const{
    if(grid==256){ if(i>=4)return false; const int s=vcu&7; u.bh=vcu>>3; u.qb=(i==0)?s:(i==1)?15-s:(i==2)?16+s:31-s; return true; }
    const int L=i*grid+vcu; if(L>=BATCH*NHEAD*NQB)return false; u.bh=L/NQB; u.qb=L%NQB; return true; }
};
__device__ __forceinline__ void attn_phase(char*lds,const bf16*Q,const bf16*K,const bf16*V,bf16*O,const unsigned*bm,const float*tab,const float*mbp,const StaticOrder&S){
  AttnUnit u; const float mb=*mbp;
  for(int i=0;S.next(i,u);++i){ attn_unit(u.bh/NHEAD,u.bh%NHEAD,u.qb,Q,K,V,O,bm,tab+(u.bh%NHEAD)*TBN,mb,lds); }
}
#undef SBAR
#undef WAIT_BAR
}

constexpr int NWAVES = 8;
constexpr int BATCH = 4, SEQ = 8192, M = BATCH * SEQ, D = 1024;
constexpr int AW = 512, NH = 8, HD = 64, TOPK = 256;
constexpr int NIN = 5376;
constexpr int PEER_H = 8, NKEYS = 128, PTOPK = 16, PLE = 256, CONVW = 31;
constexpr float EPS = 1e-6f, LOG2E = 1.4426950408889634f;
constexpr float C2 = 0.125f * LOG2E;
constexpr float IDX_SCALE = 0.125f * 0.35355339059327373f;
constexpr int TABN = 1344, TABOFF = 1087;

constexpr size_t MiB = 1u << 20;
constexpr size_t WS_CTL = 0, CTL_ZERO_BYTES = 1 * MiB;
constexpr size_t WS_SS1 = 512 * 1024;
constexpr size_t WS_RSTD1 = 1 * MiB, WS_RSTD3 = 1 * MiB + 128 * 1024, WS_TAB = 1 * MiB + 256 * 1024;
constexpr size_t WS_WI = 2 * MiB, WS_KI = 3 * MiB;
constexpr size_t WS_WIN = 8 * MiB, WS_WA = 19 * MiB, WS_WC = 20 * MiB, WS_WOUT = 21 * MiB, WS_WQ = 23 * MiB, WS_WG = 27 * MiB, WS_WP = 29 * MiB, WS_SUBK = 29 * MiB + 512 * 1024;
constexpr size_t WS_EU = 30 * MiB, WS_EV = 62 * MiB, WS_PB = 94 * MiB;
constexpr size_t WS_RC = 110 * MiB;
constexpr size_t WS_RD = 174 * MiB;
constexpr size_t WS_RB = 238 * MiB;
constexpr size_t WS_RA = 366 * MiB;
constexpr size_t WS_END = 494 * MiB;
constexpr int CW_TMO = 0, CW_CODE = 1, CW_BAR = 4096;

constexpr int RING_OFF = 0, RING_BYTES = 131072;
constexpr int LDSCTL_OFF = RING_BYTES, MISC_OFF = LDSCTL_OFF + 320;
constexpr int LDS_BYTES = 147456;

#define GAS __attribute__((address_space(1)))
#define LAS __attribute__((address_space(3)))
typedef unsigned short bf16;
typedef unsigned v4u __attribute__((ext_vector_type(4)));
typedef unsigned v2u __attribute__((ext_vector_type(2)));
typedef float f32x4 __attribute__((ext_vector_type(4)));
typedef __bf16 bf2_t __attribute__((ext_vector_type(2)));
#define LDS_WAIT() asm volatile("s_waitcnt lgkmcnt(0)" ::: "memory")
#define VM_WAIT() asm volatile("s_waitcnt vmcnt(0)" ::: "memory")
typedef float f32x2cv __attribute__((ext_vector_type(2))); typedef __bf16 bf16x2cv __attribute__((ext_vector_type(2)));
__device__ __forceinline__ unsigned pk2(float lo, float hi) { return __builtin_bit_cast(unsigned, __builtin_convertvector((f32x2cv){lo, hi}, bf16x2cv)); }
__device__ __forceinline__ unsigned f2bf(float f) { return pk2(f, 0.f) & 0xffffu; }
__device__ __forceinline__ float bflo(unsigned w) { return __uint_as_float(w << 16); }
__device__ __forceinline__ float bfhi(unsigned w) { return __uint_as_float(w & 0xffff0000u); }
__device__ __forceinline__ float bf1(bf16 b) { return __uint_as_float((unsigned)b << 16); }
__device__ __forceinline__ float dot2(unsigned a, unsigned b, float c) { return __builtin_amdgcn_fdot2_f32_bf16(__builtin_bit_cast(bf2_t, a), __builtin_bit_cast(bf2_t, b), c, false); }
__device__ __forceinline__ float dot8(v4u a, v4u b, float c) { c = dot2(a.x, b.x, c); c = dot2(a.y, b.y, c); c = dot2(a.z, b.z, c); return dot2(a.w, b.w, c); }
__device__ __forceinline__ float sigmoidf_(float x) { return __builtin_amdgcn_rcpf(1.0f + __builtin_amdgcn_exp2f(-LOG2E * x)); }
__device__ __forceinline__ float sigmoid255(float x) { return __builtin_amdgcn_rcpf((1.0f / 255.0f) + __builtin_amdgcn_exp2f(__builtin_fmaf(x, -LOG2E, -7.99435343686f))); }
__device__ __forceinline__ float gelu_tanh(float x) { const float y = 0.7978845608028654f * (x + 0.044715f * x * x * x); return x * __builtin_amdgcn_rcpf(1.0f + __builtin_amdgcn_exp2f(-2.0f * LOG2E * y)); }
__device__ __forceinline__ unsigned sortable(float f) { const unsigned u = __float_as_uint(f); return (u & 0x80000000u) ? ~u : (u | 0x80000000u); }
__device__ __forceinline__ float wave_sum(float v);
#define DPP_F(V, CTRL) __uint_as_float((unsigned)__builtin_amdgcn_update_dpp(0, (int)__float_as_uint(V), CTRL, 0xF, 0xF, false))
__device__ __forceinline__ float lane_xor1(float v) { return DPP_F(v, 0xB1); }
__device__ __forceinline__ float lane_xor2(float v) { return DPP_F(v, 0x4E); }
__device__ __forceinline__ float lane_xor8(float v) { return DPP_F(v, 0x128); }
__device__ __forceinline__ float lane_xor4(float v, bool hi4) { const float up = DPP_F(v, 0x104), dn = DPP_F(v, 0x114); return hi4 ? dn : up; }
__device__ __forceinline__ float half_sum_f(float v) {
    v += DPP_F(v, 0xB1); v += DPP_F(v, 0x4E); v += DPP_F(v, 0x141); v += DPP_F(v, 0x140);
    const auto sw = __builtin_amdgcn_permlane16_swap(__float_as_uint(v), __float_as_uint(v), false, false); return __uint_as_float(sw[0]) + __uint_as_float(sw[1]); }
__device__ __forceinline__ float xor16_sum(float v) { const auto sw = __builtin_amdgcn_permlane16_swap(__float_as_uint(v), __float_as_uint(v), false, false); return __uint_as_float(sw[0]) + __uint_as_float(sw[1]); }
__device__ __forceinline__ float xor32_sum(float v) { const auto sw = __builtin_amdgcn_permlane32_swap(__float_as_uint(v), __float_as_uint(v), false, false); return __uint_as_float(sw[0]) + __uint_as_float(sw[1]); }
__device__ __forceinline__ float wave_sum(float v) { return xor32_sum(half_sum_f(v)); }
__device__ __forceinline__ float wave_max(float v) {
#pragma unroll
    for (int o = 1; o < 64; o <<= 1) v = fmaxf(v, __shfl_xor(v, o));
    return v;
}
__device__ __forceinline__ unsigned long long wave_max_u64(unsigned long long v) {
#pragma unroll
    for (int o = 1; o < 64; o <<= 1) { const unsigned lo = __shfl_xor((unsigned)v, o), hi = __shfl_xor((unsigned)(v >> 32), o); const unsigned long long w = ((unsigned long long)hi << 32) | lo; v = w > v ? w : v; }
    return v;
}

__device__ __forceinline__ int opaque_i(int v) { asm volatile("" : "+s"(v)); return v; }
#define XB_TMO      128
#define XB_XCNT(j)  (256  + 64 * (j))
#define XB_XSUB(j)  (1280 + 64 * (j))
#define XB_XGEN(j)  (2304 + 64 * (j))
#define XB_TOP      3328
#define XB_TOPGEN   3392
#define XCD_BAR_WORDS 3456
#define XB_SPIN_CAP (1u << 18)
__device__ __forceinline__ unsigned xb_ld(unsigned* p)              { return __hip_atomic_load(p, __ATOMIC_RELAXED, __HIP_MEMORY_SCOPE_AGENT); }
__device__ __forceinline__ unsigned xb_add(unsigned* p, unsigned v) { return __hip_atomic_fetch_add(p, v, __ATOMIC_RELAXED, __HIP_MEMORY_SCOPE_AGENT); }
__device__ __forceinline__ unsigned xb_xcc_id() { return (unsigned)__builtin_amdgcn_s_getreg((3 << 11) | 20) & 0xFu; }
#define XB_SPIN(cond, bar) do { unsigned _sp = 0; while (cond) { __builtin_amdgcn_s_sleep(1); \
    if ((++_sp & 255u) == 0u) { if (xb_ld(&(bar)[XB_TMO])) break; if (_sp > XB_SPIN_CAP) { atomicAdd(&(bar)[XB_TMO], 1u); break; } } } } while (0)
struct XcdBarrier { unsigned* bar; unsigned x; volatile LAS unsigned* st; };
__device__ __forceinline__ XcdBarrier xcd_barrier_post(unsigned* bar, volatile LAS unsigned* st) {
    XcdBarrier b; b.bar = bar; b.x = xb_xcc_id(); b.st = st;
    if (threadIdx.x == 0) (void)xb_add(&bar[XB_XCNT(b.x)], 1u);
    return b;
}
__device__ __forceinline__ void xcd_barrier_complete(unsigned* bar, unsigned x, unsigned& nloc, unsigned& nx) {
    const unsigned G = gridDim.x * gridDim.y * gridDim.z;
    unsigned sum, cnt, mine, sp = 0u;
    for (;;) {
        sum = 0u; cnt = 0u; mine = 0u;
#pragma unroll
        for (unsigned j = 0; j < 16; ++j) { const unsigned c = xb_ld(&bar[XB_XCNT(j)]); sum += c; cnt += (c > 0u) ? 1u : 0u; mine = (j == x) ? c : mine; }
        if (sum == G) break;
        __builtin_amdgcn_s_sleep(1);
        if ((++sp & 255u) == 0u) { if (xb_ld(&bar[XB_TMO])) break; if (sp > XB_SPIN_CAP) { atomicAdd(&bar[XB_TMO], 1u); break; } }
    }
    nloc = mine > 0u ? mine : 1u; nx = cnt > 0u ? cnt : 1u;
}
__device__ __forceinline__ void xcd_barrier(const XcdBarrier& b) {
    asm volatile("s_waitcnt vmcnt(0)" ::: "memory");
    __syncthreads();
    if (threadIdx.x == 0) {
        unsigned* bar = b.bar;
        __builtin_amdgcn_s_waitcnt(0);
        unsigned nloc = b.st[0], nx = b.st[1];
        if (nloc == 0u) { xcd_barrier_complete(bar, b.x, nloc, nx); b.st[0] = nloc; b.st[1] = nx; }
        const unsigned old = xb_add(&bar[XB_XSUB(b.x)], 1u);
        const unsigned gen = old / nloc;
        if (old + 1u == (gen + 1u) * nloc) {
            __builtin_amdgcn_fence(__ATOMIC_RELEASE, "agent");
            asm volatile("s_waitcnt vmcnt(0)" ::: "memory");
            const unsigned og = xb_add(&bar[XB_TOP], 1u);
            const unsigned tg = og / nx;
            if (og + 1u == (tg + 1u) * nx) xb_add(&bar[XB_TOPGEN], 1u);
            else XB_SPIN(xb_ld(&bar[XB_TOPGEN]) == tg, bar);
            __builtin_amdgcn_fence(__ATOMIC_ACQUIRE, "agent");
            xb_add(&bar[XB_XGEN(b.x)], 1u);
            asm volatile("s_waitcnt vmcnt(0)" ::: "memory");
        } else {
            XB_SPIN(xb_ld(&bar[XB_XGEN(b.x)]) == gen, bar);
            __builtin_amdgcn_fence(__ATOMIC_ACQUIRE, "agent");
            asm volatile("s_waitcnt vmcnt(0)" ::: "memory");
        }
    }
    __syncthreads();
}

struct Frame {
    LAS unsigned char* lds;
    volatile LAS unsigned* MISC;
    unsigned* ctl;
    int tid, lane, wave, G, gw, NGW;
    const float *x, *p, *rel_bias, *attn_g, *w_in, *b_gate, *q_g, *k_g, *w_att, *conv_w, *conv_b, *ln_g, *ln_b, *w_conv, *w_out, *ffn_g, *w_pq, *subk, *pu, *pv, *ple_g, *w_pg, *w_pp;
    float* out;
    float *ss1, *ss2, *rstd1, *rstd3, *tab, *mb, *WI;
    bf16 *KI, *Win_t, *Wa_t, *Wc_t, *Wout_t, *Wq_t, *Wg_t, *Wp_t, *SUBK, *EU, *EV, *PB;
    bf16 *XB, *ATT, *CV, *UB, *MIX, *PP, *Q, *K, *V, *QI, *GB, *QP;
    unsigned* bitmap;
};

namespace epi {
using pg8::f32x4; using pg8::u32x4; using pg8::Unit; using pg8::bf16_t;
__device__ __forceinline__ u32x4 pack8(const float* v) { u32x4 w; w.x = pk2(v[0], v[1]); w.y = pk2(v[2], v[3]); w.z = pk2(v[4], v[5]); w.w = pk2(v[6], v[7]); return w; }
__device__ __forceinline__ void unpack8(u32x4 w, float* v) { v[0] = bflo(w.x); v[1] = bfhi(w.x); v[2] = bflo(w.y); v[3] = bfhi(w.y); v[4] = bflo(w.z); v[5] = bfhi(w.z); v[6] = bflo(w.w); v[7] = bfhi(w.w); }

struct EpiInProj {
    static constexpr bool PERM = true, AFTER_DRAIN = false;
    const float* rstd; bf16_t *Q, *K, *V, *QI, *U, *G, *KI; float* WI; const float *qg, *kg, *bgate;
    __device__ __forceinline__ void operator()(const f32x4 (&acc)[2][2][4][2], const Unit& u, int wr, int wc, int fr, int fq) const {
        const int pn = u.pn, row0 = u.pm * 256 + wr * 64 + fr;
        if (pn < 4) {
            const bool isq = pn < 2; const float* g = isq ? qg : kg; bf16_t* O = isq ? Q : K; const float sc = isq ? C2 : 1.0f;
            const int head = (pn & 1) * 4 + wc;
            float gv[2][8];
#pragma unroll
            for (int bj = 0; bj < 2; ++bj)
#pragma unroll
                for (int j = 0; j < 8; ++j) gv[bj][j] = g[32 * bj + 8 * fq + j];
#pragma unroll
            for (int ai = 0; ai < 2; ++ai)
#pragma unroll
                for (int m = 0; m < 4; ++m) {
                    const int row = row0 + ai * 128 + m * 16; const float rs = rstd[row];
                    float v[2][8]; float ss = 0.f;
#pragma unroll
                    for (int bj = 0; bj < 2; ++bj)
#pragma unroll
                        for (int n = 0; n < 2; ++n)
#pragma unroll
                            for (int i = 0; i < 4; ++i) { const float xv = acc[ai][bj][m][n][i] * rs; v[bj][4 * n + i] = xv; ss += xv * xv; }
                    ss = xor32_sum(xor16_sum(ss));
                    const float inv = rsqrtf(ss * (1.0f / 64.0f) + EPS) * sc;
#pragma unroll
                    for (int bj = 0; bj < 2; ++bj) { float o[8];
#pragma unroll
                        for (int j = 0; j < 8; ++j) o[j] = v[bj][j] * inv * gv[bj][j];
                        *(u32x4*)(O + (size_t)row * AW + head * 64 + 32 * bj + 8 * fq) = pack8(o); }
                }
        } else if (pn < 8) {
            bf16_t* O = pn < 6 ? V : QI; const int cb = (pn & 1) * 256 + 32 * wc + 8 * fq;
#pragma unroll
            for (int ai = 0; ai < 2; ++ai)
#pragma unroll
                for (int m = 0; m < 4; ++m) {
                    const int row = row0 + ai * 128 + m * 16; const float rs = rstd[row];
#pragma unroll
                    for (int bj = 0; bj < 2; ++bj) { float o[8];
#pragma unroll
                        for (int n = 0; n < 2; ++n)
#pragma unroll
                            for (int i = 0; i < 4; ++i) o[4 * n + i] = acc[ai][bj][m][n][i] * rs;
                        *(u32x4*)(O + (size_t)row * AW + cb + 128 * bj) = pack8(o); }
                }
        } else if (pn < 12) {
            const int ch0 = (pn - 8) * 128 + 32 * wc + 8 * fq;
#pragma unroll
            for (int ai = 0; ai < 2; ++ai)
#pragma unroll
                for (int m = 0; m < 4; ++m) {
                    const int row = row0 + ai * 128 + m * 16; const float rs = rstd[row]; float o[8];
#pragma unroll
                    for (int n = 0; n < 2; ++n)
#pragma unroll
                        for (int i = 0; i < 4; ++i) { const float a = acc[ai][0][m][n][i] * rs, gg = acc[ai][1][m][n][i] * rs; o[4 * n + i] = a * sigmoidf_(gg); }
                    *(u32x4*)(U + (size_t)row * 512 + ch0) = pack8(o);
                }
        } else if (pn < 20) {
            const int cb = (pn - 12) * 256 + 32 * wc + 8 * fq;
            float bv[2][8];
#pragma unroll
            for (int bj = 0; bj < 2; ++bj)
#pragma unroll
                for (int j = 0; j < 8; ++j) bv[bj][j] = bgate[cb + 128 * bj + j];
#pragma unroll
            for (int ai = 0; ai < 2; ++ai)
#pragma unroll
                for (int m = 0; m < 4; ++m) {
                    const int row = row0 + ai * 128 + m * 16; const float rs = rstd[row];
#pragma unroll
                    for (int bj = 0; bj < 2; ++bj) { float o[8];
#pragma unroll
                        for (int n = 0; n < 2; ++n)
#pragma unroll
                            for (int i = 0; i < 4; ++i) o[4 * n + i] = sigmoid255(acc[ai][bj][m][n][i] * rs + bv[bj][4 * n + i]);
                        unsigned w0 = 0u, w1 = 0u;
#pragma unroll
                        for (int i = 0; i < 4; ++i) { w0 = __builtin_amdgcn_cvt_pk_u8_f32(fmaxf(o[i], 1.0f), i, w0); w1 = __builtin_amdgcn_cvt_pk_u8_f32(fmaxf(o[4 + i], 1.0f), i, w1); }
                        *(v2u*)((unsigned char*)G + (size_t)row * 2048 + cb + 128 * bj) = (v2u){w0, w1}; }
                }
        } else {
#pragma unroll
            for (int ai = 0; ai < 2; ++ai)
#pragma unroll
                for (int m = 0; m < 4; ++m) {
                    const int row = row0 + ai * 128 + m * 16; const float rs = rstd[row]; float o[8];
#pragma unroll
                    for (int n = 0; n < 2; ++n)
#pragma unroll
                        for (int i = 0; i < 4; ++i) o[4 * n + i] = acc[ai][0][m][n][i] * rs;
                    if (wc < 2) *(u32x4*)(KI + (size_t)row * 64 + 32 * wc + 8 * fq) = pack8(o);
                    else if (wc == 2 && fq == 0) {
                        *(f32x4*)(WI + (size_t)row * 8) = (f32x4){o[0] * IDX_SCALE, o[1] * IDX_SCALE, o[2] * IDX_SCALE, o[3] * IDX_SCALE};
                        *(f32x4*)(WI + (size_t)row * 8 + 4) = (f32x4){o[4] * IDX_SCALE, o[5] * IDX_SCALE, o[6] * IDX_SCALE, o[7] * IDX_SCALE}; }
                }
        }
    }
};
template <bool ADD> struct EpiGate {
    static constexpr bool PERM = true, AFTER_DRAIN = false;
    const bf16_t* G; int goff; bf16_t* O;
    __device__ __forceinline__ void operator()(const f32x4 (&acc)[2][2][4][2], const Unit& u, int wr, int wc, int fr, int fq) const {
        const int row0 = u.pm * 256 + wr * 64 + fr, col0 = u.pn * 256 + 32 * wc + 8 * fq;
#pragma unroll
        for (int ai = 0; ai < 2; ++ai)
#pragma unroll
            for (int m = 0; m < 4; ++m) { const int row = row0 + ai * 128 + m * 16;
#pragma unroll
                for (int bj = 0; bj < 2; ++bj) { const int col = col0 + 128 * bj; float gt[8], pv[8], o[8];
                    { const v2u gw = *(const v2u*)((const unsigned char*)G + (size_t)row * 2048 + goff + col);
#pragma unroll
                      for (int i = 0; i < 4; ++i) { gt[i] = (float)((gw.x >> (8 * i)) & 0xffu) * (1.0f / 255.0f); gt[4 + i] = (float)((gw.y >> (8 * i)) & 0xffu) * (1.0f / 255.0f); } }
                    if (ADD) unpack8(*(const u32x4*)(O + (size_t)row * D + col), pv);
#pragma unroll
                    for (int n = 0; n < 2; ++n)
#pragma unroll
                        for (int i = 0; i < 4; ++i) o[4 * n + i] = (ADD ? pv[4 * n + i] : 0.f) + gt[4 * n + i] * acc[ai][bj][m][n][i];
                    *(u32x4*)(O + (size_t)row * D + col) = pack8(o); } }
    }
};
struct EpiGate2 {
    static constexpr bool PERM = true, AFTER_DRAIN = false;
    const unsigned char* G; bf16_t* O;
    __device__ __forceinline__ void mid(f32x4 (&acc)[2][2][4][2], const Unit& u, int wr, int wc, int fr, int fq) const {
        const int row0 = u.pm * 256 + wr * 64 + fr, col0 = u.pn * 256 + 32 * wc + 8 * fq;
#pragma unroll
        for (int ai = 0; ai < 2; ++ai)
#pragma unroll
            for (int m = 0; m < 4; ++m) { const int row = row0 + ai * 128 + m * 16;
#pragma unroll
                for (int bj = 0; bj < 2; ++bj) { const int col = col0 + 128 * bj;
                    const v2u a = *(const v2u*)(G + (size_t)row * 2048 + col), b = *(const v2u*)(G + (size_t)row * 2048 + 1024 + col);
#pragma unroll
                    for (int i = 0; i < 4; ++i) {
                        acc[ai][bj][m][0][i] *= (float)((a.x >> (8 * i)) & 0xffu) * __builtin_amdgcn_rcpf((float)((b.x >> (8 * i)) & 0xffu));
                        acc[ai][bj][m][1][i] *= (float)((a.y >> (8 * i)) & 0xffu) * __builtin_amdgcn_rcpf((float)((b.y >> (8 * i)) & 0xffu)); } } }
    }
    __device__ __forceinline__ void operator()(const f32x4 (&acc)[2][2][4][2], const Unit& u, int wr, int wc, int fr, int fq) const {
        const int row0 = u.pm * 256 + wr * 64 + fr, col0 = u.pn * 256 + 32 * wc + 8 * fq;
#pragma unroll
        for (int ai = 0; ai < 2; ++ai)
#pragma unroll
            for (int m = 0; m < 4; ++m) { const int row = row0 + ai * 128 + m * 16;
#pragma unroll
                for (int bj = 0; bj < 2; ++bj) { const int col = col0 + 128 * bj; float o[8];
                    const v2u b = *(const v2u*)(G + (size_t)row * 2048 + 1024 + col);
#pragma unroll
                    for (int i = 0; i < 4; ++i) { o[i] = (float)((b.x >> (8 * i)) & 0xffu) * (1.0f / 255.0f) * acc[ai][bj][m][0][i]; o[4 + i] = (float)((b.y >> (8 * i)) & 0xffu) * (1.0f / 255.0f) * acc[ai][bj][m][1][i]; }
                    *(u32x4*)(O + (size_t)row * D + col) = pack8(o); } }
    }
};
struct EpiRes1 {
    static constexpr bool PERM = true, AFTER_DRAIN = false;
    const float* x; float* out; bf16_t* xb; float* ss;
    __device__ __forceinline__ void operator()(const f32x4 (&acc)[2][2][4][2], const Unit& u, int wr, int wc, int fr, int fq) const {
        const int row0 = u.pm * 256 + wr * 64 + fr, col0 = u.pn * 256 + 32 * wc + 8 * fq;
#pragma unroll
        for (int ai = 0; ai < 2; ++ai)
#pragma unroll
            for (int m = 0; m < 4; ++m) { const int row = row0 + ai * 128 + m * 16; float s = 0.f;
#pragma unroll
                for (int bj = 0; bj < 2; ++bj) { const size_t off = (size_t)row * D + col0 + 128 * bj;
                    float xv[8]; unpack8(*(const u32x4*)(xb + off), xv);
                    const f32x4 a = (f32x4){xv[0], xv[1], xv[2], xv[3]} + acc[ai][bj][m][0], b = (f32x4){xv[4], xv[5], xv[6], xv[7]} + acc[ai][bj][m][1];
                    u32x4 w; w.x = pk2(a[0], a[1]); w.y = pk2(a[2], a[3]); w.z = pk2(b[0], b[1]); w.w = pk2(b[2], b[3]); *(u32x4*)(xb + off) = w;
                    s += (a[0] * a[0] + a[1] * a[1]) + (a[2] * a[2] + a[3] * a[3]) + (b[0] * b[0] + b[1] * b[1]) + (b[2] * b[2] + b[3] * b[3]); }
                s = xor32_sum(xor16_sum(s));
                if (fq == 0) atomicAdd(ss + row, s); }
    }
};
struct EpiScaleRow {
    static constexpr bool PERM = true, AFTER_DRAIN = false;
    const float* ss; bf16_t* O; int ldc;
    __device__ __forceinline__ void operator()(const f32x4 (&acc)[2][2][4][2], const Unit& u, int wr, int wc, int fr, int fq) const {
        const int row0 = u.pm * 256 + wr * 64 + fr, col0 = u.pn * 256 + 32 * wc + 8 * fq;
#pragma unroll
        for (int ai = 0; ai < 2; ++ai)
#pragma unroll
            for (int m = 0; m < 4; ++m) { const int row = row0 + ai * 128 + m * 16; const float rs = rsqrtf(ss[row] * (1.0f / 1024.0f) + EPS);
#pragma unroll
                for (int bj = 0; bj < 2; ++bj) { float o[8];
#pragma unroll
                    for (int n = 0; n < 2; ++n)
#pragma unroll
                        for (int i = 0; i < 4; ++i) o[4 * n + i] = acc[ai][bj][m][n][i] * rs;
                    *(u32x4*)(O + (size_t)row * ldc + col0 + 128 * bj) = pack8(o); } }
    }
};
struct EpiPlain {
    static constexpr bool PERM = true, AFTER_DRAIN = false;
    bf16_t* O; int ldc;
    __device__ __forceinline__ void operator()(const f32x4 (&acc)[2][2][4][2], const Unit& u, int wr, int wc, int fr, int fq) const {
        const int row0 = u.pm * 256 + wr * 64 + fr, col0 = u.pn * 256 + 32 * wc + 8 * fq;
#pragma unroll
        for (int ai = 0; ai < 2; ++ai)
#pragma unroll
            for (int m = 0; m < 4; ++m) { const int row = row0 + ai * 128 + m * 16;
#pragma unroll
                for (int bj = 0; bj < 2; ++bj) { float o[8];
#pragma unroll
                    for (int n = 0; n < 2; ++n)
#pragma unroll
                        for (int i = 0; i < 4; ++i) o[4 * n + i] = acc[ai][bj][m][n][i];
                    *(u32x4*)(O + (size_t)row * ldc + col0 + 128 * bj) = pack8(o); } }
    }
};
struct EpiPle {
    static constexpr bool PERM = true, AFTER_DRAIN = false;
    const float* rstd; const bf16_t* pp; const bf16_t* xb; float* out;
    __device__ __forceinline__ void operator()(const f32x4 (&acc)[2][2][4][2], const Unit& u, int wr, int wc, int fr, int fq) const {
        const int row0 = u.pm * 256 + wr * 64 + fr, col0 = u.pn * 256 + 32 * wc + 8 * fq;
#pragma unroll
        for (int ai = 0; ai < 2; ++ai)
#pragma unroll
            for (int m = 0; m < 4; ++m) { const int row = row0 + ai * 128 + m * 16; const float rs = rsqrtf(rstd[row] * (1.0f / 1024.0f) + EPS);
#pragma unroll
                for (int bj = 0; bj < 2; ++bj) { const size_t off = (size_t)row * D + col0 + 128 * bj; float pv[8];
                    unpack8(*(const u32x4*)(pp + off), pv);
                    float xv[8]; unpack8(*(const u32x4*)(xb + off), xv);
                    f32x4 a = (f32x4){xv[0], xv[1], xv[2], xv[3]}, b = (f32x4){xv[4], xv[5], xv[6], xv[7]};
#pragma unroll
                    for (int i = 0; i < 4; ++i) { a[i] += sigmoidf_(acc[ai][bj][m][0][i] * rs) * pv[i]; b[i] += sigmoidf_(acc[ai][bj][m][1][i] * rs) * pv[4 + i]; }
                    *(f32x4*)(out + off) = a; *(f32x4*)(out + off + 4) = b; }
                asm volatile("" ::: "memory"); }
    }
};
}

__device__ __forceinline__ void tr_item(const float* W, int ldw, int K, int src_col0, int nvalid, bf16* WT, int dst_row0, const float* gain, LAS float* scr, int kb, int lane) {
    const int k0 = 64 * kb;
#pragma unroll
    for (int j = 0; j < 8; ++j) { const int kk = (lane >> 3) + 8 * j, c4 = (lane & 7) * 4; f32x4 v = (f32x4){0.f, 0.f, 0.f, 0.f};
        if (src_col0 >= 0 && c4 < nvalid) { v = *(const f32x4*)(W + (size_t)(k0 + kk) * ldw + src_col0 + c4); if (gain) v *= gain[k0 + kk]; }
        scr[kk * 33 + c4] = v[0]; scr[kk * 33 + c4 + 1] = v[1]; scr[kk * 33 + c4 + 2] = v[2]; scr[kk * 33 + c4 + 3] = v[3]; }
    LDS_WAIT(); asm volatile("" ::: "memory");
    const int c = lane & 7;
#pragma unroll
    for (int j = 0; j < 4; ++j) { const int n = (lane >> 3) + 8 * j; const LAS float* s = scr + (8 * c) * 33 + n;
        v4u o; o.x = pk2(s[0 * 33], s[1 * 33]); o.y = pk2(s[2 * 33], s[3 * 33]); o.z = pk2(s[4 * 33], s[5 * 33]); o.w = pk2(s[6 * 33], s[7 * 33]);
        *(v4u*)(WT + (size_t)(dst_row0 + n) * K + k0 + 8 * c) = o; }
    LDS_WAIT(); asm volatile("" ::: "memory");
}
__device__ __forceinline__ void win_src_col(int gidx, int& src, int& nvalid) {
    const int tile = gidx >> 3, gi = gidx & 7; nvalid = 32;
    if (tile < 2) src = (tile * 4 + (gi & 3)) * 64 + (gi >> 2) * 32;
    else if (tile < 4) src = 512 + ((tile - 2) * 4 + (gi & 3)) * 64 + (gi >> 2) * 32;
    else if (tile < 6) src = 1024 + (tile - 4) * 256 + gi * 32;
    else if (tile < 8) src = 1536 + (tile - 6) * 256 + gi * 32;
    else if (tile < 12) src = (gi < 4) ? 2120 + 128 * (tile - 8) + 32 * gi : 2632 + 128 * (tile - 8) + 32 * (gi - 4);
    else if (tile < 20) src = 3144 + (tile - 12) * 256 + 32 * gi;
    else { if (gi < 2) src = 2048 + 32 * gi; else if (gi == 2) { src = 2112; nvalid = 8; } else { src = -1; nvalid = 0; } }
}
__device__ __forceinline__ void cvt_bf16_stream(const float* src, bf16* dst, size_t n8, size_t start, size_t stride) {
    for (size_t i = start; i < n8; i += stride) { const f32x4 a = *(const f32x4*)(src + i * 8), b = *(const f32x4*)(src + i * 8 + 4);
        v4u o; o.x = pk2(a[0], a[1]); o.y = pk2(a[2], a[3]); o.z = pk2(b[0], b[1]); o.w = pk2(b[2], b[3]); *(v4u*)(dst + i * 8) = o; }
}
__device__ __forceinline__ void cvt_fp8_stream(const float* src, unsigned char* dst, size_t n16, size_t start, size_t stride, float scale) {
    for (size_t i = start; i < n16; i += stride) { v4u o;
#pragma unroll
        for (int j = 0; j < 4; ++j) { const f32x4 a = *(const f32x4*)(src + i * 16 + 4 * j) * scale; int pk = __builtin_amdgcn_cvt_pk_fp8_f32(a[0], a[1], 0, false); pk = __builtin_amdgcn_cvt_pk_fp8_f32(a[2], a[3], pk, true); o[j] = (unsigned)pk; }
        const size_t row = (i * 16) >> 10, col = (i * 16) & 1023;
        *(v4u*)(dst + ((col >> 7) * 16384 + row) * 128 + (col & 127)) = o; }
}
constexpr float EU_SCALE = 256.0f, EV_SCALE = 16.0f;
__device__ __forceinline__ int t5_bucket(int rel) {
    const int n = rel < 0 ? -rel : rel; int v;
    if (n < 8) v = n; else { v = 8 + (int)(logf((float)n / 8.0f) / logf(128.0f) * 8.0f); if (v > 15) v = 15; }
    return (rel > 0 ? 16 : 0) + v;
}
__device__ __forceinline__ void p0_prologue(Frame& F) {
    LAS float* scr = (LAS float*)(F.lds + RING_OFF + F.wave * 16384);
    const int gw = F.gw, NGW = F.NGW, lane = F.lane;
    constexpr int I_IN = 168 * 16, I_A = 32 * 8, I_C = 32 * 8, I_O = 32 * 16, I_Q = 64 * 16, I_G = 32 * 16, I_P = 32 * 4;
    constexpr int NITEMS = I_IN + I_A + I_C + I_O + I_Q + I_G + I_P;
    for (int it = gw; it < NITEMS; it += NGW) {
        int r = it;
        if (r < I_IN) { int src, nv; win_src_col(r / 16, src, nv); tr_item(F.w_in, 5192, D, src, nv, F.Win_t, (r / 16) * 32, F.attn_g, scr, r % 16, lane); continue; } r -= I_IN;
        if (r < I_A) { tr_item(F.w_att, D, 1024, (r / 8) * 32, 32, F.Wa_t, (r / 8) * 32, nullptr, scr, r % 8, lane); continue; } r -= I_A;
        if (r < I_C) { tr_item(F.w_conv, D, 1024, (r / 8) * 32, 32, F.Wa_t + 512, (r / 8) * 32, nullptr, scr, r % 8, lane);     continue; } r -= I_C;
        if (r < I_O) { tr_item(F.w_out, D, D, (r / 16) * 32, 32, F.Wout_t, (r / 16) * 32, nullptr, scr, r % 16, lane); continue; } r -= I_O;
        if (r < I_Q) { tr_item(F.w_pq, 2048, D, (r / 16) * 32, 32, F.Wq_t, (r / 16) * 32, F.ffn_g, scr, r % 16, lane); continue; } r -= I_Q;
        if (r < I_G) { tr_item(F.w_pg, D, D, (r / 16) * 32, 32, F.Wg_t, (r / 16) * 32, F.ple_g, scr, r % 16, lane); continue; } r -= I_G;
        tr_item(F.w_pp, D, PLE, (r / 4) * 32, 32, F.Wp_t, (r / 4) * 32, nullptr, scr, r % 4, lane);
    }
    const size_t gt = (size_t)blockIdx.x * (NWAVES * 64) + F.tid, GT = (size_t)F.G * NWAVES * 64;
    cvt_bf16_stream(F.subk, F.SUBK, (size_t)PEER_H * 2 * NKEYS * 128 / 8, gt, GT);
#ifdef NAIVE_P7
    cvt_bf16_stream(F.pu, F.EU, (size_t)16384 * D / 8, gt, GT);
    cvt_bf16_stream(F.pv, F.EV, (size_t)16384 * D / 8, gt, GT);
#else
    cvt_fp8_stream(F.pu, (unsigned char*)F.EU, (size_t)16384 * D / 16, gt, GT, EU_SCALE);
    cvt_fp8_stream(F.pv, (unsigned char*)F.EV, (size_t)16384 * D / 16, gt, GT, EV_SCALE);
#endif
    cvt_bf16_stream(F.p, F.PB, (size_t)M * PLE / 8, gt, GT);
    for (int m = gw; m < M; m += NGW) {
        const f32x4* xr = (const f32x4*)(F.x + (size_t)m * D) + lane; f32x4 v[4]; float s = 0.f;
#pragma unroll
        for (int j = 0; j < 4; ++j) { v[j] = xr[64 * j]; s += (v[j][0] * v[j][0] + v[j][1] * v[j][1]) + (v[j][2] * v[j][2] + v[j][3] * v[j][3]); }
        s = wave_sum(s);
        if (lane == 0) F.rstd1[m] = rsqrtf(s * (1.0f / D) + EPS);
        v2u* o8 = (v2u*)(F.XB + (size_t)m * D) + lane;
#pragma unroll
        for (int j = 0; j < 4; ++j) { v2u o; o.x = pk2(v[j][0], v[j][1]); o.y = pk2(v[j][2], v[j][3]); o8[64 * j] = o; }
    }
    if (blockIdx.x == 0 && F.wave == 0) { const float gq = wave_max(fabsf(F.q_g[lane])), gk = wave_max(fabsf(F.k_g[lane]));
        float bm = 0.f;
#pragma unroll
        for (int i = 0; i < 4; ++i) bm = fmaxf(bm, fabsf(F.rel_bias[lane + 64 * i]));
        bm = wave_max(bm);
        if (lane == 0) F.mb[0] = C2 * 64.0f * gq * gk + LOG2E * bm + 0.5f; }
    for (size_t i = gt; i < (size_t)NH * TABN; i += GT) { const int h = (int)(i / TABN), rel = (int)(i % TABN) - TABOFF; F.tab[i] = LOG2E * F.rel_bias[t5_bucket(rel) * NH + h]; }
}

__device__ __forceinline__ void p2_index_naive(Frame& F, float* scratch) {
    const int lane = F.lane;
    LAS unsigned* qi_l = (LAS unsigned*)(F.lds + F.wave * 1024);
    LAS unsigned* hist = (LAS unsigned*)(F.lds + 8192 + F.wave * 1024);
    float* scr = scratch + (size_t)F.gw * SEQ;
    const unsigned long long lt = __lanemask_lt();
    for (int t = F.gw; t < M; t += F.NGW) {
        const int b = t / SEQ, sq = t % SEQ, vis = (sq / 64 + 1) * 64, nst = vis / 64;
        unsigned* bm = F.bitmap + (size_t)t * 256;
        if (vis <= TOPK) { for (int wd = lane; wd < 256; wd += 64) bm[wd] = (wd * 32 < vis) ? 0xffffffffu : 0u; continue; }
        *(LAS v4u*)(qi_l + lane * 4) = *(const v4u*)(F.QI + (size_t)t * 512 + lane * 8);
        float w[8];
#pragma unroll
        for (int h = 0; h < 8; ++h) w[h] = F.WI[(size_t)t * 8 + h];
        LDS_WAIT();
        for (int st = 0; st < nst; ++st) {
            asm volatile("" ::: "memory");
            const int key = st * 64 + lane; const v4u* kr = (const v4u*)(F.KI + ((size_t)b * SEQ + key) * 64);
            v4u kk[8];
#pragma unroll
            for (int i = 0; i < 8; ++i) kk[i] = kr[i];
            float s = 0.f;
#pragma unroll
            for (int h = 0; h < 8; ++h) { float d = 0.f;
#pragma unroll
                for (int i = 0; i < 8; ++i) d = dot8(*(const LAS v4u*)(qi_l + h * 32 + i * 4), kk[i], d);
                s += w[h] * fmaxf(d, 0.f); }
            scr[key] = s;
        }
        unsigned prefix = 0u, remaining = TOPK;
        for (int pass = 0; pass < 4; ++pass) {
            const int shift = 24 - 8 * pass;
            *(LAS v4u*)(hist + lane * 4) = (v4u){0u, 0u, 0u, 0u};
            LDS_WAIT();
            for (int st = 0; st < nst; ++st) { const unsigned uu = sortable(scr[st * 64 + lane]);
                const bool ok = (pass == 0) || ((uu >> (shift + 8)) == prefix);
                if (ok) __hip_atomic_fetch_add(hist + ((uu >> shift) & 255u), 1u, __ATOMIC_RELAXED, __HIP_MEMORY_SCOPE_WORKGROUP); }
            LDS_WAIT();
            const v4u c = *(const LAS v4u*)(hist + lane * 4);
            const unsigned tot = c.x + c.y + c.z + c.w; unsigned incl = tot;
#pragma unroll
            for (int o = 1; o < 64; o <<= 1) { const unsigned v = __shfl_down(incl, o); incl += (lane + o < 64) ? v : 0u; }
            const unsigned excl = incl - tot;
            const bool mine = (excl < remaining) && (remaining <= incl);
            unsigned bsel = 0u, before = 0u;
            if (mine) { unsigned cum = excl;
                if (remaining <= cum + c.w) { bsel = 3u; before = cum; } else { cum += c.w;
                if (remaining <= cum + c.z) { bsel = 2u; before = cum; } else { cum += c.z;
                if (remaining <= cum + c.y) { bsel = 1u; before = cum; } else { cum += c.y; bsel = 0u; before = cum; } } }
                bsel += 4u * lane; }
            const unsigned long long mm = __ballot(mine);
            const int src = __ffsll((long long)mm) - 1;
            bsel = __shfl(bsel, src); before = __shfl(before, src);
            prefix = (prefix << 8) | bsel; remaining -= before;
            LDS_WAIT();
        }
        unsigned taken = 0u;
        for (int st = 0; st < nst; ++st) { const unsigned uu = sortable(scr[st * 64 + lane]);
            const bool gtb = uu > prefix, eq = uu == prefix; const unsigned long long meq = __ballot(eq);
            const unsigned rank = __popcll(meq & lt); const bool sel = gtb || (eq && (taken + rank < remaining)); taken += __popcll(meq);
            const unsigned long long ms = __ballot(sel);
            if (lane == 0) { bm[2 * st] = (unsigned)ms; bm[2 * st + 1] = (unsigned)(ms >> 32); } }
        for (int wd = 2 * nst + lane; wd < 256; wd += 64) bm[wd] = 0u;
    }
}
__device__ __forceinline__ void p2_conv_naive(Frame& F) {
    const int lane = F.lane, c0 = 8 * lane;
    for (int t = F.gw; t < M; t += F.NGW) {
        const int sq = t % SEQ; float y[8];
#pragma unroll
        for (int i = 0; i < 8; ++i) y[i] = F.conv_b[c0 + i];
        for (int j = 0; j < CONVW; ++j) { const int sp = sq - (CONVW - 1) + j; if (sp < 0) continue;
            float uv[8]; epi::unpack8(*(const v4u*)(F.UB + (size_t)(t - (CONVW - 1) + j) * 512 + c0), uv);
            const f32x4 w0 = *(const f32x4*)(F.conv_w + j * 512 + c0), w1 = *(const f32x4*)(F.conv_w + j * 512 + c0 + 4);
#pragma unroll
            for (int i = 0; i < 4; ++i) { y[i] += uv[i] * w0[i]; y[4 + i] += uv[4 + i] * w1[i]; } }
        float s = 0.f;
#pragma unroll
        for (int i = 0; i < 8; ++i) s += y[i];
        const float mean = wave_sum(s) * (1.0f / 512.0f); float q = 0.f;
#pragma unroll
        for (int i = 0; i < 8; ++i) { y[i] -= mean; q += y[i] * y[i]; }
        const float rstd = rsqrtf(wave_sum(q) * (1.0f / 512.0f) + EPS); float o[8];
#pragma unroll
        for (int i = 0; i < 8; ++i) { const float z = y[i] * rstd * F.ln_g[c0 + i] + F.ln_b[c0 + i]; o[i] = z * sigmoidf_(z); }
        *(v4u*)(F.CV + (size_t)t * 512 + c0) = epi::pack8(o);
    }
}
__device__ __forceinline__ void p3_attn_naive(Frame& F) {
    const int lane = F.lane;
    LAS int* sel = (LAS int*)(F.lds + F.wave * 2048);
    LAS float* pl = (LAS float*)(F.lds + F.wave * 2048 + 1024);
    const unsigned long long lt = __lanemask_lt();
    for (int t = F.gw; t < M; t += F.NGW) {
        const int b = t / SEQ, sq = t % SEQ, vis = (sq / 64 + 1) * 64, nst = vis / 64;
        const unsigned* bm = F.bitmap + (size_t)t * 256; int nsel = 0;
        for (int st = 0; st < nst; ++st) { const unsigned long long m = (unsigned long long)bm[2 * st] | ((unsigned long long)bm[2 * st + 1] << 32);
            const int pos = nsel + __popcll(m & lt); if (((m >> lane) & 1ull) && pos < TOPK) sel[pos] = st * 64 + lane;
            nsel += __popcll(m); nsel = nsel > TOPK ? TOPK : nsel; }
        LDS_WAIT();
        for (int h = 0; h < NH; ++h) {
            v4u qq[8]; const v4u* qr = (const v4u*)(F.Q + (size_t)t * AW + h * 64);
#pragma unroll
            for (int i = 0; i < 8; ++i) qq[i] = qr[i];
            float lg[4]; float mx = -INFINITY;
#pragma unroll
            for (int j = 0; j < 4; ++j) { const int idx = lane + 64 * j; lg[j] = -INFINITY;
                if (idx < nsel) { const int key = sel[idx]; const v4u* kr = (const v4u*)(F.K + ((size_t)b * SEQ + key) * AW + h * 64); float d = 0.f;
#pragma unroll
                    for (int i = 0; i < 8; ++i) d = dot8(qq[i], kr[i], d);
                    int ti = key - sq + TABOFF; ti = ti < 0 ? 0 : ti; d += F.tab[h * TABN + ti]; lg[j] = d; mx = fmaxf(mx, d); } }
            mx = wave_max(mx); float sm = 0.f;
#pragma unroll
            for (int j = 0; j < 4; ++j) { const int idx = lane + 64 * j; if (idx < nsel) { const float pj = exp2f(lg[j] - mx); sm += pj; pl[idx] = pj; } }
            sm = wave_sum(sm); LDS_WAIT();
            float o = 0.f; const bf16* vb = F.V + (size_t)b * SEQ * AW + h * 64 + lane;
            for (int j = 0; j < nsel; ++j) o += pl[j] * bf1(vb[(size_t)sel[j] * AW]);
            F.ATT[(size_t)t * AW + h * 64 + lane] = (bf16)f2bf(o / sm);
            LDS_WAIT();
        }
    }
}
__device__ __forceinline__ void p7_peer_naive(Frame& F) {
    const int lane = F.lane;
    LAS int* EI = (LAS int*)(F.lds + F.wave * 2048);
    LAS float* GT = (LAS float*)(F.lds + F.wave * 2048 + 512);
    LAS float* sv = (LAS float*)(F.lds + F.wave * 2048 + 1024);
    LAS int* si = (LAS int*)(F.lds + F.wave * 2048 + 1024 + 128);
    LAS float* ts = (LAS float*)(F.lds + F.wave * 2048 + 1024 + 256);
    for (int t = F.gw; t < M; t += F.NGW) {
        for (int h = 0; h < PEER_H; ++h) {
            for (int c = 0; c < 2; ++c) {
                v4u qv[16]; const v4u* qr = (const v4u*)(F.QP + (size_t)t * 2048 + h * 256 + c * 128);
#pragma unroll
                for (int i = 0; i < 16; ++i) qv[i] = qr[i];
                float s[2];
#pragma unroll
                for (int kk = 0; kk < 2; ++kk) { const v4u* kr = (const v4u*)(F.SUBK + ((size_t)(h * 2 + c) * NKEYS + lane + 64 * kk) * 128); float d = 0.f;
#pragma unroll
                    for (int i = 0; i < 16; ++i) d = dot8(qv[i], kr[i], d);
                    s[kk] = d; }
                unsigned long long k0 = ((unsigned long long)sortable(s[0]) << 32) | (0xffffffffu - (unsigned)lane), k1 = ((unsigned long long)sortable(s[1]) << 32) | (0xffffffffu - (unsigned)(lane + 64));
                for (int r = 0; r < PTOPK; ++r) {
                    const unsigned long long best = wave_max_u64(k0 > k1 ? k0 : k1);
                    const int bi = (int)(0xffffffffu - (unsigned)best);
                    if (k0 == best) { sv[c * 16 + r] = s[0]; si[c * 16 + r] = bi; k0 = 0ull; }
                    if (k1 == best) { sv[c * 16 + r] = s[1]; si[c * 16 + r] = bi; k1 = 0ull; }
                }
            }
            LDS_WAIT();
            unsigned long long ck[4]; float cs[4];
#pragma unroll
            for (int jj = 0; jj < 4; ++jj) { const int n = lane + 64 * jj; cs[jj] = sv[n >> 4] + sv[16 + (n & 15)]; ck[jj] = ((unsigned long long)sortable(cs[jj]) << 32) | (0xffffffffu - (unsigned)n); }
            for (int r = 0; r < PTOPK; ++r) {
                unsigned long long loc = ck[0] > ck[1] ? ck[0] : ck[1]; const unsigned long long loc2 = ck[2] > ck[3] ? ck[2] : ck[3]; loc = loc > loc2 ? loc : loc2;
                const unsigned long long best = wave_max_u64(loc);
                const int n = (int)(0xffffffffu - (unsigned)best);
#pragma unroll
                for (int jj = 0; jj < 4; ++jj) if (ck[jj] == best) { ts[r] = cs[jj]; EI[h * 16 + r] = si[n >> 4] * NKEYS + si[16 + (n & 15)]; ck[jj] = 0ull; }
            }
            LDS_WAIT();
            { const float t0 = ts[0]; float e = (lane < 16) ? __expf(ts[lane & 15] - t0) : 0.f; const float sum = wave_sum(e); if (lane < 16) GT[h * 16 + lane] = e / sum; }
            LDS_WAIT();
        }
        const float rs2 = rsqrtf(F.ss1[t] * (1.0f / D) + EPS);
        f32x4 x1[4]; float hx[16], oa[16];
#pragma unroll
        for (int j = 0; j < 4; ++j) { x1[j] = *((const f32x4*)(F.out + (size_t)t * D) + lane + 64 * j); const f32x4 g = *((const f32x4*)F.ffn_g + lane + 64 * j);
#pragma unroll
            for (int i = 0; i < 4; ++i) { hx[4 * j + i] = x1[j][i] * rs2 * g[i]; oa[4 * j + i] = 0.f; } }
        for (int n = 0; n < PEER_H * PTOPK; ++n) {
            const int e = EI[n]; const float g = GT[n];
            const v2u* ur = (const v2u*)(F.EU + (size_t)e * D) + lane; const v2u* vr = (const v2u*)(F.EV + (size_t)e * D) + lane; float d = 0.f; v2u vv[4];
#pragma unroll
            for (int j = 0; j < 4; ++j) { const v2u uu = ur[64 * j]; vv[j] = vr[64 * j];
                d += bflo(uu.x) * hx[4 * j] + bfhi(uu.x) * hx[4 * j + 1] + bflo(uu.y) * hx[4 * j + 2] + bfhi(uu.y) * hx[4 * j + 3]; }
            d = wave_sum(d); const float a = gelu_tanh(d) * g;
#pragma unroll
            for (int j = 0; j < 4; ++j) { oa[4 * j] += a * bflo(vv[j].x); oa[4 * j + 1] += a * bfhi(vv[j].x); oa[4 * j + 2] += a * bflo(vv[j].y); oa[4 * j + 3] += a * bfhi(vv[j].y); }
        }
        float s = 0.f;
#pragma unroll
        for (int j = 0; j < 4; ++j) { f32x4 o;
#pragma unroll
            for (int i = 0; i < 4; ++i) { o[i] = x1[j][i] + oa[4 * j + i]; s += o[i] * o[i]; }
            *((f32x4*)(F.out + (size_t)t * D) + lane + 64 * j) = o;
            v2u w; w.x = pk2(o[0], o[1]); w.y = pk2(o[2], o[3]); *((v2u*)(F.XB + (size_t)t * D) + lane + 64 * j) = w; }
        s = wave_sum(s); if (lane == 0) F.rstd3[t] = rsqrtf(s * (1.0f / D) + EPS);
        LDS_WAIT();
    }
}


__device__ __forceinline__ void p2_conv(Frame& F) {
    const int tid = F.tid, lane = F.lane, wave = F.wave;
    LAS bf16* UT = (LAS bf16*)(F.lds + RING_OFF);
    LAS float* YT = (LAS float*)(F.lds + RING_OFF + 63488);
    float w[CONVW];
#pragma unroll
    for (int j = 0; j < CONVW; ++j) w[j] = F.conv_w[j * 512 + tid];
    const float cb = F.conv_b[tid];
    for (int tile = blockIdx.x; tile < M / 32; tile += F.G) {
        const int t0 = tile * 32, s0 = t0 % SEQ;
        __syncthreads();
#pragma unroll
        for (int i = 0; i < 8; ++i) { const int p = tid + 512 * i, row = p >> 6, c16 = p & 63;
            if (row < 62) { v4u v = (v4u){0u, 0u, 0u, 0u}; if (s0 - 30 + row >= 0) v = *(const v4u*)(F.UB + (size_t)(t0 - 30 + row) * 512 + c16 * 8); *(LAS v4u*)(UT + row * 512 + c16 * 8) = v; } }
        __syncthreads();
        { float u[62];
#pragma unroll
          for (int k = 0; k < 62; ++k) u[k] = bf1(UT[k * 512 + tid]);
#pragma unroll
          for (int o = 0; o < 32; ++o) { float y0 = cb, y1 = 0.f;
#pragma unroll
              for (int j = 0; j < CONVW - 1; j += 2) { y0 += w[j] * u[o + j]; y1 += w[j + 1] * u[o + j + 1]; }
              y0 += w[CONVW - 1] * u[o + CONVW - 1];
              YT[o * 512 + tid] = y0 + y1; } }
        __syncthreads();
#pragma unroll
        for (int i = 0; i < 4; ++i) { const int tk = wave * 4 + i; const f32x4 a = *(const LAS f32x4*)(YT + tk * 512 + 8 * lane), b = *(const LAS f32x4*)(YT + tk * 512 + 8 * lane + 4);
            float y[8] = {a[0], a[1], a[2], a[3], b[0], b[1], b[2], b[3]}; float s = 0.f;
#pragma unroll
            for (int e = 0; e < 8; ++e) s += y[e];
            const float mean = wave_sum(s) * (1.0f / 512.0f); float q = 0.f;
#pragma unroll
            for (int e = 0; e < 8; ++e) { y[e] -= mean; q += y[e] * y[e]; }
            const float rstd = rsqrtf(wave_sum(q) * (1.0f / 512.0f) + EPS); float o[8];
            const f32x4 g0 = *(const f32x4*)(F.ln_g + 8 * lane), g1 = *(const f32x4*)(F.ln_g + 8 * lane + 4), b0 = *(const f32x4*)(F.ln_b + 8 * lane), b1 = *(const f32x4*)(F.ln_b + 8 * lane + 4);
#pragma unroll
            for (int e = 0; e < 8; ++e) { const float z = y[e] * rstd * (e < 4 ? g0[e & 3] : g1[e & 3]) + (e < 4 ? b0[e & 3] : b1[e & 3]); o[e] = z * sigmoidf_(z); }
            *(v4u*)(F.ATT + (size_t)(t0 + tk) * 1024 + 512 + 8 * lane) = epi::pack8(o); }
    }
}
typedef short bf16x8_t __attribute__((ext_vector_type(8)));
typedef short s16x2 __attribute__((ext_vector_type(2)));
typedef unsigned short u16x2 __attribute__((ext_vector_type(2)));
constexpr int KT_BYTES = 512 * 128;
constexpr unsigned SC_INVALID = 0x80008000u;
__device__ __forceinline__ unsigned score_key16(float f) { const _Float16 hv = (_Float16)f; const unsigned short b = __builtin_bit_cast(unsigned short, hv); return (unsigned)(unsigned short)(b ^ (unsigned short)(((short)b >> 15) & 0x7FFF)); }
__device__ __forceinline__ unsigned pk_lt_count(unsigned acc, unsigned v, unsigned cpk) {
    const s16x2 d = __builtin_elementwise_sub_sat(__builtin_bit_cast(s16x2, v), __builtin_bit_cast(s16x2, cpk));
    const u16x2 m = __builtin_bit_cast(u16x2, d) >> (u16x2){15, 15};
    return __builtin_bit_cast(unsigned, (u16x2)(__builtin_bit_cast(u16x2, acc) + m));
}
__device__ __forceinline__ unsigned pk_ne_count(unsigned acc, unsigned v, unsigned cpk) {
    const u16x2 e = __builtin_elementwise_min(__builtin_bit_cast(u16x2, v ^ cpk), (u16x2){1, 1});
    return __builtin_bit_cast(unsigned, (u16x2)(__builtin_bit_cast(u16x2, acc) + e));
}
__device__ __forceinline__ int half_sum_i(int v) {
    v += __builtin_amdgcn_update_dpp(0, v, 0xB1, 0xF, 0xF, false); v += __builtin_amdgcn_update_dpp(0, v, 0x4E, 0xF, 0xF, false);
    v += __builtin_amdgcn_update_dpp(0, v, 0x141, 0xF, 0xF, false); v += __builtin_amdgcn_update_dpp(0, v, 0x140, 0xF, 0xF, false);
    const auto sw = __builtin_amdgcn_permlane16_swap((unsigned)v, (unsigned)v, false, false); return (int)(sw[0] + sw[1]); }
#define P2_WRITELANE2(WA, WB, VA, VB, LN) asm volatile("s_nop 1\n\tv_writelane_b32 %0, %2, %4\n\tv_writelane_b32 %1, %3, %4" : "+v"(WA), "+v"(WB) : "s"(VA), "s"(VB), "n"(LN))
__device__ __forceinline__ void p2_index(Frame& F) {
    const int lane = F.lane, wave = F.wave, tid = F.tid, B = (int)blockIdx.x;
    LAS unsigned char* KT = F.lds + RING_OFF;
    for (int it = 0;; ++it) {
        const int L = it * F.G + B; if (L >= M / 16) break;
        const int b = L / 512, r512 = L % 512, j = (r512 < 256) ? r512 : 767 - r512;
        const int q0 = 16 * j, vis = (q0 / 64 + 1) * 64;
        const size_t row0 = (size_t)b * SEQ;
        unsigned* bm0 = F.bitmap + (row0 + q0 + 2 * wave) * 256; unsigned* bm1 = bm0 + 256;
        if (vis <= TOPK) {
#pragma unroll
            for (int g = 0; g < 4; ++g) { const unsigned w = ((64 * g + lane) * 32 < vis) ? 0xffffffffu : 0u; bm0[64 * g + lane] = w; bm1[64 * g + lane] = w; }
            continue;
        }
        bf16x8_t af[2];
        { const int rw = lane & 15, tq = rw >> 3, hh = rw & 7; const bf16* qp = F.QI + (row0 + q0 + 2 * wave + tq) * 512 + hh * 64 + 8 * (lane >> 4);
          const float wrow = F.WI[(row0 + q0 + 2 * wave + tq) * 8 + hh];
          v4u a0 = *(const v4u*)qp, a1 = *(const v4u*)(qp + 32);
#pragma unroll
          for (int i = 0; i < 4; ++i) { a0[i] = pk2(bflo(a0[i]) * wrow, bfhi(a0[i]) * wrow); a1[i] = pk2(bflo(a1[i]) * wrow, bfhi(a1[i]) * wrow); }
          af[0] = __builtin_bit_cast(bf16x8_t, a0); af[1] = __builtin_bit_cast(bf16x8_t, a1); }
        const f32x4 w4 = *(const f32x4*)(F.WI + (row0 + q0 + 2 * wave + (lane >> 5)) * 8 + ((lane >> 4) & 1) * 4);
        float clo[4], chi[4];
#pragma unroll
        for (int i = 0; i < 4; ++i) { clo[i] = (w4[i] >= 0.f) ? 0.f : -INFINITY; chi[i] = (w4[i] >= 0.f) ? INFINITY : 0.f; }
        typedef unsigned u32x16_t __attribute__((ext_vector_type(16)));
        u32x16_t scv[8];
#pragma unroll
        for (int i = 0; i < 8; ++i)
#pragma unroll
            for (int j = 0; j < 16; ++j) scv[i][j] = SC_INVALID;
        const int nt2 = (vis + 511) / 512;
        const int srow = 64 * wave + (lane >> 3), schunk = (lane & 7) ^ (lane >> 3);
        const bf16* gsrc = F.KI + (row0 + srow) * 64 + schunk * 8;
#define P2_STAGE(BUF, TILEBASE) do { _Pragma("unroll") for (int i_ = 0; i_ < 8; ++i_) \
            __builtin_amdgcn_global_load_lds((const unsigned*)(gsrc + (size_t)(TILEBASE) * 64 + i_ * 512), (LAS unsigned*)((BUF) + wave * 8192 + i_ * 1024), 16, 0, 0); } while (0)
        __syncthreads();
        P2_STAGE(KT, 0);
        VM_WAIT(); __syncthreads();
        const int brow = lane & 15, q4 = lane >> 4;
        const int fo0 = brow * 128 + ((q4 ^ (brow & 7)) << 4), fo1 = brow * 128 + (((4 + q4) ^ (brow & 7)) << 4);
#define P2_LOADF(DST, BUF, R) do { _Pragma("unroll") for (int kb_ = 0; kb_ < 4; ++kb_) { DST[kb_][0] = *(const LAS bf16x8_t*)((BUF) + (4 * (R) + kb_) * 2048 + fo0); DST[kb_][1] = *(const LAS bf16x8_t*)((BUF) + (4 * (R) + kb_) * 2048 + fo1); } } while (0)
        for (int T = 0; T < nt2; ++T) {
            const int base = 512 * T;
            LAS unsigned char* buf = KT + (T & 1) * KT_BYTES; LAS unsigned char* nbuf = KT + ((T + 1) & 1) * KT_BYTES;
            if (T + 1 < nt2) P2_STAGE(nbuf, base + 512);
            bf16x8_t fA[4][2], fB[4][2];
#ifndef P2_SCREP
#define P2_SCREP 1
#endif
            for (int srep_ = 0; srep_ < P2_SCREP; ++srep_) {
            P2_LOADF(fA, buf, 0);
            f32x4 accA[4], accB[4];
#define P2_MMA(ACC, FR) do { _Pragma("unroll") for (int kb_ = 0; kb_ < 4; ++kb_) ACC[kb_] = __builtin_amdgcn_mfma_f32_16x16x32_bf16(af[0], FR[kb_][0], (f32x4){0.f, 0.f, 0.f, 0.f}, 0, 0, 0); \
                              _Pragma("unroll") for (int kb_ = 0; kb_ < 4; ++kb_) ACC[kb_] = __builtin_amdgcn_mfma_f32_16x16x32_bf16(af[1], FR[kb_][1], ACC[kb_], 0, 0, 0); } while (0)
#define P2_ADDF(A, B) ({ float r_; asm("v_add_f32 %0, %1, %2" : "=v"(r_) : "v"(A), "v"(B)); r_; })
#define P2_FIN(ACC, R) do { float ps_[4]; \
                _Pragma("unroll") for (int kb_ = 0; kb_ < 4; ++kb_) ps_[kb_] = P2_ADDF(P2_ADDF(__builtin_amdgcn_fmed3f(ACC[kb_][0], clo[0], chi[0]), __builtin_amdgcn_fmed3f(ACC[kb_][1], clo[1], chi[1])), P2_ADDF(__builtin_amdgcn_fmed3f(ACC[kb_][2], clo[2], chi[2]), __builtin_amdgcn_fmed3f(ACC[kb_][3], clo[3], chi[3]))); \
                const auto swa_ = __builtin_amdgcn_permlane16_swap(__float_as_uint(ps_[0]), __float_as_uint(ps_[1]), false, false); \
                const auto swb_ = __builtin_amdgcn_permlane16_swap(__float_as_uint(ps_[2]), __float_as_uint(ps_[3]), false, false); \
                const float s0_ = P2_ADDF(__uint_as_float(swa_[0]), __uint_as_float(swa_[1])), s1_ = P2_ADDF(__uint_as_float(swb_[0]), __uint_as_float(swb_[1])); \
                typedef _Float16 h16x2_ __attribute__((ext_vector_type(2))); \
                const h16x2_ hv_ = {(_Float16)s0_, (_Float16)s1_}; const unsigned hb_ = __builtin_bit_cast(unsigned, hv_); \
                const unsigned kk_ = hb_ ^ (__builtin_bit_cast(unsigned, (s16x2)(__builtin_bit_cast(s16x2, hb_) >> (s16x2){15, 15})) & 0x7FFF7FFFu); \
                scv[R][T] = (base + 64 * (R) < vis) ? kk_ : SC_INVALID; } while (0)
            P2_LOADF(fB, buf, 1);
            P2_MMA(accA, fA);
            __builtin_amdgcn_sched_barrier(0);
#pragma unroll
            for (int r = 1; r < 8; ++r) {
                bf16x8_t (&cur)[4][2] = (r & 1) ? fB : fA; bf16x8_t (&nxt)[4][2] = (r & 1) ? fA : fB;
                if (r & 1) { P2_MMA(accB, cur); } else { P2_MMA(accA, cur); }
                __builtin_amdgcn_sched_barrier(0);
                if (r < 7) P2_LOADF(nxt, buf, r + 1);
                if (r & 1) { P2_FIN(accA, r - 1); } else { P2_FIN(accB, r - 1); }
                __builtin_amdgcn_sched_barrier(0);
            }
            P2_FIN(accB, 7);
#undef P2_MMA
#undef P2_FIN
            }
            VM_WAIT(); __syncthreads();
        }
#undef P2_STAGE
#undef P2_LOADF
        int Tu, lastrej, eqc;
        { const int ltfix = (128 - 8 * nt2) * 2;
#define P2_SS(V, CPK) __builtin_bit_cast(unsigned, __builtin_elementwise_sub_sat(__builtin_bit_cast(s16x2, (unsigned)(V)), __builtin_bit_cast(s16x2, CPK)))
#define P2_COUNT_GE(CU, GE, LTL) do { const unsigned cs_ = (unsigned)((CU) - 32768) & 0xffffu, cpk_ = cs_ | (cs_ << 16); \
            unsigned a0_ = 0u, a1_ = 0u, a2_ = 0u, a3_ = 0u; \
            _Pragma("unroll") for (int c = 0; c < 16; ++c) if (c < nt2) { \
                const unsigned d0_ = P2_SS(scv[0][c], cpk_), d1_ = P2_SS(scv[1][c], cpk_), d2_ = P2_SS(scv[2][c], cpk_), d3_ = P2_SS(scv[3][c], cpk_), \
                               d4_ = P2_SS(scv[4][c], cpk_), d5_ = P2_SS(scv[5][c], cpk_), d6_ = P2_SS(scv[6][c], cpk_), d7_ = P2_SS(scv[7][c], cpk_); \
                const unsigned p0_ = __builtin_amdgcn_perm(d0_, d1_, 0x07050301u), p1_ = __builtin_amdgcn_perm(d2_, d3_, 0x07050301u), p2_ = __builtin_amdgcn_perm(d4_, d5_, 0x07050301u), p3_ = __builtin_amdgcn_perm(d6_, d7_, 0x07050301u); \
                a0_ += (unsigned)__builtin_popcount(p0_ & 0x80808080u); a1_ += (unsigned)__builtin_popcount(p1_ & 0x80808080u); a2_ += (unsigned)__builtin_popcount(p2_ & 0x80808080u); a3_ += (unsigned)__builtin_popcount(p3_ & 0x80808080u); \
                asm volatile("" : "+v"(a0_), "+v"(a1_), "+v"(a2_), "+v"(a3_)); } \
            LTL = (int)((a0_ + a1_) + (a2_ + a3_)); GE = 8192 - half_sum_i(LTL + ltfix); } while (0)
          int est = 0;
          { const int nvs = vis < 512 ? vis : 512, ks = (TOPK * nvs) / vis;
            for (int bit = 15; bit >= 5; --bit) {
                const int cu = est | (1 << bit); const unsigned cs = (unsigned)(cu - 32768) & 0xffffu, cpk = cs | (cs << 16);
                unsigned a = 0u;
#pragma unroll
                for (int r = 0; r < 8; ++r) a = pk_lt_count(a, scv[r][0], cpk);
                const int lt = half_sum_i((int)(a & 0xffffu) + (int)(a >> 16));
                if (512 - lt >= ks) est = cu; } }
          int lo = 0, hi = 65536, chi = 0, ge, ltl, step = 64; bool kl = false, kh = false;
          int ltlo = 0, lthi = 16 * nt2;
          for (;;) {
              const bool fin = kl && kh && (hi - lo <= 1);
              if (__ballot(!fin) == 0ull) break;
              const bool gal = kl != kh;
              int cand = (kl && kh) ? lo + ((hi - lo) >> 1) : kl ? lo + step : kh ? hi - step : est;
              cand = cand < 0 ? 0 : (cand > 65535 ? 65535 : cand);
              P2_COUNT_GE(cand, ge, ltl);
              if (ge >= TOPK) { if (cand >= lo) { lo = cand; ltlo = ltl; } kl = true; if (cand == 65535) kh = true; }
              else { if (cand < hi) { hi = cand; chi = ge; lthi = ltl; } kh = true; }
              if (gal) step <<= 1;
          }
#undef P2_COUNT_GE
#undef P2_SS
          Tu = lo; lastrej = chi; eqc = lthi - ltlo; }
        const unsigned ts16 = (unsigned)(Tu - 32768) & 0xffffu, tpk = ts16 | (ts16 << 16);
        const int need = TOPK - lastrej;
        int quota;
        { const int eq = eqc;
          int incl = eq;
#pragma unroll
          for (int o = 1; o < 32; o <<= 1) { const int v = __shfl_up(incl, o, 32); incl += ((lane & 31) >= o) ? v : 0; }
          const int excl = incl - eq; quota = need - excl; quota = quota < 0 ? 0 : (quota > eq ? eq : quota); }
        const int Ts = (int)(short)ts16;
#ifndef P2_FINREP
#define P2_FINREP 1
#endif
        int run = 0;
        const bool simple = __ballot((quota > 0) && (quota < eqc)) == 0ull;
        const short te = (short)((quota > 0) ? Ts - 1 : Ts);
        for (int frep_ = 0; frep_ < P2_FINREP; ++frep_) { run = 0;
        for (int g = 0; g < 4; ++g) {
            unsigned W0 = 0u, W1 = 0u;
            if (4 * g < nt2) {
                if (simple) {
#pragma unroll
                  for (int s = 0; s < 64; ++s) {
                    const unsigned v = scv[(s >> 1) & 7][4 * g + (s >> 4)];
                    const short key = (s & 1) ? (short)(v >> 16) : (short)(v & 0xffffu);
                    const unsigned long long msk = __ballot(key > te);
                    const unsigned mlo = (unsigned)msk, mhi = (unsigned)(msk >> 32);
                    P2_WRITELANE2(W0, W1, mlo, mhi, s);
                  }
                } else {
#pragma unroll
                  for (int s = 0; s < 64; ++s) {
                    const unsigned v = scv[(s >> 1) & 7][4 * g + (s >> 4)];
                    const int key = (s & 1) ? ((int)v >> 16) : (int)(short)(v & 0xffffu);
                    const bool eq = key == Ts; const bool take = eq && (run < quota); run += eq ? 1 : 0;
                    const unsigned long long msk = __ballot((key > Ts) || take);
                    const unsigned mlo = (unsigned)msk, mhi = (unsigned)(msk >> 32);
                    P2_WRITELANE2(W0, W1, mlo, mhi, s);
                  }
                }
            }
            bm0[64 * g + lane] = W0; bm1[64 * g + lane] = W1;
        }
        }
    }
}
__device__ __forceinline__ float unsort_mid(unsigned m, unsigned lowmask, unsigned mid) { const unsigned u = (m & ~lowmask) | mid; return __uint_as_float((u & 0x80000000u) ? (u ^ 0x80000000u) : ~u); }
__device__ __forceinline__ unsigned umax3(unsigned a, unsigned b, unsigned c) { return max(max(a, b), c); }
__device__ __forceinline__ void ce_desc(unsigned& a, unsigned& b) { const unsigned hi = max(a, b), lo = min(a, b); a = hi; b = lo; }
__device__ __forceinline__ void merge16_desc(unsigned (&v)[16]) {
#pragma unroll
    for (int j = 8; j >= 1; j >>= 1)
#pragma unroll
        for (int i = 0; i < 16; ++i) { const int l = i ^ j; if (l > i) ce_desc(v[i], v[l]); }
}
__device__ __forceinline__ void sort16_desc(unsigned (&v)[16]) {
#pragma unroll
    for (int k = 2; k <= 16; k <<= 1)
#pragma unroll
        for (int j = k >> 1; j >= 1; j >>= 1)
#pragma unroll
            for (int i = 0; i < 16; ++i) { const int l = i ^ j; if (l > i) { if ((i & k) == 0) ce_desc(v[i], v[l]); else ce_desc(v[l], v[i]); } }
}
constexpr int SK_PITCH = 272;
__device__ __forceinline__ void p7_peer(Frame& F, unsigned* keys1, unsigned short* eig, float* gtg) {
    const int lane = F.lane, wave = F.wave, tid = F.tid;
    LAS unsigned char* SK = F.lds + RING_OFF;
    LAS int* EI = (LAS int*)(F.lds + RING_OFF);
    LAS float* GT = (LAS float*)(F.lds + RING_OFF + 32768);
    const int nunits = M / 64;
    for (int unit = blockIdx.x; unit < nunits; unit += F.G) {
        const int t0 = unit * 64;
        const int c = wave >> 2, tok = t0 + (wave & 3) * 16 + (lane & 15), q4 = lane >> 4;
        v4u stg[8]; bf16x8_t qn[4];
#define P7_PREF(H) do { const v4u* src_ = (const v4u*)(F.SUBK + (size_t)(H) * 2 * NKEYS * 128);     \
            _Pragma("unroll") for (int i = 0; i < 8; ++i) stg[i] = src_[tid + 512 * i]; \
            _Pragma("unroll") for (int s_ = 0; s_ < 4; ++s_) qn[s_] = *(const bf16x8_t*)(F.QP + (size_t)tok * 2048 + (H) * 256 + c * 128 + 32 * s_ + 8 * q4); } while (0)
        P7_PREF(0);
        for (int h = 0; h < PEER_H; ++h) {
            __syncthreads();
#pragma unroll
            for (int i = 0; i < 8; ++i) { const int p = tid + 512 * i, row = p >> 4, c16 = p & 15; *(LAS v4u*)(SK + row * SK_PITCH + c16 * 16) = stg[i]; }
            bf16x8_t qf[4];
#pragma unroll
            for (int s = 0; s < 4; ++s) qf[s] = qn[s];
            __syncthreads();
            if (h + 1 < PEER_H) P7_PREF(h + 1);
            unsigned pk[32];
#pragma unroll
            for (int kb = 0; kb < 8; ++kb) { f32x4 acc = (f32x4){0.f, 0.f, 0.f, 0.f};
#pragma unroll
                for (int s = 0; s < 4; ++s) { const bf16x8_t a = *(const LAS bf16x8_t*)(SK + (c * 128 + 16 * kb + (lane & 15)) * SK_PITCH + (32 * s + 8 * q4) * 2);
                    acc = __builtin_amdgcn_mfma_f32_16x16x32_bf16(a, qf[s], acc, 0, 0, 0); }
#pragma unroll
                for (int i = 0; i < 4; ++i) pk[kb * 4 + i] = (sortable(acc[i]) & ~0x7Fu) | (unsigned)(127 - (16 * kb + 4 * q4 + i)); }
            unsigned Mr[16];
            { unsigned A[16], B[16];
#pragma unroll
              for (int i = 0; i < 16; ++i) { A[i] = pk[i]; B[i] = pk[16 + i]; }
              sort16_desc(A); sort16_desc(B);
#pragma unroll
              for (int i = 0; i < 16; ++i) Mr[i] = max(A[i], B[15 - i]);
              merge16_desc(Mr);
              unsigned P[16];
#pragma unroll
              for (int i = 0; i < 16; ++i) { const auto sw = __builtin_amdgcn_permlane16_swap(Mr[15 - i], Mr[i], false, false); P[i] = sw[1]; }
#pragma unroll
              for (int i = 0; i < 16; ++i) Mr[i] = max(Mr[i], P[i]);
              merge16_desc(Mr);
#pragma unroll
              for (int i = 0; i < 16; ++i) { const auto sw = __builtin_amdgcn_permlane32_swap(Mr[15 - i], Mr[15 - i], false, false); P[i] = sw[1]; }
#pragma unroll
              for (int i = 0; i < 16; ++i) Mr[i] = max(Mr[i], P[i]);
              merge16_desc(Mr); }
            if (q4 == 0) { v4u* dst = (v4u*)(keys1 + (((size_t)tok * 8 + h) * 2 + c) * 16);
#pragma unroll
                for (int i = 0; i < 4; ++i) dst[i] = (v4u){Mr[4 * i], Mr[4 * i + 1], Mr[4 * i + 2], Mr[4 * i + 3]}; }
        }
#undef P7_PREF
        VM_WAIT(); __syncthreads();
        { const int tl = tid & 63, h = tid >> 6, tok = t0 + tl;
          const unsigned* kp = keys1 + ((size_t)tok * 8 + h) * 32;
          unsigned kk[32];
#pragma unroll
          for (int i = 0; i < 8; ++i) { const v4u w = ((const v4u*)kp)[i]; kk[4 * i] = w.x; kk[4 * i + 1] = w.y; kk[4 * i + 2] = w.z; kk[4 * i + 3] = w.w; }
          float s0[16], s1[16];
#pragma unroll
          for (int i = 0; i < 16; ++i) { s0[i] = unsort_mid(kk[i], 0x7Fu, 0x40u); s1[i] = unsort_mid(kk[16 + i], 0x7Fu, 0x40u); }
          unsigned x0[16], x1[16];
#pragma unroll
          for (int i = 0; i < 16; ++i) { x0[i] = (127u - (kk[i] & 0x7Fu)) * NKEYS; x1[i] = 127u - (kk[16 + i] & 0x7Fu); }
          unsigned ck[50]; { int k = 0;
#pragma unroll
            for (int i = 0; i < 16; ++i)
#pragma unroll
                for (int j = 0; j < 16; ++j) if ((i + 1) * (j + 1) <= 16) { ck[k] = (sortable(s0[i] + s1[j]) & ~0x3FFFu) | (x0[i] + x1[j]); ++k; } }
          unsigned G1[16], G2[16], G3[16], Fw[16];
#pragma unroll
          for (int i = 0; i < 16; ++i) { G1[i] = ck[i]; G2[i] = ck[16 + i]; G3[i] = ck[32 + i]; }
          sort16_desc(G2); sort16_desc(G3);
          { unsigned g40 = ck[48], g41 = ck[49]; ce_desc(g40, g41);
#pragma unroll
            for (int i = 0; i < 16; ++i) G1[i] = max(G1[i], G2[15 - i]);
            merge16_desc(G1);
            G3[15] = max(G3[15], g40); G3[14] = max(G3[14], g41);
            merge16_desc(G3); }
#pragma unroll
          for (int i = 0; i < 16; ++i) Fw[i] = max(G1[i], G3[15 - i]);
          merge16_desc(Fw);
          float ts[16];
#pragma unroll
          for (int r = 0; r < 16; ++r) { ts[r] = unsort_mid(Fw[r], 0x3FFFu, 0x2000u); EI[tl * 128 + h * 16 + r] = (int)(Fw[r] & 0x3FFFu); }
          float ex[16]; float sum = 0.f;
#pragma unroll
          for (int r = 0; r < 16; ++r) { ex[r] = __expf(ts[r] - ts[0]); sum += ex[r]; }
          const float inv = 1.0f / sum;
#pragma unroll
          for (int r = 0; r < 16; ++r) GT[tl * 128 + h * 16 + r] = ex[r] * inv;
        }
        __syncthreads();
        { v2u* de = (v2u*)(eig + (size_t)t0 * 128); v4u* dg = (v4u*)(gtg + (size_t)t0 * 128); const LAS v4u* se = (const LAS v4u*)EI; const LAS v4u* sg = (const LAS v4u*)GT;
#pragma unroll
          for (int i = 0; i < 4; ++i) { const v4u e4 = se[tid + 512 * i]; v2u o; o.x = e4.x | (e4.y << 16); o.y = e4.z | (e4.w << 16); de[tid + 512 * i] = o; dg[tid + 512 * i] = sg[tid + 512 * i]; } }
    }
}
constexpr int CW_UCNT = 8192, CW_VCNT = 9216;
__device__ __forceinline__ int p7_next_unit(Frame& F, unsigned* cnt, int myp, int& pq, int ntiles) {
    for (;;) {
        if (pq >= 8) return -1;
        const int p = (myp + pq) & 7;
        if (F.tid == 0) F.MISC[16] = __hip_atomic_fetch_add(cnt + 64 * p, 1u, __ATOMIC_RELAXED, __HIP_MEMORY_SCOPE_AGENT);
        __syncthreads(); const unsigned idx = F.MISC[16]; __syncthreads();
        if (idx < (unsigned)ntiles) return p * ntiles + (int)idx;
        ++pq;
    }
}
typedef float f32x2_ __attribute__((ext_vector_type(2)));
__device__ __forceinline__ void p7_uphase(Frame& F, const unsigned short* eig, bf16* part, int cntoff) {
    const int lane = F.lane, wave = F.wave;
    const int myp = (int)(xb_xcc_id() & 7u); int pq = 0;
    LAS int* EL = (LAS int*)(F.lds + RING_OFF + wave * 4096);
    const unsigned char* EU8 = (const unsigned char*)F.EU;
    const int g = lane >> 3, c = lane & 7;
    for (;;) {
        const int unit = p7_next_unit(F, F.ctl + CW_UCNT + cntoff, myp, pq, M / 256); if (unit < 0) break;
        const int p = unit / (M / 256), tw = (unit % (M / 256)) * 256 + wave * 32;
        const unsigned char* ubase = EU8 + (size_t)p * (16384 * 128) + 16 * c;
        bf16* pp = part + (size_t)p * M * 128;
        f32x4 g2[4];
#pragma unroll
        for (int q = 0; q < 4; ++q) g2[q] = *(const f32x4*)(F.ffn_g + 128 * p + 16 * c + 4 * q);
        int e0, e1;
#define PU_FETCH(T) do { e0 = __builtin_nontemporal_load(eig + (size_t)(T) * 128 + lane); e1 = __builtin_nontemporal_load(eig + (size_t)(T) * 128 + 64 + lane); } while (0)
#define PU_STASH(BUF) do { EL[(BUF) * 128 + lane] = e0; EL[(BUF) * 128 + 64 + lane] = e1; LDS_WAIT(); } while (0)
#define PU_XLOAD(S, T) do { xa##S = __builtin_nontemporal_load((const v4u*)(F.XB + (size_t)(T) * D + 128 * p + 16 * c)); xb##S = __builtin_nontemporal_load((const v4u*)(F.XB + (size_t)(T) * D + 128 * p + 16 * c + 8)); ss##S = F.ss1[T]; } while (0)
#define PU_XCVT(S) do { xv[0] = (f32x4){bflo(xa##S.x), bfhi(xa##S.x), bflo(xa##S.y), bfhi(xa##S.y)}; xv[1] = (f32x4){bflo(xa##S.z), bfhi(xa##S.z), bflo(xa##S.w), bfhi(xa##S.w)}; \
            xv[2] = (f32x4){bflo(xb##S.x), bfhi(xb##S.x), bflo(xb##S.y), bfhi(xb##S.y)}; xv[3] = (f32x4){bflo(xb##S.z), bfhi(xb##S.z), bflo(xb##S.w), bfhi(xb##S.w)}; rs2 = rsqrtf(ss##S * (1.0f / D) + EPS); } while (0)
#define PU_GATHER(VR, BUF) do { _Pragma("unroll") for (int i_ = 0; i_ < 16; ++i_) { const int e_ = EL[(BUF) * 128 + 8 * i_ + g]; VR[i_] = *(const v4u*)(ubase + (size_t)e_ * 128); } } while (0)
#define PU_REDUCE(VR, S, T) do { \
            PU_XCVT(S); f32x2_ hx2[8]; \
            _Pragma("unroll") for (int q_ = 0; q_ < 4; ++q_) { const f32x4 h_ = xv[q_] * g2[q_] * rs2; hx2[2 * q_] = (f32x2_){h_[0], h_[1]}; hx2[2 * q_ + 1] = (f32x2_){h_[2], h_[3]}; } \
            float v16[16]; \
            _Pragma("unroll") for (int i_ = 0; i_ < 16; ++i_) { f32x2_ d2_ = (f32x2_){0.f, 0.f}; \
                _Pragma("unroll") for (int j_ = 0; j_ < 4; ++j_) { const f32x2_ lo_ = __builtin_amdgcn_cvt_pk_f32_fp8((int)VR[i_][j_], false), hi_ = __builtin_amdgcn_cvt_pk_f32_fp8((int)VR[i_][j_], true); \
                    d2_ = __builtin_elementwise_fma(lo_, hx2[2 * j_], d2_); d2_ = __builtin_elementwise_fma(hi_, hx2[2 * j_ + 1], d2_); } \
                v16[i_] = d2_.x + d2_.y; } \
              \
            float w8[8], w4[4], w2[2]; \
              \
              \
            { float k8_[8], s8_[8]; \
              _Pragma("unroll") for (int j_ = 0; j_ < 8; ++j_) { const float a_ = v16[2 * j_], b_ = v16[2 * j_ + 1]; k8_[j_] = (lane & 1) ? b_ : a_; s8_[j_] = (lane & 1) ? a_ : b_; } \
              __builtin_amdgcn_sched_barrier(0); \
              _Pragma("unroll") for (int j_ = 0; j_ < 8; ++j_) w8[j_] = k8_[j_] + lane_xor1(s8_[j_]); \
              __builtin_amdgcn_sched_barrier(0); } \
            { float k4_[4], s4_[4]; \
              _Pragma("unroll") for (int j_ = 0; j_ < 4; ++j_) { const float a_ = w8[2 * j_], b_ = w8[2 * j_ + 1]; k4_[j_] = (lane & 2) ? b_ : a_; s4_[j_] = (lane & 2) ? a_ : b_; } \
              __builtin_amdgcn_sched_barrier(0); \
              _Pragma("unroll") for (int j_ = 0; j_ < 4; ++j_) w4[j_] = k4_[j_] + lane_xor2(s4_[j_]); \
              __builtin_amdgcn_sched_barrier(0); } \
            _Pragma("unroll") for (int j_ = 0; j_ < 2; ++j_) { const float a_ = w4[2 * j_], b_ = w4[2 * j_ + 1]; w2[j_] = ((lane & 4) ? b_ : a_) + lane_xor4((lane & 4) ? a_ : b_, (lane & 4) != 0); } \
            pp[(size_t)(T) * 128 + 8 * c + g] = (bf16)f2bf(w2[0]); pp[(size_t)(T) * 128 + 64 + 8 * c + g] = (bf16)f2bf(w2[1]); } while (0)
        v4u vA[16], vB[16]; f32x4 xv[4]; float rs2; v4u xaA, xbA, xaB, xbB; float ssA, ssB;
        PU_FETCH(tw); PU_STASH(0); PU_GATHER(vA, 0); PU_FETCH(tw + 1); PU_STASH(1); PU_XLOAD(A, tw);
        for (int ti = 0; ti < 32; ti += 2) {
            PU_XLOAD(B, tw + ti + 1);
            if (ti + 2 < 32) PU_FETCH(tw + ti + 2);
            PU_GATHER(vB, 1);
            PU_REDUCE(vA, A, tw + ti);
            if (ti + 2 < 32) PU_STASH(0);
            PU_XLOAD(A, tw + (ti + 2 < 32 ? ti + 2 : 31));
            if (ti + 3 < 32) PU_FETCH(tw + ti + 3);
            if (ti + 2 < 32) PU_GATHER(vA, 0);
            PU_REDUCE(vB, B, tw + ti + 1);
            if (ti + 3 < 32) PU_STASH(1);
        }
#undef PU_FETCH
#undef PU_STASH
#undef PU_XLOAD
#undef PU_XCVT
#undef PU_GATHER
#undef PU_REDUCE
    }
}
__device__ __forceinline__ void p7_reduce(Frame& F, const bf16* part, const float* gtg, float* actg) {
    const int lane = F.lane;
    for (int t = F.gw; t < M; t += F.NGW) {
        float s0 = 0.f, s1 = 0.f;
#pragma unroll
        for (int q = 0; q < 8; ++q) { s0 += bf1(__builtin_nontemporal_load(part + ((size_t)q * M + t) * 128 + lane)); s1 += bf1(__builtin_nontemporal_load(part + ((size_t)q * M + t) * 128 + 64 + lane)); }
        actg[(size_t)t * 128 + lane] = gelu_tanh(s0 * (1.0f / EU_SCALE)) * gtg[(size_t)t * 128 + lane];
        actg[(size_t)t * 128 + 64 + lane] = gelu_tanh(s1 * (1.0f / EU_SCALE)) * gtg[(size_t)t * 128 + 64 + lane];
    }
}
__device__ __forceinline__ void p7_vphase(Frame& F, const unsigned short* eig, const float* actg, float* ss2, int cntoff, bool dry) {
    const int lane = F.lane, wave = F.wave;
    const int myp = (int)(xb_xcc_id() & 7u); int pq = 0;
    LAS int* EL = (LAS int*)(F.lds + RING_OFF + wave * 4096);
    LAS float* AL = (LAS float*)(F.lds + RING_OFF + wave * 4096 + 1024);
    LAS float* OS = (LAS float*)(F.lds + RING_OFF + wave * 4096 + 2048);
    const unsigned char* EV8 = (const unsigned char*)F.EV;
    const int g = lane >> 3, c = lane & 7;
    const int b3 = (lane >> 3) & 1, b4 = (lane >> 4) & 1, b5 = (lane >> 5) & 1;
    const int colp = 16 * (lane & 7) + 8 * b5 + 4 * b4 + 2 * b3;
    for (;;) {
        const int unit = p7_next_unit(F, F.ctl + CW_VCNT + cntoff, myp, pq, M / 256); if (unit < 0) break;
        const int p = unit / (M / 256), tw = (unit % (M / 256)) * 256 + wave * 32;
        const unsigned char* vbase = EV8 + (size_t)p * (16384 * 128) + 16 * c;
        int e0, e1; float a0, a1;
#define PV_FETCH(T) do { e0 = __builtin_nontemporal_load(eig + (size_t)(T) * 128 + lane); e1 = __builtin_nontemporal_load(eig + (size_t)(T) * 128 + 64 + lane); \
                         a0 = __builtin_nontemporal_load(actg + (size_t)(T) * 128 + lane); a1 = __builtin_nontemporal_load(actg + (size_t)(T) * 128 + 64 + lane); } while (0)
#define PV_STASH(BUF) do { EL[(BUF) * 128 + lane] = e0; EL[(BUF) * 128 + 64 + lane] = e1; AL[(BUF) * 128 + lane] = a0 * (1.0f / EV_SCALE); AL[(BUF) * 128 + 64 + lane] = a1 * (1.0f / EV_SCALE); LDS_WAIT(); } while (0)
#define PV_GATHER(VR, BUF) do { _Pragma("unroll") for (int i_ = 0; i_ < 16; ++i_) { const int e_ = EL[(BUF) * 128 + 8 * i_ + g]; VR[i_] = *(const v4u*)(vbase + (size_t)e_ * 128); } } while (0)
#define PV_XLOAD(T) do { xw = *(const unsigned*)(F.XB + (size_t)(T) * D + 128 * p + colp); } while (0)
#define PV_REDUCE(VR, BUF, T) do { \
            const size_t off_ = (size_t)(T) * D + 128 * p + colp; \
            f32x2_ ac2[8]; \
            _Pragma("unroll") for (int k_ = 0; k_ < 8; ++k_) ac2[k_] = (f32x2_){0.f, 0.f}; \
            _Pragma("unroll") for (int i_ = 0; i_ < 16; ++i_) { const float a_ = AL[(BUF) * 128 + 8 * i_ + g]; const f32x2_ aa_ = (f32x2_){a_, a_}; \
                _Pragma("unroll") for (int j_ = 0; j_ < 4; ++j_) { const f32x2_ lo_ = __builtin_amdgcn_cvt_pk_f32_fp8((int)VR[i_][j_], false), hi_ = __builtin_amdgcn_cvt_pk_f32_fp8((int)VR[i_][j_], true); \
                    ac2[2 * j_] = __builtin_elementwise_fma(aa_, lo_, ac2[2 * j_]); ac2[2 * j_ + 1] = __builtin_elementwise_fma(aa_, hi_, ac2[2 * j_ + 1]); } } \
            float acc[16]; \
            _Pragma("unroll") for (int k_ = 0; k_ < 8; ++k_) { acc[2 * k_] = ac2[k_].x; acc[2 * k_ + 1] = ac2[k_].y; } \
            float a8[8], a4[4], c2[2]; \
              \
            _Pragma("unroll") for (int j_ = 0; j_ < 8; ++j_) { const auto sw_ = __builtin_amdgcn_permlane32_swap(__float_as_uint(acc[j_]), __float_as_uint(acc[j_ + 8]), false, false); a8[j_] = __uint_as_float(sw_[0]) + __uint_as_float(sw_[1]); } \
            _Pragma("unroll") for (int j_ = 0; j_ < 4; ++j_) { const auto sw_ = __builtin_amdgcn_permlane16_swap(__float_as_uint(a8[j_]), __float_as_uint(a8[j_ + 4]), false, false); a4[j_] = __uint_as_float(sw_[0]) + __uint_as_float(sw_[1]); } \
            _Pragma("unroll") for (int j_ = 0; j_ < 2; ++j_) { const float a_ = a4[j_], b_ = a4[j_ + 2]; c2[j_] = (b3 ? b_ : a_) + lane_xor8(b3 ? a_ : b_); } \
            const float x0_ = bflo(xw) + c2[0], x1_ = bfhi(xw) + c2[1]; \
            if (!dry) *(unsigned*)(F.XB + off_) = pk2(x0_, x1_); \
            const float ssq_ = wave_sum(x0_ * x0_ + x1_ * x1_); if (lane == 0) atomicAdd(ss2 + (T), dry ? 0.f : ssq_); } while (0)
        v4u vA[16], vB[16]; unsigned xw;
        PV_FETCH(tw); PV_STASH(0); PV_GATHER(vA, 0); PV_FETCH(tw + 1); PV_STASH(1);
        for (int ti = 0; ti < 32; ti += 2) {
            PV_XLOAD(tw + ti);
            if (ti + 2 < 32) PV_FETCH(tw + ti + 2);
            PV_GATHER(vB, 1);
            PV_REDUCE(vA, 0, tw + ti);
            if (ti + 2 < 32) PV_STASH(0);
            PV_XLOAD(tw + ti + 1);
            if (ti + 3 < 32) PV_FETCH(tw + ti + 3);
            if (ti + 2 < 32) PV_GATHER(vA, 0);
            PV_REDUCE(vB, 1, tw + ti + 1);
            if (ti + 3 < 32) PV_STASH(1);
        }
#undef PV_XLOAD
#undef PV_FETCH
#undef PV_STASH
#undef PV_GATHER
#undef PV_REDUCE
    }
}
constexpr int NPHASE = 12;
struct Args { const float* in[23]; float* out; unsigned char* ws; int ph_lo, ph_hi; };
__global__ void __launch_bounds__(NWAVES * 64, 2) fwd(Args args) {
    extern __shared__ __attribute__((aligned(16))) unsigned char lds[];
    Frame F;
    F.lds = (LAS unsigned char*)lds; F.MISC = (volatile LAS unsigned*)(F.lds + MISC_OFF);
    F.tid = threadIdx.x; F.lane = F.tid & 63; F.wave = __builtin_amdgcn_readfirstlane(F.tid >> 6); F.G = gridDim.x;
    F.gw = blockIdx.x * NWAVES + F.wave; F.NGW = F.G * NWAVES;
    unsigned char* ws = args.ws;
    F.ctl = (unsigned*)(ws + WS_CTL);
    F.x = args.in[0]; F.p = args.in[1]; F.rel_bias = args.in[2]; F.attn_g = args.in[3]; F.w_in = args.in[4]; F.b_gate = args.in[5]; F.q_g = args.in[6]; F.k_g = args.in[7];
    F.w_att = args.in[8]; F.conv_w = args.in[9]; F.conv_b = args.in[10]; F.ln_g = args.in[11]; F.ln_b = args.in[12]; F.w_conv = args.in[13]; F.w_out = args.in[14]; F.ffn_g = args.in[15];
    F.w_pq = args.in[16]; F.subk = args.in[17]; F.pu = args.in[18]; F.pv = args.in[19]; F.ple_g = args.in[20]; F.w_pg = args.in[21]; F.w_pp = args.in[22]; F.out = args.out;
    F.ss1 = (float*)(ws + WS_SS1); F.ss2 = (float*)(ws + WS_SS1 + 128 * 1024); F.rstd1 = (float*)(ws + WS_RSTD1); F.rstd3 = (float*)(ws + WS_RSTD3); F.tab = (float*)(ws + WS_TAB); F.mb = (float*)(ws + WS_TAB + 64 * 1024); F.WI = (float*)(ws + WS_WI); F.KI = (bf16*)(ws + WS_KI);
    F.Win_t = (bf16*)(ws + WS_WIN); F.Wa_t = (bf16*)(ws + WS_WA); F.Wc_t = (bf16*)(ws + WS_WC); F.Wout_t = (bf16*)(ws + WS_WOUT); F.Wq_t = (bf16*)(ws + WS_WQ); F.Wg_t = (bf16*)(ws + WS_WG); F.Wp_t = (bf16*)(ws + WS_WP);
    F.SUBK = (bf16*)(ws + WS_SUBK); F.EU = (bf16*)(ws + WS_EU); F.EV = (bf16*)(ws + WS_EV); F.PB = (bf16*)(ws + WS_PB);
    F.XB = (bf16*)(ws + WS_RC); F.ATT = (bf16*)(ws + WS_RA + 64 * MiB); F.CV = (bf16*)(ws + WS_RA + 96 * MiB);
    F.UB = (bf16*)(ws + WS_RD); F.bitmap = (unsigned*)(ws + WS_RD + 32 * MiB); F.MIX = (bf16*)(ws + WS_RD); F.PP = (bf16*)(ws + WS_RD);
    F.Q = (bf16*)(ws + WS_RB); F.K = (bf16*)(ws + WS_RB + 32 * MiB); F.V = (bf16*)(ws + WS_RB + 64 * MiB); F.QI = (bf16*)(ws + WS_RB + 96 * MiB);
    F.GB = (bf16*)(ws + WS_RA); F.QP = (bf16*)(ws + WS_RA);
    for (int u = F.tid; u < (LDS_BYTES - LDSCTL_OFF) / 4; u += NWAVES * 64) ((LAS unsigned*)(F.lds + LDSCTL_OFF))[u] = 0u;
    __syncthreads();
    const int lo = args.ph_lo, hi = args.ph_hi;
    XcdBarrier bar; bar.bar = F.ctl + CW_BAR; bar.x = 0; bar.st = nullptr;
    if (hi - lo > 1) bar = xcd_barrier_post(F.ctl + CW_BAR, F.MISC + 8);
#ifndef PH_MASK
#define PH_MASK 0xfff
#endif
#define IN(k) (((PH_MASK >> (k)) & 1) && lo <= (k) && (k) < hi)
#define SEAM(k) do { if (IN(k) && IN((k) + 1)) xcd_barrier(bar); } while (0)
#ifndef REP_MASK
#define REP_MASK 0
#endif
#define NREP(k) (((REP_MASK >> (k)) & 1) ? 2 : 1)
    const int bid = (int)blockIdx.x;

    if (IN(0)) for (int rep_ = 0; rep_ < NREP(0); ++rep_) { p0_prologue(F); } SEAM(0);
    if (IN(1)) for (int rep_ = 0; rep_ < NREP(1); ++rep_) {
        pg8::Gemm g{F.XB, F.Win_t, M, NIN, opaque_i(D)}; pg8::StaticOrder S; S.init(M, NIN, F.G, bid);
        epi::EpiInProj E{F.rstd1, F.Q, F.K, F.V, F.QI, F.UB, F.GB, F.KI, F.WI, F.q_g, F.k_g, F.b_gate};
        pg8::gemm_phase<epi::EpiInProj, pg8::StaticOrder, true, true>(F.lds + RING_OFF, g, S, E);
    } SEAM(1);
#ifdef NAIVE_P2
    if (IN(2)) for (int rep_ = 0; rep_ < NREP(2); ++rep_) { p2_index_naive(F, F.out); p2_conv_naive(F); } SEAM(2);
#else
    if (IN(2)) for (int rep_ = 0; rep_ < NREP(2); ++rep_) { for (int r2_ = 0; r2_ < NREP(9); ++r2_) p2_index(F); for (int r2_ = 0; r2_ < NREP(10); ++r2_) p2_conv(F); } SEAM(2);
#endif
#ifdef NAIVE_P3
    if (IN(3)) for (int rep_ = 0; rep_ < NREP(3); ++rep_) { p3_attn_naive(F); } SEAM(3);
#else
    if (IN(3)) for (int rep_ = 0; rep_ < NREP(3); ++rep_) { static_assert(attn2::ATTN_LDS_BYTES <= RING_BYTES && attn2::TBN == TABN && attn2::TBOFF == TABOFF, "attention body vs frame");
        const attn2::StaticOrder S((int)F.G, bid);
        attn2::attn_phase((char*)lds + RING_OFF, (const attn2::bf16*)F.Q, (const attn2::bf16*)F.K, (const attn2::bf16*)F.V, (attn2::bf16*)F.ATT, F.bitmap, F.tab, F.mb, S); } SEAM(3);
#endif
    if (IN(4)) for (int rep_ = 0; rep_ < NREP(4); ++rep_) {
        { pg8::Gemm g{F.ATT, F.Wa_t, M, D, opaque_i(1024)}; pg8::StaticOrder S; S.init(M, D, F.G, bid); epi::EpiGate2 E{(const unsigned char*)F.GB, F.MIX};
          pg8::gemm_phase<epi::EpiGate2, pg8::StaticOrder, true, true, true>(F.lds + RING_OFF, g, S, E); }
    } SEAM(4);
    if (IN(5)) for (int rep_ = 0; rep_ < NREP(5); ++rep_) {
        pg8::Gemm g{F.MIX, F.Wout_t, M, D, opaque_i(D)}; pg8::StaticOrder S; S.init(M, D, F.G, bid); epi::EpiRes1 E{F.x, F.out, F.XB, F.ss1};
        pg8::gemm_phase<epi::EpiRes1, pg8::StaticOrder, true, true>(F.lds + RING_OFF, g, S, E);
    } SEAM(5);
    if (IN(6)) for (int rep_ = 0; rep_ < NREP(6); ++rep_) {
        pg8::Gemm g{F.XB, F.Wq_t, M, 2048, opaque_i(D)}; pg8::StaticOrder S; S.init(M, 2048, F.G, bid); epi::EpiScaleRow E{F.ss1, F.QP, 2048};
        pg8::gemm_phase<epi::EpiScaleRow, pg8::StaticOrder, true, true>(F.lds + RING_OFF, g, S, E);
    } SEAM(6);
#ifdef NAIVE_P7
    if (IN(7)) for (int rep_ = 0; rep_ < NREP(7); ++rep_) { p7_peer_naive(F); } SEAM(7);
#else
    if (IN(7)) for (int rep_ = 0; rep_ < NREP(7); ++rep_) { p7_peer(F, (unsigned*)(ws + WS_RB), (unsigned short*)(ws + WS_RB + 40 * MiB), (float*)(ws + WS_RB + 56 * MiB)); } SEAM(7);
    if (IN(8)) for (int rep_ = 0; rep_ < NREP(11); ++rep_) { p7_uphase(F, (const unsigned short*)(ws + WS_RB + 40 * MiB), (bf16*)(ws + WS_RA), rep_ * 2048); } SEAM(8);
    if (IN(9)) for (int rep_ = 0; rep_ < NREP(13); ++rep_) { p7_reduce(F, (const bf16*)(ws + WS_RA), (const float*)(ws + WS_RB + 56 * MiB), (float*)(ws + WS_RB + 72 * MiB)); } SEAM(9);
    if (IN(10)) for (int rep_ = 0; rep_ < NREP(12); ++rep_) { p7_vphase(F, (const unsigned short*)(ws + WS_RB + 40 * MiB), (const float*)(ws + WS_RB + 72 * MiB), F.ss2, rep_ * 2048, rep_ + 1 < NREP(12)); } SEAM(10);
#endif
    if (IN(11)) for (int rep_ = 0; rep_ < NREP(8); ++rep_) {
#ifndef NO8A
        { pg8::Gemm g{F.PB, F.Wp_t, M, D, opaque_i(PLE)}; pg8::StaticOrder S; S.init(M, D, F.G, bid); epi::EpiPlain E{F.PP, D};
          pg8::gemm_phase<epi::EpiPlain, pg8::StaticOrder, true, true>(F.lds + RING_OFF, g, S, E); }
#endif
#ifndef NO8B
        { pg8::Gemm g{F.XB, F.Wg_t, M, D, opaque_i(D)}; pg8::StaticOrder S; S.init(M, D, F.G, bid); epi::EpiPle E{F.ss2, F.PP, F.XB, F.out};
          pg8::gemm_phase<epi::EpiPle, pg8::StaticOrder, true, true>(F.lds + RING_OFF, g, S, E); }
#endif
    }
#undef IN
#undef SEAM
}

#ifndef MK_MULTI
#define MK_MULTI 0
#endif
extern "C" void kernel_launch(void* const* d_in, const int* in_sizes, int n_in, void* d_out, int out_size, void* d_ws, size_t ws_size, hipStream_t stream) {
    static int grid = 0;
    if (grid == 0) {
        if (n_in != 23 || in_sizes[0] != M * D || out_size != M * D || ws_size < WS_END) { fprintf(stderr, "kernel_launch: unexpected problem: n_in %d in0 %d out %d ws %zu (need %zu)\n", n_in, n_in > 0 ? in_sizes[0] : -1, out_size, ws_size, (size_t)WS_END); grid = -1; return; }
        int dev = 0, cus = 0;
        if (hipGetDevice(&dev) != hipSuccess || hipDeviceGetAttribute(&cus, hipDeviceAttributeMultiprocessorCount, dev) != hipSuccess) { grid = -1; return; }
        if (hipFuncSetAttribute((const void*)fwd, hipFuncAttributeMaxDynamicSharedMemorySize, LDS_BYTES) != hipSuccess) { fprintf(stderr, "kernel_launch: hipFuncSetAttribute failed\n"); grid = -1; return; }
        int per_cu = 0;
        if (hipOccupancyMaxActiveBlocksPerMultiprocessor(&per_cu, (const void*)fwd, NWAVES * 64, LDS_BYTES) != hipSuccess || per_cu < 1) fprintf(stderr, "kernel_launch: occupancy query says %d\n", per_cu);
        (void)hipGetLastError();
        grid = cus;
    }
    if (grid < 0) return;
    if (hipMemsetAsync((char*)d_ws + WS_CTL, 0, CTL_ZERO_BYTES, stream) != hipSuccess) return;
    Args a{};
    for (int i = 0; i < 23; ++i) a.in[i] = (const float*)d_in[i];
    a.out = (float*)d_out; a.ws = (unsigned char*)d_ws;
#if MK_MULTI
    for (int ph = 0; ph < NPHASE; ++ph) { a.ph_lo = ph; a.ph_hi = ph + 1; hipLaunchKernelGGL(fwd, dim3(grid), dim3(NWAVES * 64), LDS_BYTES, stream, a); }
#else
    a.ph_lo = 0; a.ph_hi = NPHASE; hipLaunchKernelGGL(fwd, dim3(grid), dim3(NWAVES * 64), LDS_BYTES, stream, a);
#endif
}
```

```cpp
#include <hip/hip_runtime.h>
#include <cstdio>
#include <cstdint>
namespace pg8 {
#define PG8_LAS __attribute__((address_space(3)))
typedef unsigned short bf16_t;
typedef short bf16x8 __attribute__((ext_vector_type(8)));
typedef float f32x4 __attribute__((ext_vector_type(4)));
typedef unsigned u32x4 __attribute__((ext_vector_type(4)));
constexpr int BM = 256, BK = 64, HALF = 128, HTB = HALF * BK * 2  , STAGE_BYTES = 8 * HTB, NXCD = 8, WGM = 8;

__host__ __device__ __forceinline__ int lds_byte(int r, int c) { const int st = (r >> 4) * 2 + (c >> 5), rr = r & 15, cc = c & 31, ob = rr * 64 + cc * 2; return st * 1024 + (ob ^ (((ob >> 9) & 1) << 5)); }
__host__ __device__ __forceinline__ void stage_rc(int b, int& R, int& C) { const int st = b / 1024, sb = b % 1024, swz = sb ^ (((sb >> 9) & 1) << 5); R = (st >> 1) * 16 + swz / 64; C = (st & 1) * 32 + (swz % 64) / 2; }
__host__ __device__ __forceinline__ int perm32(int rho) { const int n = rho >> 4, i = rho & 15; return 8 * (i >> 2) + 4 * n + (i & 3); }

struct Unit { int pm, pn; };
struct Gemm { const bf16_t* A; const bf16_t* Bt; int M, N, K; };

struct StaticOrder {
    int nM, nN, nwg, G, c;
    __host__ __device__ void init(int M, int N, int G_, int c_) { nM = M / BM; nN = N / BM; nwg = nM * nN; G = G_; c = c_; }
    __host__ __device__ bool next(int i, Unit& u) const {
        const long L = (long)i * G + c; if (L >= nwg) return false;
        int wgid = (int)L; { const int q = nwg / NXCD, r = nwg % NXCD, xcd = wgid % NXCD, off = wgid / NXCD; wgid = (xcd < r ? xcd * (q + 1) : r * (q + 1) + (xcd - r) * q) + off; }
        const int nig = WGM * nN, gid = wgid / nig, fm = gid * WGM, gsz = (nM - fm) < WGM ? (nM - fm) : WGM;
        u.pm = fm + ((wgid % nig) % gsz); u.pn = (wgid % nig) / gsz; return true;
    }
    __device__ __forceinline__ void a_ready(const Unit&) const {}
    __device__ __forceinline__ void done(const Unit&) const {}
};

__device__ __forceinline__ unsigned cvt_pk_bf16(float lo, float hi) { unsigned r; asm volatile("v_cvt_pk_bf16_f32 %0, %1, %2" : "=v"(r) : "v"(lo), "v"(hi)); return r; }
typedef float f32x2 __attribute__((ext_vector_type(2)));
__device__ __forceinline__ f32x2 gelu_pk(f32x2 v) {
    const f32x2 av = __builtin_elementwise_abs(v), d = av * 0.2316418882f + 1.0f;
    f32x2 t; t.x = __builtin_amdgcn_rcpf(d.x); t.y = __builtin_amdgcn_rcpf(d.y);
    f32x2 q = t * 0.5307027145f + (-0.7265760135f); q = q * t + 0.7107068705f; q = q * t + (-0.142248368f); q = q * t + 0.127414796f; q = q * t;
    const f32x2 s = (v * v) * (-0.72134752044f);
    f32x2 e; e.x = __builtin_amdgcn_exp2f(s.x); e.y = __builtin_amdgcn_exp2f(s.y);
    const f32x2 m = v * (q * e), r = v - m;
    f32x2 o; o.x = v.x < 0.f ? m.x : r.x; o.y = v.y < 0.f ? m.y : r.y; return o;
}

template <int ACT  > struct EpiBf16 {
    static constexpr bool PERM = true, AFTER_DRAIN = false; static_assert(ACT == 0 || ACT == 1, "EpiBf16: ACT is 0 (none) or 1 (gelu_pk)");
    bf16_t* O; int ldc; const float* bias; int split_cols; size_t split_stride; float scale0;
    __device__ __forceinline__ void operator()(const f32x4 (&acc)[2][2][4][2], const Unit& u, int wr, int wc, int fr, int fq) const {
        const int row0 = u.pm * BM + wr * 64 + fr; int colt = u.pn * BM; bf16_t* base = O;
        float sc = 1.f; if (split_cols) { const int t = colt / split_cols; base += (size_t)t * split_stride; colt -= t * split_cols; if (t == 0) sc = scale0; }
        const int col0 = colt + wc * 32 + 8 * fq, bcol0 = u.pn * BM + wc * 32 + 8 * fq;
        f32x4 bv[2][2];
#pragma unroll
        for (int bj = 0; bj < 2; ++bj)
#pragma unroll
            for (int n = 0; n < 2; ++n) bv[bj][n] = bias ? *(const f32x4*)(bias + bcol0 + bj * HALF + 4 * n) : (f32x4){0.f, 0.f, 0.f, 0.f};
#pragma unroll
        for (int ai = 0; ai < 2; ++ai)
#pragma unroll
            for (int m = 0; m < 4; ++m) { bf16_t* rowp = base + (size_t)(row0 + ai * HALF + m * 16) * ldc + col0;
#pragma unroll
                for (int bj = 0; bj < 2; ++bj) { f32x4 v0 = acc[ai][bj][m][0] + bv[bj][0], v1 = acc[ai][bj][m][1] + bv[bj][1];
                    if (ACT == 1) { f32x2 a = gelu_pk((f32x2){v0[0], v0[1]}), b = gelu_pk((f32x2){v0[2], v0[3]}), c = gelu_pk((f32x2){v1[0], v1[1]}), d = gelu_pk((f32x2){v1[2], v1[3]});
                        v0 = (f32x4){a.x, a.y, b.x, b.y}; v1 = (f32x4){c.x, c.y, d.x, d.y}; }
                    v0 = v0 * sc; v1 = v1 * sc; u32x4 w; w.x = cvt_pk_bf16(v0[0], v0[1]); w.y = cvt_pk_bf16(v0[2], v0[3]); w.z = cvt_pk_bf16(v1[0], v1[1]); w.w = cvt_pk_bf16(v1[2], v1[3]);
                    *(u32x4*)(rowp + bj * HALF) = w; } }
    }
};

struct PanelStats {
    unsigned* xbuf;
    unsigned* cnt;
    unsigned* tmo;
    int ntn; float eps;
    unsigned code;
    __device__ __forceinline__ bool run(const f32x4 (&v)[2][2][4][2], const Unit& u, int wr, int wc, int fr, int fq, PG8_LAS unsigned char* lds, int wid, int lane) const {
        typedef float f32x2v __attribute__((ext_vector_type(2)));
        PG8_LAS f32x2v* P = (PG8_LAS f32x2v*)lds;
        PG8_LAS f32x2v* S = (PG8_LAS f32x2v*)(lds + 8192);
        PG8_LAS unsigned* flag = (PG8_LAS unsigned*)(lds + 8192 + 2048);
#pragma unroll
        for (int ai = 0; ai < 2; ++ai)
#pragma unroll
            for (int m = 0; m < 4; ++m) {
                float s = 0.f;
#pragma unroll
                for (int bj = 0; bj < 2; ++bj)
#pragma unroll
                    for (int n = 0; n < 2; ++n) { const f32x4 x = v[ai][bj][m][n]; s += (x[0] + x[1]) + (x[2] + x[3]); }
                s += __shfl_xor(s, 16); s += __shfl_xor(s, 32);
                const float mw = s * (1.0f / 64.0f); float q = 0.f;
#pragma unroll
                for (int bj = 0; bj < 2; ++bj)
#pragma unroll
                    for (int n = 0; n < 2; ++n) { const f32x4 d = v[ai][bj][m][n] - mw; q += (d[0] * d[0] + d[1] * d[1]) + (d[2] * d[2] + d[3] * d[3]); }
                q += __shfl_xor(q, 16); q += __shfl_xor(q, 32);
                if (fq == 0) P[(ai * HALF + wr * 64 + m * 16 + fr) * 4 + wc] = (f32x2v){mw, q};
            }
        asm volatile("s_waitcnt lgkmcnt(0)" ::: "memory"); __builtin_amdgcn_s_barrier(); asm volatile("" ::: "memory");
#if defined(BROKEN_EXCHANGE_NO_WAIT)
#warning BROKEN CONTROL BUILD: the row-statistics exchange does not wait; results are wrong by design
        if (blockIdx.x >= 64) { const long long t0_ = clock64(); while (clock64() - t0_ < 60000) __builtin_amdgcn_s_sleep(8); }
#endif
        const int row = wid * 32 + (lane & 31);
        if (lane < 32) {
            const f32x2v a = P[row * 4 + 0], b = P[row * 4 + 1], c = P[row * 4 + 2], d = P[row * 4 + 3];
            const float mt = (a.x + b.x + c.x + d.x) * 0.25f;
            const float da = a.x - mt, db = b.x - mt, dc = c.x - mt, dd = d.x - mt;
            const float m2 = (a.y + b.y) + (c.y + d.y) + 64.0f * ((da * da + db * db) + (dc * dc + dd * dd));
            unsigned long long* slot = (unsigned long long*)xbuf + ((size_t)(u.pm * BM + row) * 4 + u.pn);
            __hip_atomic_store(slot, ((unsigned long long)__float_as_uint(m2) << 32) | __float_as_uint(mt), __ATOMIC_RELAXED, __HIP_MEMORY_SCOPE_AGENT);
        }
        asm volatile("s_waitcnt vmcnt(0)" ::: "memory");
        if (lane == 0) __hip_atomic_fetch_add(cnt + 64 * u.pm, 1u, __ATOMIC_RELAXED, __HIP_MEMORY_SCOPE_AGENT);
        if (wid == 0) {
            bool dead = false; const unsigned long long t0 = __builtin_amdgcn_s_memrealtime(); const unsigned want = 8u * (unsigned)ntn;
            for (;;) {
#if defined(BROKEN_EXCHANGE_NO_WAIT)
                break;
#endif
                if ((unsigned)__builtin_amdgcn_readfirstlane(__hip_atomic_load(cnt + 64 * u.pm, __ATOMIC_RELAXED, __HIP_MEMORY_SCOPE_AGENT)) >= want) break;
                if (__builtin_amdgcn_s_memrealtime() - t0 > 2000000ull) {
                    if (lane == 0) { unsigned expect = 0u; __hip_atomic_compare_exchange_strong(tmo + 1, &expect, code | (unsigned)(u.pm & 0xff), __ATOMIC_RELAXED, __ATOMIC_RELAXED, __HIP_MEMORY_SCOPE_AGENT);
                                     __hip_atomic_store(tmo, 1u, __ATOMIC_RELAXED, __HIP_MEMORY_SCOPE_AGENT); }
                    dead = true; break; }
                __builtin_amdgcn_s_sleep(2);
            }
            __builtin_amdgcn_fence(__ATOMIC_ACQUIRE, "agent");
            if (lane == 0) flag[0] = dead ? 1u : 0u;
        }
        asm volatile("s_waitcnt vmcnt(0) lgkmcnt(0)" ::: "memory"); __builtin_amdgcn_s_barrier(); asm volatile("" ::: "memory");
        const bool bad = flag[0] != 0u;
        if (lane < 32) {
            const unsigned long long* slot = (const unsigned long long*)xbuf + (size_t)(u.pm * BM + row) * 4; float mt[4], m2[4]; float ms = 0.f;
#pragma unroll
            for (int t = 0; t < 4; ++t) { if (t < ntn) { const unsigned long long w = __hip_atomic_load(slot + t, __ATOMIC_RELAXED, __HIP_MEMORY_SCOPE_AGENT); mt[t] = __uint_as_float((unsigned)w); m2[t] = __uint_as_float((unsigned)(w >> 32)); } else { mt[t] = 0.f; m2[t] = 0.f; } ms += mt[t]; }
            const float mean = ms / (float)ntn; float q = 0.f;
#pragma unroll
            for (int t = 0; t < 4; ++t) if (t < ntn) { const float dm = mt[t] - mean; q += m2[t] + 256.0f * dm * dm; }
            S[row] = (f32x2v){mean, 1.0f / sqrtf(q / (256.0f * (float)ntn) + eps)};
        }
        asm volatile("s_waitcnt lgkmcnt(0)" ::: "memory"); __builtin_amdgcn_s_barrier(); asm volatile("" ::: "memory");
        return bad;
    }
};
struct EpiLnRes {
    static constexpr bool PERM = false, AFTER_DRAIN = true;
    const float* base; float* out; int ldc; const float* bias; PanelStats st; unsigned poison;
    __device__ __forceinline__ void fused(f32x4 (&acc)[2][2][4][2], const Unit& u, int wr, int wc, int fr, int fq, PG8_LAS unsigned char* lds, int wid, int lane) const {
        typedef float f32x2v __attribute__((ext_vector_type(2)));
        const PG8_LAS f32x2v* S = (const PG8_LAS f32x2v*)(lds + 8192);
        const int col0 = u.pn * BM + wc * 32 + 4 * fq;
#pragma unroll
        for (int bj = 0; bj < 2; ++bj)
#pragma unroll
            for (int n = 0; n < 2; ++n) { const f32x4 bv = bias ? *(const f32x4*)(bias + col0 + bj * HALF + n * 16) : (f32x4){0.f, 0.f, 0.f, 0.f};
#pragma unroll
                for (int ai = 0; ai < 2; ++ai)
#pragma unroll
                    for (int m = 0; m < 4; ++m) acc[ai][bj][m][n] += bv; }
        f32x4 pre[4][2][2];
#pragma unroll
        for (int m = 0; m < 4; ++m) { const size_t off = (size_t)(u.pm * BM + wr * 64 + m * 16 + fr) * ldc + col0;
#pragma unroll
            for (int bj = 0; bj < 2; ++bj)
#pragma unroll
                for (int n = 0; n < 2; ++n) pre[m][bj][n] = *(const f32x4*)(base + off + bj * HALF + n * 16); }
        const bool bad = st.run(acc, u, wr, wc, fr, fq, lds, wid, lane) || poison != 0u;
        const float qnan = __builtin_nanf("");
#pragma unroll
        for (int ai = 0; ai < 2; ++ai)
#pragma unroll
            for (int m = 0; m < 4; ++m) { const int r = ai * HALF + wr * 64 + m * 16 + fr; const f32x2v sr = S[r]; const size_t off = (size_t)(u.pm * BM + r) * ldc + col0;
#pragma unroll
                for (int bj = 0; bj < 2; ++bj)
#pragma unroll
                    for (int n = 0; n < 2; ++n) { const f32x4 bs = ai == 0 ? pre[m][bj][n] : *(const f32x4*)(base + off + bj * HALF + n * 16); f32x4 o = bs + (acc[ai][bj][m][n] - sr.x) * sr.y;
                        if (bad) o = (f32x4){qnan, qnan, qnan, qnan}; *(f32x4*)(out + off + bj * HALF + n * 16) = o; }
                if (m & 1) asm volatile("" ::: "memory"); }
    }
};
struct EpiLnResLn {
    static constexpr bool PERM = false, AFTER_DRAIN = true;
    const float* base; float* out; bf16_t* xn; int ldc; const float* bias; PanelStats st1, st2; unsigned poison;
    __device__ __forceinline__ void fused(f32x4 (&acc)[2][2][4][2], const Unit& u, int wr, int wc, int fr, int fq, PG8_LAS unsigned char* lds, int wid, int lane) const {
        typedef float f32x2v __attribute__((ext_vector_type(2))); typedef unsigned u32x2v __attribute__((ext_vector_type(2)));
        const PG8_LAS f32x2v* S = (const PG8_LAS f32x2v*)(lds + 8192);
        const int col0 = u.pn * BM + wc * 32 + 4 * fq;
#pragma unroll
        for (int bj = 0; bj < 2; ++bj)
#pragma unroll
            for (int n = 0; n < 2; ++n) { const f32x4 bv = bias ? *(const f32x4*)(bias + col0 + bj * HALF + n * 16) : (f32x4){0.f, 0.f, 0.f, 0.f};
#pragma unroll
                for (int ai = 0; ai < 2; ++ai)
#pragma unroll
                    for (int m = 0; m < 4; ++m) acc[ai][bj][m][n] += bv; }
        bool bad = st1.run(acc, u, wr, wc, fr, fq, lds, wid, lane) || poison != 0u;
        const float qnan = __builtin_nanf("");
#pragma unroll
        for (int ai = 0; ai < 2; ++ai)
#pragma unroll
            for (int m = 0; m < 4; ++m) { const int r = ai * HALF + wr * 64 + m * 16 + fr; const f32x2v sr = S[r]; const size_t off = (size_t)(u.pm * BM + r) * ldc + col0;
#pragma unroll
                for (int bj = 0; bj < 2; ++bj)
#pragma unroll
                    for (int n = 0; n < 2; ++n) { const f32x4 bs = *(const f32x4*)(base + off + bj * HALF + n * 16); acc[ai][bj][m][n] = bs + (acc[ai][bj][m][n] - sr.x) * sr.y; }
                asm volatile("" : "+v"(acc[ai][0][m][0]), "+v"(acc[ai][0][m][1]), "+v"(acc[ai][1][m][0]), "+v"(acc[ai][1][m][1]));
                if (m & 1) asm volatile("" ::: "memory"); }
        const bool bad1 = bad;
        bad = st2.run(acc, u, wr, wc, fr, fq, lds, wid, lane) || bad;
#pragma unroll
        for (int ai = 0; ai < 2; ++ai)
#pragma unroll
            for (int m = 0; m < 4; ++m) { const int r = ai * HALF + wr * 64 + m * 16 + fr; const f32x2v sr = S[r]; const size_t off = (size_t)(u.pm * BM + r) * ldc + col0;
#pragma unroll
                for (int bj = 0; bj < 2; ++bj)
#pragma unroll
                    for (int n = 0; n < 2; ++n) { const f32x4 x1 = acc[ai][bj][m][n]; *(f32x4*)(out + off + bj * HALF + n * 16) = bad1 ? (f32x4){qnan, qnan, qnan, qnan} : x1;
                        const f32x4 o = (x1 - sr.x) * sr.y; u32x2v w; w.x = cvt_pk_bf16(o[0], o[1]); w.y = cvt_pk_bf16(o[2], o[3]);
                        if (bad) { w.x = 0x7fc07fc0u; w.y = 0x7fc07fc0u; } *(u32x2v*)(xn + off + bj * HALF + n * 16) = w; }
                asm volatile("" ::: "memory"); }
    }
};

template <class Epi, class Sched, bool ALIGN_EPI = false, bool SP2 = false, bool MID = false  >
__device__ __forceinline__ void gemm_phase(PG8_LAS unsigned char* lds, const Gemm g, const Sched& S, const Epi& E) {
    int tid_ = threadIdx.x; asm volatile("" : "+v"(tid_));
    const int tid = tid_, wid = __builtin_amdgcn_readfirstlane(tid >> 6), lane = tid & 63, wr = wid >> 2, wc = wid & 3, fr = lane & 15, fq = lane >> 4;
    const int K = g.K, nt = K / BK;
    unsigned voffA[2], voffB[2];
#pragma unroll
    for (int i = 0; i < 2; ++i) { int R, C; stage_rc(tid * 16 + i * 8192, R, C); const int Rb = Epi::PERM ? ((R & ~31) + perm32(R & 31)) : R;
        voffA[i] = (unsigned)(R * K + C) * 2u; voffB[i] = (unsigned)(Rb * K + C) * 2u; }
    const size_t kstep = (size_t)(BK * 2);
    const size_t hstep = (size_t)HALF * K * 2;
    const size_t tstep = 2 * hstep;
    const unsigned ldsw = (unsigned)wid * 1024u;
    const int aoff = lds_byte(wr * 64 + fr, fq * 8), boff = lds_byte(wc * 32 + fr, fq * 8);
#define PG8_SA(b, h) (((b) * 2 + (h)) * HTB)
#define PG8_SB(b, h) ((4 + (b) * 2 + (h)) * HTB)
#define PG8_STAGE(bufoff, gbase, voff) do { _Pragma("unroll") for (int _i = 0; _i < 2; ++_i) \
        __builtin_amdgcn_global_load_lds((const unsigned*)((const char*)(gbase) + (voff)[_i]), (PG8_LAS unsigned*)(lds + (bufoff) + ldsw + _i * 8192), 16, 0, 0); } while (0)
#define PG8_LDA(dst, b, h) do { _Pragma("unroll") for (int m = 0; m < 4; ++m) _Pragma("unroll") for (int k = 0; k < 2; ++k) dst[m][k] = *(const PG8_LAS bf16x8*)(lds + PG8_SA(b, h) + aoff + m * 2048 + k * 1024); } while (0)
#define PG8_LDB(dst, b, h) do { _Pragma("unroll") for (int n = 0; n < 2; ++n) _Pragma("unroll") for (int k = 0; k < 2; ++k) dst[n][k] = *(const PG8_LAS bf16x8*)(lds + PG8_SB(b, h) + boff + n * 2048 + k * 1024); } while (0)
#define PG8_MMA(ai, bj, At, Bt) do { __builtin_amdgcn_s_setprio(1); _Pragma("unroll") for (int m = 0; m < 4; ++m) _Pragma("unroll") for (int n = 0; n < 2; ++n) _Pragma("unroll") for (int k = 0; k < 2; ++k) \
        acc[ai][bj][m][n] = __builtin_amdgcn_mfma_f32_16x16x32_bf16(Bt[n][k], At[m][k], acc[ai][bj][m][n], 0, 0, 0); __builtin_amdgcn_s_setprio(0); } while (0)
#define PG8_WAIT_V(n) asm volatile("s_waitcnt vmcnt(" #n ")" ::: "memory")
#define PG8_WAIT_L(n) asm volatile("s_waitcnt lgkmcnt(" #n ")" ::: "memory")
#define PG8_BAR __builtin_amdgcn_s_barrier()
#define PG8_SCHED __builtin_amdgcn_sched_barrier(0)
    Unit cur, nxt; int ui = 0;
    if (!S.next(0, cur)) return;
    f32x4 acc[2][2][4][2];
#pragma unroll
    for (int a = 0; a < 2; ++a)
#pragma unroll
        for (int b = 0; b < 2; ++b)
#pragma unroll
            for (int m = 0; m < 4; ++m)
#pragma unroll
                for (int n = 0; n < 2; ++n) acc[a][b][m][n] = (f32x4){0.f, 0.f, 0.f, 0.f};
    bf16x8 At[4][2], B0[2][2], B1[2][2];
    const char* cA = (const char*)g.A + (size_t)cur.pm * tstep; const char* cB = (const char*)g.Bt + (size_t)cur.pn * tstep;
    S.a_ready(cur);
    if constexpr (SP2) {
        PG8_STAGE(PG8_SB(0, 0), cB, voffB); PG8_STAGE(PG8_SB(0, 1), cB + hstep, voffB); PG8_STAGE(PG8_SA(0, 0), cA, voffA); PG8_STAGE(PG8_SA(0, 1), cA + hstep, voffA);
        if (wr == 1) PG8_BAR;
        PG8_WAIT_V(2); PG8_BAR;
        PG8_STAGE(PG8_SB(1, 0), cB + kstep, voffB); PG8_STAGE(PG8_SA(1, 0), cA + kstep, voffA); PG8_STAGE(PG8_SB(1, 1), cB + hstep + kstep, voffB);
        PG8_WAIT_V(6); PG8_BAR;
    } else {
        PG8_STAGE(PG8_SB(0, 0), cB, voffB); PG8_STAGE(PG8_SA(0, 0), cA, voffA); PG8_STAGE(PG8_SB(0, 1), cB + hstep, voffB); PG8_STAGE(PG8_SA(0, 1), cA + hstep, voffA);
        if (wr == 1) PG8_BAR;
        PG8_WAIT_V(4); PG8_BAR;
        PG8_STAGE(PG8_SB(1, 0), cB + kstep, voffB); PG8_STAGE(PG8_SA(1, 0), cA + kstep, voffA); PG8_STAGE(PG8_SB(1, 1), cB + hstep + kstep, voffB);
        PG8_WAIT_V(6); PG8_BAR;
    }
    for (;;) {
        const bool has_next = S.next(ui + 1, nxt);
        const char* nA = has_next ? (const char*)g.A + (size_t)nxt.pm * tstep : cA; const char* nB = has_next ? (const char*)g.Bt + (size_t)nxt.pn * tstep : cB;
        for (int t = 0; t < nt; t += 2) {
            if constexpr (MID) { if (t == (nt >> 1)) E.mid(acc, cur, wr, wc, fr, fq); }
            const bool last = (t == nt - 2);
            const char* a1 = cA + (size_t)(t + 1) * kstep;
            const char* a2 = last ? nA : cA + (size_t)(t + 2) * kstep; const char* b2 = last ? nB : cB + (size_t)(t + 2) * kstep;
            const char* a3 = a2 + kstep; const char* b3 = b2 + kstep;
            if (last && has_next) S.a_ready(nxt);
            if constexpr (SP2) {
            PG8_LDB(B0, 0, 0); PG8_LDB(B1, 0, 1); PG8_SCHED; PG8_LDA(At, 0, 0); PG8_STAGE(PG8_SA(1, 1), a1 + hstep, voffA);
            PG8_WAIT_V(8); PG8_WAIT_L(0); PG8_BAR; PG8_MMA(0, 0, At, B0); PG8_MMA(0, 1, At, B1); PG8_BAR; PG8_SCHED;
            PG8_LDA(At, 0, 1); PG8_STAGE(PG8_SB(0, 0), b2, voffB); PG8_STAGE(PG8_SB(0, 1), b2 + hstep, voffB); PG8_STAGE(PG8_SA(0, 0), a2, voffA);
            PG8_WAIT_V(8); PG8_WAIT_L(0); PG8_BAR; PG8_MMA(1, 0, At, B0); PG8_MMA(1, 1, At, B1); PG8_BAR; PG8_SCHED;
            PG8_LDB(B0, 1, 0); PG8_LDB(B1, 1, 1); PG8_SCHED; PG8_LDA(At, 1, 0); PG8_STAGE(PG8_SA(0, 1), a2 + hstep, voffA);
            PG8_WAIT_V(8); PG8_WAIT_L(0); PG8_BAR; PG8_MMA(0, 0, At, B0); PG8_MMA(0, 1, At, B1); PG8_BAR; PG8_SCHED;
            PG8_LDA(At, 1, 1); PG8_STAGE(PG8_SB(1, 0), b3, voffB); PG8_STAGE(PG8_SB(1, 1), b3 + hstep, voffB); PG8_STAGE(PG8_SA(1, 0), a3, voffA);
            PG8_WAIT_V(8); PG8_WAIT_L(0); PG8_BAR; PG8_MMA(1, 0, At, B0); PG8_MMA(1, 1, At, B1); PG8_BAR; PG8_SCHED;
            } else {
            PG8_LDB(B0, 0, 0); PG8_SCHED; PG8_LDA(At, 0, 0); PG8_STAGE(PG8_SA(1, 1), a1 + hstep, voffA);
            PG8_WAIT_L(8); PG8_BAR; PG8_WAIT_L(0); PG8_MMA(0, 0, At, B0); PG8_BAR; PG8_SCHED;
            PG8_LDB(B1, 0, 1); PG8_STAGE(PG8_SB(0, 0), b2, voffB);
            PG8_BAR; PG8_WAIT_L(0); PG8_MMA(0, 1, At, B1); PG8_BAR;
            PG8_LDA(At, 0, 1); PG8_STAGE(PG8_SA(0, 0), a2, voffA);
            PG8_BAR; PG8_WAIT_L(0); PG8_MMA(1, 0, At, B0); PG8_BAR; PG8_SCHED;
            PG8_STAGE(PG8_SB(0, 1), b2 + hstep, voffB);
            PG8_WAIT_V(6); PG8_BAR; PG8_MMA(1, 1, At, B1); PG8_BAR;
            PG8_LDB(B0, 1, 0); PG8_SCHED; PG8_LDA(At, 1, 0); PG8_STAGE(PG8_SA(0, 1), a2 + hstep, voffA);
            PG8_WAIT_L(8); PG8_BAR; PG8_WAIT_L(0); PG8_MMA(0, 0, At, B0); PG8_BAR; PG8_SCHED;
            PG8_LDB(B1, 1, 1); PG8_STAGE(PG8_SB(1, 0), b3, voffB);
            PG8_BAR; PG8_WAIT_L(0); PG8_MMA(0, 1, At, B1); PG8_BAR;
            PG8_LDA(At, 1, 1); PG8_STAGE(PG8_SA(1, 0), a3, voffA);
            PG8_BAR; PG8_WAIT_L(0); PG8_MMA(1, 0, At, B0); PG8_BAR; PG8_SCHED;
            PG8_STAGE(PG8_SB(1, 1), b3 + hstep, voffB);
            PG8_WAIT_V(6); PG8_BAR; PG8_MMA(1, 1, At, B1); PG8_BAR;
            }
        }
        if constexpr (ALIGN_EPI) { if (wr == 0) PG8_BAR; }
        if constexpr (!Epi::AFTER_DRAIN) { E(acc, cur, wr, wc, fr, fq); S.done(cur); }
        if (!has_next) break;
#pragma unroll
        for (int a = 0; a < 2; ++a)
#pragma unroll
            for (int b = 0; b < 2; ++b)
#pragma unroll
                for (int m = 0; m < 4; ++m)
#pragma unroll
                    for (int n = 0; n < 2; ++n) acc[a][b][m][n] = (f32x4){0.f, 0.f, 0.f, 0.f};
        cur = nxt; cA = nA; cB = nB; ++ui;
        if constexpr (ALIGN_EPI) { if (wr == 1) PG8_BAR; }
    }
    PG8_WAIT_V(0);
    if constexpr (!ALIGN_EPI) { if (wr == 0) PG8_BAR; }
    PG8_BAR;
    if constexpr (Epi::AFTER_DRAIN) { E.fused(acc, cur, wr, wc, fr, fq, lds, wid, lane); S.done(cur); }
#undef PG8_SA
#undef PG8_SB
#undef PG8_STAGE
#undef PG8_LDA
#undef PG8_LDB
#undef PG8_MMA
#undef PG8_WAIT_V
#undef PG8_WAIT_L
#undef PG8_BAR
#undef PG8_SCHED
}
}
#include <hip/hip_bf16.h>
#include <cmath>
namespace attn2 {
using bf16=__hip_bfloat16;
using bf16x8=__attribute__((ext_vector_type(8)))short;
using s16x4=__attribute__((ext_vector_type(4)))short;
using f32x16=__attribute__((ext_vector_type(16)))float;
using f32x4=__attribute__((ext_vector_type(4)))float;
using u32x4=__attribute__((ext_vector_type(4)))unsigned;
using u32x2=__attribute__((ext_vector_type(2)))unsigned;
constexpr int BATCH=4,NHEAD=8,SEQ=8192,D=64,DM=NHEAD*D;
constexpr int OPITCH=1024; constexpr int NW=8,QBLK=32,QB=QBLK*NW,KVBLK=64,NQB=SEQ/QB;
__device__ __forceinline__ int crow(int r,int hi){return (r&3)+8*(r>>2)+4*hi;}
#define SBAR() __builtin_amdgcn_sched_barrier(0)
constexpr int NSLOT=3, SLOTB=8192;
constexpr int TBN=1344, TBSTRIDE=1360, TBOFF=1087;
constexpr int LDS_K=0, LDS_V=NSLOT*SLOTB, LDS_WS=2*NSLOT*SLOTB, LDS_OST=LDS_WS+NW*64*4, LDS_MASK=LDS_OST+NW*4096, LDS_TB=LDS_MASK+NSLOT*2048, LDS_BYTES=LDS_TB+4*TBSTRIDE*4;
__device__ __forceinline__ void glds16(const void*gsrc,unsigned lds_dst){unsigned keep;
  asm volatile("s_mov_b32 %0, m0\n\ts_mov_b32 m0, %2\n\ts_nop 0\n\tglobal_load_lds_dwordx4 %1, off\n\ts_mov_b32 m0, %0":"=&s"(keep):"v"(gsrc),"s"(lds_dst):"memory");}
__device__ __forceinline__ void glds4(const void*gsrc,unsigned lds_dst){unsigned keep;
  asm volatile("s_mov_b32 %0, m0\n\ts_mov_b32 m0, %2\n\ts_nop 0\n\tglobal_load_lds_dword %1, off\n\ts_mov_b32 m0, %0":"=&s"(keep):"v"(gsrc),"s"(lds_dst):"memory");}
typedef float f32x2_t __attribute__((ext_vector_type(2))); typedef __bf16 bf16x2_t __attribute__((ext_vector_type(2)));
__device__ __forceinline__ unsigned cvtpk_s(float lo,float hi){f32x2_t v={lo,hi};bf16x2_t b=__builtin_convertvector(v,bf16x2_t);return __builtin_bit_cast(unsigned,b);}
#define WAIT_BAR(N) asm volatile("s_waitcnt vmcnt(" #N ") lgkmcnt(0)\n\ts_barrier":::"memory")
typedef __attribute__((address_space(3))) const char* lds_cptr;
typedef short v4i16_t __attribute__((ext_vector_type(4)));
__device__ __forceinline__ void kload8(bf16x8*kf,lds_cptr kp){
  kf[0]=*(const __attribute__((address_space(3))) bf16x8*)(kp);      kf[1]=*(const __attribute__((address_space(3))) bf16x8*)(kp+512);
  kf[2]=*(const __attribute__((address_space(3))) bf16x8*)(kp+2048); kf[3]=*(const __attribute__((address_space(3))) bf16x8*)(kp+2560);
  kf[4]=*(const __attribute__((address_space(3))) bf16x8*)(kp+4096); kf[5]=*(const __attribute__((address_space(3))) bf16x8*)(kp+4608);
  kf[6]=*(const __attribute__((address_space(3))) bf16x8*)(kp+6144); kf[7]=*(const __attribute__((address_space(3))) bf16x8*)(kp+6656);
}
__device__ __forceinline__ void kload2(bf16x8*kf,lds_cptr kp,int j){ kf[2*j]=*(const __attribute__((address_space(3))) bf16x8*)(kp+j*2048); kf[2*j+1]=*(const __attribute__((address_space(3))) bf16x8*)(kp+j*2048+512); }
__device__ __forceinline__ s16x4 vtr(lds_cptr p){ return __builtin_bit_cast(s16x4,__builtin_amdgcn_ds_read_tr16_b64_v4i16((__attribute__((address_space(3))) v4i16_t*)p)); }
__device__ __forceinline__ float exm(float x,unsigned w,int pos){ return __uint_as_float(__float_as_uint(__builtin_amdgcn_exp2f(x))&(unsigned)__builtin_amdgcn_sbfe((int)w,pos,1)); }
__device__ __forceinline__ void cinit_near(f32x16&c0,f32x16&c1,lds_cptr tb){
  #pragma unroll
  for(int g=0;g<4;++g){ const f32x4 a=*(const __attribute__((address_space(3))) f32x4*)(tb+32*g), b=*(const __attribute__((address_space(3))) f32x4*)(tb+128+32*g);
    c0[4*g]=a[0];c0[4*g+1]=a[1];c0[4*g+2]=a[2];c0[4*g+3]=a[3]; c1[4*g]=b[0];c1[4*g+1]=b[1];c1[4*g+2]=b[2];c1[4*g+3]=b[3]; }
}
__device__ __forceinline__ void pv(f32x16*o,int vb,bf16x8 pa0,bf16x8 pa1,bf16x8 pa2,bf16x8 pa3){
  #pragma unroll
  for(int d0=0;d0<2;++d0){s16x4 lo[4],hi[4];
    #pragma unroll
    for(int ks=0;ks<4;++ks){
      asm volatile("ds_read_b64_tr_b16 %0,%1 offset:%c2":"=&v"(lo[ks]):"v"(vb),"i"(d0*4096+ks*1024):"memory");
      asm volatile("ds_read_b64_tr_b16 %0,%1 offset:%c2":"=&v"(hi[ks]):"v"(vb),"i"(d0*4096+ks*1024+512):"memory");}
    asm volatile("s_waitcnt lgkmcnt(0)":::"memory");SBAR();
    #define PK(k) (bf16x8){lo[k][0],lo[k][1],lo[k][2],lo[k][3],hi[k][0],hi[k][1],hi[k][2],hi[k][3]}
    o[d0]=__builtin_amdgcn_mfma_f32_32x32x16_bf16(pa0,PK(0),o[d0],0,0,0);
    o[d0]=__builtin_amdgcn_mfma_f32_32x32x16_bf16(pa1,PK(1),o[d0],0,0,0);
    o[d0]=__builtin_amdgcn_mfma_f32_32x32x16_bf16(pa2,PK(2),o[d0],0,0,0);
    o[d0]=__builtin_amdgcn_mfma_f32_32x32x16_bf16(pa3,PK(3),o[d0],0,0,0);
    #undef PK
  }
}
#ifndef ATTN_STORE16
#define ATTN_STORE16(p,v) (*(u32x4*)(p)=(v))
#endif
__device__ __forceinline__ void attn_unit(int b,int h,int qb,const bf16*Q,const bf16*__restrict__ K,const bf16*__restrict__ V,bf16*O,const unsigned*__restrict__ bm,const float*__restrict__ tabh,float mb,char*shm){
  const int tid=threadIdx.x,lane=tid&63,r32=lane&31,hi=lane>>5; const int wid=__builtin_amdgcn_readfirstlane(tid>>6);
  const long rowbase=(long)b*SEQ; const int q0=qb*QB;
  const bf16*Qw=Q+(rowbase+q0+wid*QBLK)*DM+h*D;
  const bf16*Kh=K+rowbase*DM+h*D,*Vh=V+rowbase*DM+h*D;
  const unsigned lds0=(unsigned)(uintptr_t)shm;
  float*wsf=(float*)(shm+LDS_WS)+wid*64;
  { float*tb=(float*)(shm+LDS_TB);
    for(int i=tid;i<4*TBSTRIDE;i+=NW*64){ const int k=i/TBSTRIDE,j=i-k*TBSTRIDE; tb[i]=((j+k<TBN)?tabh[j+k]:0.f)-mb; } }
  const bf16*ksrc=Kh+(long)lane*DM+wid*8;
  const bf16*vsrc=Vh+(long)(16*(wid&3)+(lane>>2))*DM+(wid>>2)*32+(lane&3)*8;
  const unsigned*msrc=bm+(rowbase+q0+wid*QBLK+(lane>>1))*256+(lane&1);
  const unsigned kdst=lds0+LDS_K+wid*1024, vdst=lds0+LDS_V+wid*1024, mdst=lds0+LDS_MASK+wid*256;
  #define DMA_K(t,slot) glds16(ksrc+(long)(t)*KVBLK*DM,(unsigned)__builtin_amdgcn_readfirstlane(kdst+(slot)))
  #define DMA_V(t,slot) glds16(vsrc+(long)(t)*KVBLK*DM,(unsigned)__builtin_amdgcn_readfirstlane(vdst+(slot)))
  #define DMA_M(t,slot) glds4(msrc+2*(t),(unsigned)__builtin_amdgcn_readfirstlane(mdst+((slot)>>2)))
  const int vb0=(int)(lds0+LDS_V)+((lane>>4)&1)*32+(lane&3)*8+(4*hi+((lane&15)>>2))*64;
  bf16x8 kf[8];
  const lds_cptr shm3=(lds_cptr)shm; const lds_cptr kp0=shm3+LDS_K+hi*1024+r32*16; const lds_cptr vp0=shm3+LDS_V+((lane>>4)&1)*32+(lane&3)*8+(4*hi+((lane&15)>>2))*64;
  const lds_cptr mp0=shm3+LDS_MASK+wid*256+r32*8;
  const int NT=(q0+QB)/KVBLK;
  const int qw=q0+wid*QBLK; int tn=(qw-622>=0)?((qw-622)/64+1):0; tn&=~1;
  const int qpos=qw+r32, idx0=4*hi+TBOFF-qpos, kcp=idx0&3;
  const lds_cptr tb0=shm3+LDS_TB+(kcp*TBSTRIDE+(idx0-kcp))*4;
  DMA_K(0,0);DMA_M(0,0);DMA_V(0,0);DMA_K(1,SLOTB);DMA_M(1,SLOTB);
  bf16x8 qr[4];
  #pragma unroll
  for(int d0=0;d0<4;++d0)qr[d0]=*reinterpret_cast<const bf16x8*>(&Qw[(long)r32*DM+d0*16+hi*8]);
  float l_reg=0.f;f32x16 o[2];o[0]=f32x16{};o[1]=f32x16{};
  f32x16 negm; { const float nf=tabh[0]-mb;
    #pragma unroll
    for(int r=0;r<16;++r)negm[r]=nf; } asm volatile("":"+v"(negm));
  f32x16 pA0,pA1,pB0,pB1;
  int sl_prev=0,sl_cur=0,sl_next=SLOTB;
  #define ROT() do{sl_prev=sl_cur;sl_cur=sl_next;sl_next=(sl_next==(NSLOT-1)*SLOTB)?0:sl_next+SLOTB;}while(0)
  DMA_K(2,2*SLOTB);
  WAIT_BAR(3);
  { const char*kb=shm+LDS_K+hi*1024+r32*16;
    if(tn>0){pA0=negm;pA1=negm;} else cinit_near(pA0,pA1,tb0);
    #pragma unroll
    for(int d0=0;d0<4;++d0){
      const bf16x8 b0=*reinterpret_cast<const bf16x8*>(kb+d0*2048);
      const bf16x8 b1=*reinterpret_cast<const bf16x8*>(kb+d0*2048+512);
      pA0=__builtin_amdgcn_mfma_f32_32x32x16_bf16(b0,qr[d0],pA0,0,0,0);pA1=__builtin_amdgcn_mfma_f32_32x32x16_bf16(b1,qr[d0],pA1,0,0,0);}
    const u32x2 mw=*(const __attribute__((address_space(3))) u32x2*)(mp0); const unsigned w0=mw.x>>(4*hi),w1=mw.y>>(4*hi);
    #pragma unroll
    for(int r=0;r<16;++r){pA0[r]=exm(pA0[r],w0,(r&3)+8*(r>>2));pA1[r]=exm(pA1[r],w1,(r&3)+8*(r>>2));} }
  WAIT_BAR(0);
  DMA_K(3,0);DMA_V(1,SLOTB);DMA_M(2,2*SLOTB);
  ROT();
  kload8(kf,kp0+sl_cur);
  WAIT_BAR(3);
  s16x4 vlo[8],vhi[8]; u32x4 pw0,pw1,pw2,pw3;
  #define PKW(P,B) cvtpk_s(P[B],P[B+1])
  #define PAF(k) __builtin_bit_cast(bf16x8,pw##k)
  #define VFR(i) (bf16x8){vlo[i][0],vlo[i][1],vlo[i][2],vlo[i][3],vhi[i][0],vhi[i][1],vhi[i][2],vhi[i][3]}
  #define PIN(x) asm volatile("":"+v"(x))
  #define GAPA(MF,A0,A1,A2,A3,W0,W1,PW) do{ MF; sacc+=A0; sacc+=A1; sacc+=A2; sacc+=A3; PIN(sacc); W0; W1; PIN(PW); SBAR(); }while(0)
  #define EXB(x,T,I) __uint_as_float(__float_as_uint(__builtin_amdgcn_exp2f(x))&(unsigned)__builtin_amdgcn_sbfe((int)(T),8*(I),8))
  #define EXM4(X,A,T) do{ X[A]=EXB(X[A],T,0); X[(A)+4]=EXB(X[(A)+4],T,1); X[(A)+8]=EXB(X[(A)+8],T,2); X[(A)+12]=EXB(X[(A)+12],T,3); }while(0)
  #define GAPB(MF,X,A,TB) do{ MF; { unsigned t_=(TB)<<(3-(A)); asm("":"+v"(t_)); EXM4(X,A,t_); } PIN(X); SBAR(); }while(0)
  #define VRD(i) do{ vlo[i]=vtr(vp_+(((i)>>2)*4096+((i)&3)*1024)); vhi[i]=vtr(vp_+(((i)>>2)*4096+((i)&3)*1024+512)); }while(0)
  #define KRD(G,j) do{ if(G){ kload2(kf,kp0+sl_next,j); SBAR(); } }while(0)
  #define STEP(C0,C1,P0,P1,t,GK,GV,GM,GL,NEAR) do{ SBAR(); \
    const lds_cptr vp_=vp0+sl_prev; \
    if(NEAR){ cinit_near(C0,C1,tb0+256*(t)); SBAR(); } \
    VRD(0); SBAR(); float sacc=(P0[0]+P0[1]); \
    GAPA(C0=__builtin_amdgcn_mfma_f32_32x32x16_bf16(kf[0],qr[0],(NEAR)?C0:negm,0,0,0), P0[2],P0[3],P0[4],P0[5],     pw0[0]=PKW(P0,0), pw0[1]=PKW(P0,2), pw0); \
    VRD(4); SBAR(); GAPA(C1=__builtin_amdgcn_mfma_f32_32x32x16_bf16(kf[1],qr[0],(NEAR)?C1:negm,0,0,0), P0[6],P0[7],P0[8],P0[9],     pw0[2]=PKW(P0,4), pw0[3]=PKW(P0,6), pw0); \
    VRD(1); SBAR(); GAPA(C0=__builtin_amdgcn_mfma_f32_32x32x16_bf16(kf[2],qr[1],C0,0,0,0),   P0[10],P0[11],P0[12],P0[13], pw1[0]=PKW(P0,8), pw1[1]=PKW(P0,10), pw1); \
    VRD(5); SBAR(); GAPA(C1=__builtin_amdgcn_mfma_f32_32x32x16_bf16(kf[3],qr[1],C1,0,0,0),   P0[14],P0[15],P1[0],P1[1],   pw1[2]=PKW(P0,12),pw1[3]=PKW(P0,14), pw1); \
    VRD(2); SBAR(); GAPA(C0=__builtin_amdgcn_mfma_f32_32x32x16_bf16(kf[4],qr[2],C0,0,0,0),   P1[2],P1[3],P1[4],P1[5],     pw2[0]=PKW(P1,0), pw2[1]=PKW(P1,2), pw2); \
    VRD(6); SBAR(); GAPA(C1=__builtin_amdgcn_mfma_f32_32x32x16_bf16(kf[5],qr[2],C1,0,0,0),   P1[6],P1[7],P1[8],P1[9],     pw2[2]=PKW(P1,4), pw2[3]=PKW(P1,6), pw2); \
    VRD(3); SBAR(); GAPA(C0=__builtin_amdgcn_mfma_f32_32x32x16_bf16(kf[6],qr[3],C0,0,0,0),   P1[10],P1[11],P1[12],P1[13], pw3[0]=PKW(P1,8), pw3[1]=PKW(P1,10), pw3); \
    VRD(7); SBAR(); GAPA(C1=__builtin_amdgcn_mfma_f32_32x32x16_bf16(kf[7],qr[3],C1,0,0,0),   P1[14],P1[15],0.f,0.f,       pw3[2]=PKW(P1,12),pw3[3]=PKW(P1,14), pw3); \
    l_reg+=sacc; \
    if(GK){DMA_K((t)+3,sl_cur);} if(GV){DMA_V((t)+1,sl_next);} if(GM){DMA_M((t)+2,sl_prev);} \
    const u32x2 mw_=*(const __attribute__((address_space(3))) u32x2*)(mp0+(sl_cur>>2)); const unsigned w0_=mw_.x<<(4-4*hi),w1_=mw_.y<<(4-4*hi); \
    SBAR(); \
    GAPB(o[0]=__builtin_amdgcn_mfma_f32_32x32x16_bf16(PAF(0),VFR(0),o[0],0,0,0), C0,0,w0_); \
    GAPB(o[1]=__builtin_amdgcn_mfma_f32_32x32x16_bf16(PAF(0),VFR(4),o[1],0,0,0), C0,1,w0_); \
    KRD(GL,0); GAPB(o[0]=__builtin_amdgcn_mfma_f32_32x32x16_bf16(PAF(1),VFR(1),o[0],0,0,0), C0,2,w0_); \
    KRD(GL,1); GAPB(o[1]=__builtin_amdgcn_mfma_f32_32x32x16_bf16(PAF(1),VFR(5),o[1],0,0,0), C0,3,w0_); \
    KRD(GL,2); GAPB(o[0]=__builtin_amdgcn_mfma_f32_32x32x16_bf16(PAF(2),VFR(2),o[0],0,0,0), C1,0,w1_); \
    KRD(GL,3); GAPB(o[1]=__builtin_amdgcn_mfma_f32_32x32x16_bf16(PAF(2),VFR(6),o[1],0,0,0), C1,1,w1_); \
    GAPB(o[0]=__builtin_amdgcn_mfma_f32_32x32x16_bf16(PAF(3),VFR(3),o[0],0,0,0), C1,2,w1_); \
    GAPB(o[1]=__builtin_amdgcn_mfma_f32_32x32x16_bf16(PAF(3),VFR(7),o[1],0,0,0), C1,3,w1_); \
    }while(0)
  int t=1;
  for(;t+5<NT&&t+1<tn;t+=2){
    STEP(pB0,pB1,pA0,pA1,t,true,true,true,true,false);     WAIT_BAR(3); ROT();
    STEP(pA0,pA1,pB0,pB1,t+1,true,true,true,true,false);   WAIT_BAR(3); ROT();
  }
  for(;t+5<NT;t+=2){
    STEP(pB0,pB1,pA0,pA1,t,true,true,true,true,true);     WAIT_BAR(3); ROT();
    STEP(pA0,pA1,pB0,pB1,t+1,true,true,true,true,true);   WAIT_BAR(3); ROT();
  }
  #define ENDW(tt) do{ if((tt)+3<NT){WAIT_BAR(3);} else if((tt)+2<NT){WAIT_BAR(2);} else {WAIT_BAR(0);} }while(0)
  for(;t+1<NT;t+=2){
    STEP(pB0,pB1,pA0,pA1,t,(t+3<NT),(t+1<NT),(t+2<NT),(t+1<NT),true);       ENDW(t);   ROT();
    STEP(pA0,pA1,pB0,pB1,t+1,(t+4<NT),(t+2<NT),(t+3<NT),(t+2<NT),true);     ENDW(t+1); ROT();
  }
  STEP(pB0,pB1,pA0,pA1,NT-1,false,false,false,false,true);
  { float sacc=pB0[0]+pB0[1]; _Pragma("unroll") for(int r=2;r<16;++r)sacc+=pB0[r]; _Pragma("unroll") for(int r=0;r<16;++r)sacc+=pB1[r]; l_reg+=sacc;
    pw0=(u32x4){PKW(pB0,0),PKW(pB0,2),PKW(pB0,4),PKW(pB0,6)};pw1=(u32x4){PKW(pB0,8),PKW(pB0,10),PKW(pB0,12),PKW(pB0,14)};pw2=(u32x4){PKW(pB1,0),PKW(pB1,2),PKW(pB1,4),PKW(pB1,6)};pw3=(u32x4){PKW(pB1,8),PKW(pB1,10),PKW(pB1,12),PKW(pB1,14)};
    SBAR(); pv(o,vb0+sl_cur,PAF(0),PAF(1),PAF(2),PAF(3)); }
  #undef PKW
  #undef PAF
  #undef VFR
  #undef PIN
  #undef GAPA
  #undef GAPB
  #undef VRD
  #undef KRD
  #undef STEP
  #undef ENDW
  {auto rr=__builtin_amdgcn_permlane32_swap(__float_as_uint(l_reg),__float_as_uint(l_reg),false,false);l_reg=__uint_as_float(rr[0])+__uint_as_float(rr[1]);}
  if(hi==0)wsf[32+r32]=l_reg;asm volatile("s_waitcnt lgkmcnt(0)":::"memory");
  float rli[16];
  #pragma unroll
  for(int r=0;r<16;++r)rli[r]=__builtin_amdgcn_rcpf(wsf[32+crow(r,hi)]);
  bf16*Ow=O+(rowbase+q0+wid*QBLK)*OPITCH+h*D;
  { bf16*stg=(bf16*)(shm+LDS_OST)+wid*2048;
    #pragma unroll
    for(int r=0;r<16;++r){const int orow=crow(r,hi);
      #pragma unroll
      for(int d0=0;d0<2;++d0)stg[orow*64+d0*32+r32]=__float2bfloat16(o[d0][r]*rli[r]);}
    asm volatile("s_waitcnt lgkmcnt(0)":::"memory");
    #pragma unroll
    for(int i=0;i<4;++i){const int row=i*8+(lane>>3),ch=lane&7; const u32x4 v=*(const u32x4*)(stg+row*64+ch*8); ATTN_STORE16(Ow+(long)row*OPITCH+ch*8,v);} }
  asm volatile("s_waitcnt lgkmcnt(0)\n\ts_barrier":::"memory");
  #undef DMA_K
  #undef DMA_V
  #undef DMA_M
  #undef ROT
}
constexpr int ATTN_LDS_BYTES=LDS_BYTES;
struct AttnUnit { int bh; int qb; };
struct StaticOrder {
  int vcu,grid;
  __device__ __forceinline__ explicit StaticOrder(int g,int block):vcu((g%8==0)?(block%8)*(g/8)+block/8:block),grid(g){}
  __device__ __forceinline__ bool next(int i,AttnUnit&u)const{
    if(grid==256){ if(i>=4)return false; const int s=vcu&7; u.bh=vcu>>3; u.qb=(i==0)?s:(i==1)?15-s:(i==2)?16+s:31-s; return true; }
    const int L=i*grid+vcu; if(L>=BATCH*NHEAD*NQB)return false; u.bh=L/NQB; u.qb=L%NQB; return true; }
};
__device__ __forceinline__ void attn_phase(char*lds,const bf16*Q,const bf16*K,const bf16*V,bf16*O,const unsigned*bm,const float*tab,const float*mbp,const StaticOrder&S){
  AttnUnit u; const float mb=*mbp;
  for(int i=0;S.next(i,u);++i){ attn_unit(u.bh/NHEAD,u.bh%NHEAD,u.qb,Q,K,V,O,bm,tab+(u.bh%NHEAD)*TBN,mb,lds); }
}
#undef SBAR
#undef WAIT_BAR
}

constexpr int NWAVES = 8;
constexpr int BATCH = 4, SEQ = 8192, M = BATCH * SEQ, D = 1024;
constexpr int AW = 512, NH = 8, HD = 64, TOPK = 256;
constexpr int NIN = 5376;
constexpr int PEER_H = 8, NKEYS = 128, PTOPK = 16, PLE = 256, CONVW = 31;
constexpr float EPS = 1e-6f, LOG2E = 1.4426950408889634f;
constexpr float C2 = 0.125f * LOG2E;
constexpr float IDX_SCALE = 0.125f * 0.35355339059327373f;
constexpr int TABN = 1344, TABOFF = 1087;

constexpr size_t MiB = 1u << 20;
constexpr size_t WS_CTL = 0, CTL_ZERO_BYTES = 1 * MiB;
constexpr size_t WS_SS1 = 512 * 1024;
constexpr size_t WS_RSTD1 = 1 * MiB, WS_RSTD3 = 1 * MiB + 128 * 1024, WS_TAB = 1 * MiB + 256 * 1024;
constexpr size_t WS_WI = 2 * MiB, WS_KI = 3 * MiB;
constexpr size_t WS_WIN = 8 * MiB, WS_WA = 19 * MiB, WS_WC = 20 * MiB, WS_WOUT = 21 * MiB, WS_WQ = 23 * MiB, WS_WG = 27 * MiB, WS_WP = 29 * MiB, WS_SUBK = 29 * MiB + 512 * 1024;
constexpr size_t WS_EU = 30 * MiB, WS_EV = 62 * MiB, WS_PB = 94 * MiB;
constexpr size_t WS_RC = 110 * MiB;
constexpr size_t WS_RD = 174 * MiB;
constexpr size_t WS_RB = 238 * MiB;
constexpr size_t WS_RA = 366 * MiB;
constexpr size_t WS_END = 494 * MiB;
constexpr int CW_TMO = 0, CW_CODE = 1, CW_BAR = 4096;

constexpr int RING_OFF = 0, RING_BYTES = 131072;
constexpr int LDSCTL_OFF = RING_BYTES, MISC_OFF = LDSCTL_OFF + 320;
constexpr int LDS_BYTES = 147456;

#define GAS __attribute__((address_space(1)))
#define LAS __attribute__((address_space(3)))
typedef unsigned short bf16;
typedef unsigned v4u __attribute__((ext_vector_type(4)));
typedef unsigned v2u __attribute__((ext_vector_type(2)));
typedef float f32x4 __attribute__((ext_vector_type(4)));
typedef __bf16 bf2_t __attribute__((ext_vector_type(2)));
#define LDS_WAIT() asm volatile("s_waitcnt lgkmcnt(0)" ::: "memory")
#define VM_WAIT() asm volatile("s_waitcnt vmcnt(0)" ::: "memory")
typedef float f32x2cv __attribute__((ext_vector_type(2))); typedef __bf16 bf16x2cv __attribute__((ext_vector_type(2)));
__device__ __forceinline__ unsigned pk2(float lo, float hi) { return __builtin_bit_cast(unsigned, __builtin_convertvector((f32x2cv){lo, hi}, bf16x2cv)); }
__device__ __forceinline__ unsigned f2bf(float f) { return pk2(f, 0.f) & 0xffffu; }
__device__ __forceinline__ float bflo(unsigned w) { return __uint_as_float(w << 16); }
__device__ __forceinline__ float bfhi(unsigned w) { return __uint_as_float(w & 0xffff0000u); }
__device__ __forceinline__ float bf1(bf16 b) { return __uint_as_float((unsigned)b << 16); }
__device__ __forceinline__ float dot2(unsigned a, unsigned b, float c) { return __builtin_amdgcn_fdot2_f32_bf16(__builtin_bit_cast(bf2_t, a), __builtin_bit_cast(bf2_t, b), c, false); }
__device__ __forceinline__ float dot8(v4u a, v4u b, float c) { c = dot2(a.x, b.x, c); c = dot2(a.y, b.y, c); c = dot2(a.z, b.z, c); return dot2(a.w, b.w, c); }
__device__ __forceinline__ float sigmoidf_(float x) { return __builtin_amdgcn_rcpf(1.0f + __builtin_amdgcn_exp2f(-LOG2E * x)); }
__device__ __forceinline__ float sigmoid255(float x) { return __builtin_amdgcn_rcpf((1.0f / 255.0f) + __builtin_amdgcn_exp2f(__builtin_fmaf(x, -LOG2E, -7.99435343686f))); }
__device__ __forceinline__ float gelu_tanh(float x) { const float y = 0.7978845608028654f * (x + 0.044715f * x * x * x); return x * __builtin_amdgcn_rcpf(1.0f + __builtin_amdgcn_exp2f(-2.0f * LOG2E * y)); }
__device__ __forceinline__ unsigned sortable(float f) { const unsigned u = __float_as_uint(f); return (u & 0x80000000u) ? ~u : (u | 0x80000000u); }
__device__ __forceinline__ float wave_sum(float v);
#define DPP_F(V, CTRL) __uint_as_float((unsigned)__builtin_amdgcn_update_dpp(0, (int)__float_as_uint(V), CTRL, 0xF, 0xF, false))
__device__ __forceinline__ float lane_xor1(float v) { return DPP_F(v, 0xB1); }
__device__ __forceinline__ float lane_xor2(float v) { return DPP_F(v, 0x4E); }
__device__ __forceinline__ float lane_xor8(float v) { return DPP_F(v, 0x128); }
__device__ __forceinline__ float lane_xor4(float v, bool hi4) { const float up = DPP_F(v, 0x104), dn = DPP_F(v, 0x114); return hi4 ? dn : up; }
__device__ __forceinline__ float half_sum_f(float v) {
    v += DPP_F(v, 0xB1); v += DPP_F(v, 0x4E); v += DPP_F(v, 0x141); v += DPP_F(v, 0x140);
    const auto sw = __builtin_amdgcn_permlane16_swap(__float_as_uint(v), __float_as_uint(v), false, false); return __uint_as_float(sw[0]) + __uint_as_float(sw[1]); }
__device__ __forceinline__ float xor16_sum(float v) { const auto sw = __builtin_amdgcn_permlane16_swap(__float_as_uint(v), __float_as_uint(v), false, false); return __uint_as_float(sw[0]) + __uint_as_float(sw[1]); }
__device__ __forceinline__ float xor32_sum(float v) { const auto sw = __builtin_amdgcn_permlane32_swap(__float_as_uint(v), __float_as_uint(v), false, false); return __uint_as_float(sw[0]) + __uint_as_float(sw[1]); }
__device__ __forceinline__ float wave_sum(float v) { return xor32_sum(half_sum_f(v)); }
__device__ __forceinline__ float wave_max(float v) {
#pragma unroll
    for (int o = 1; o < 64; o <<= 1) v = fmaxf(v, __shfl_xor(v, o));
    return v;
}
__device__ __forceinline__ unsigned long long wave_max_u64(unsigned long long v) {
#pragma unroll
    for (int o = 1; o < 64; o <<= 1) { const unsigned lo = __shfl_xor((unsigned)v, o), hi = __shfl_xor((unsigned)(v >> 32), o); const unsigned long long w = ((unsigned long long)hi << 32) | lo; v = w > v ? w : v; }
    return v;
}

__device__ __forceinline__ int opaque_i(int v) { asm volatile("" : "+s"(v)); return v; }
#define XB_TMO      128
#define XB_XCNT(j)  (256  + 64 * (j))
#define XB_XSUB(j)  (1280 + 64 * (j))
#define XB_XGEN(j)  (2304 + 64 * (j))
#define XB_TOP      3328
#define XB_TOPGEN   3392
#define XCD_BAR_WORDS 3456
#define XB_SPIN_CAP (1u << 18)
__device__ __forceinline__ unsigned xb_ld(unsigned* p)              { return __hip_atomic_load(p, __ATOMIC_RELAXED, __HIP_MEMORY_SCOPE_AGENT); }
__device__ __forceinline__ unsigned xb_add(unsigned* p, unsigned v) { return __hip_atomic_fetch_add(p, v, __ATOMIC_RELAXED, __HIP_MEMORY_SCOPE_AGENT); }
__device__ __forceinline__ unsigned xb_xcc_id() { return (unsigned)__builtin_amdgcn_s_getreg((3 << 11) | 20) & 0xFu; }
#define XB_SPIN(cond, bar) do { unsigned _sp = 0; while (cond) { __builtin_amdgcn_s_sleep(1); \
    if ((++_sp & 255u) == 0u) { if (xb_ld(&(bar)[XB_TMO])) break; if (_sp > XB_SPIN_CAP) { atomicAdd(&(bar)[XB_TMO], 1u); break; } } } } while (0)
struct XcdBarrier { unsigned* bar; unsigned x; volatile LAS unsigned* st; };
__device__ __forceinline__ XcdBarrier xcd_barrier_post(unsigned* bar, volatile LAS unsigned* st) {
    XcdBarrier b; b.bar = bar; b.x = xb_xcc_id(); b.st = st;
    if (threadIdx.x == 0) (void)xb_add(&bar[XB_XCNT(b.x)], 1u);
    return b;
}
__device__ __forceinline__ void xcd_barrier_complete(unsigned* bar, unsigned x, unsigned& nloc, unsigned& nx) {
    const unsigned G = gridDim.x * gridDim.y * gridDim.z;
    unsigned sum, cnt, mine, sp = 0u;
    for (;;) {
        sum = 0u; cnt = 0u; mine = 0u;
#pragma unroll
        for (unsigned j = 0; j < 16; ++j) { const unsigned c = xb_ld(&bar[XB_XCNT(j)]); sum += c; cnt += (c > 0u) ? 1u : 0u; mine = (j == x) ? c : mine; }
        if (sum == G) break;
        __builtin_amdgcn_s_sleep(1);
        if ((++sp & 255u) == 0u) { if (xb_ld(&bar[XB_TMO])) break; if (sp > XB_SPIN_CAP) { atomicAdd(&bar[XB_TMO], 1u); break; } }
    }
    nloc = mine > 0u ? mine : 1u; nx = cnt > 0u ? cnt : 1u;
}
__device__ __forceinline__ void xcd_barrier(const XcdBarrier& b) {
    asm volatile("s_waitcnt vmcnt(0)" ::: "memory");
    __syncthreads();
    if (threadIdx.x == 0) {
        unsigned* bar = b.bar;
        __builtin_amdgcn_s_waitcnt(0);
        unsigned nloc = b.st[0], nx = b.st[1];
        if (nloc == 0u) { xcd_barrier_complete(bar, b.x, nloc, nx); b.st[0] = nloc; b.st[1] = nx; }
        const unsigned old = xb_add(&bar[XB_XSUB(b.x)], 1u);
        const unsigned gen = old / nloc;
        if (old + 1u == (gen + 1u) * nloc) {
            __builtin_amdgcn_fence(__ATOMIC_RELEASE, "agent");
            asm volatile("s_waitcnt vmcnt(0)" ::: "memory");
            const unsigned og = xb_add(&bar[XB_TOP], 1u);
            const unsigned tg = og / nx;
            if (og + 1u == (tg + 1u) * nx) xb_add(&bar[XB_TOPGEN], 1u);
            else XB_SPIN(xb_ld(&bar[XB_TOPGEN]) == tg, bar);
            __builtin_amdgcn_fence(__ATOMIC_ACQUIRE, "agent");
            xb_add(&bar[XB_XGEN(b.x)], 1u);
            asm volatile("s_waitcnt vmcnt(0)" ::: "memory");
        } else {
            XB_SPIN(xb_ld(&bar[XB_XGEN(b.x)]) == gen, bar);
            __builtin_amdgcn_fence(__ATOMIC_ACQUIRE, "agent");
            asm volatile("s_waitcnt vmcnt(0)" ::: "memory");
        }
    }
    __syncthreads();
}

struct Frame {
    LAS unsigned char* lds;
    volatile LAS unsigned* MISC;
    unsigned* ctl;
    int tid, lane, wave, G, gw, NGW;
    const float *x, *p, *rel_bias, *attn_g, *w_in, *b_gate, *q_g, *k_g, *w_att, *conv_w, *conv_b, *ln_g, *ln_b, *w_conv, *w_out, *ffn_g, *w_pq, *subk, *pu, *pv, *ple_g, *w_pg, *w_pp;
    float* out;
    float *ss1, *ss2, *rstd1, *rstd3, *tab, *mb, *WI;
    bf16 *KI, *Win_t, *Wa_t, *Wc_t, *Wout_t, *Wq_t, *Wg_t, *Wp_t, *SUBK, *EU, *EV, *PB;
    bf16 *XB, *ATT, *CV, *UB, *MIX, *PP, *Q, *K, *V, *QI, *GB, *QP;
    unsigned* bitmap;
};

namespace epi {
using pg8::f32x4; using pg8::u32x4; using pg8::Unit; using pg8::bf16_t;
__device__ __forceinline__ u32x4 pack8(const float* v) { u32x4 w; w.x = pk2(v[0], v[1]); w.y = pk2(v[2], v[3]); w.z = pk2(v[4], v[5]); w.w = pk2(v[6], v[7]); return w; }
__device__ __forceinline__ void unpack8(u32x4 w, float* v) { v[0] = bflo(w.x); v[1] = bfhi(w.x); v[2] = bflo(w.y); v[3] = bfhi(w.y); v[4] = bflo(w.z); v[5] = bfhi(w.z); v[6] = bflo(w.w); v[7] = bfhi(w.w); }

struct EpiInProj {
    static constexpr bool PERM = true, AFTER_DRAIN = false;
    const float* rstd; bf16_t *Q, *K, *V, *QI, *U, *G, *KI; float* WI; const float *qg, *kg, *bgate;
    __device__ __forceinline__ void operator()(const f32x4 (&acc)[2][2][4][2], const Unit& u, int wr, int wc, int fr, int fq) const {
        const int pn = u.pn, row0 = u.pm * 256 + wr * 64 + fr;
        if (pn < 4) {
            const bool isq = pn < 2; const float* g = isq ? qg : kg; bf16_t* O = isq ? Q : K; const float sc = isq ? C2 : 1.0f;
            const int head = (pn & 1) * 4 + wc;
            float gv[2][8];
#pragma unroll
            for (int bj = 0; bj < 2; ++bj)
#pragma unroll
                for (int j = 0; j < 8; ++j) gv[bj][j] = g[32 * bj + 8 * fq + j];
#pragma unroll
            for (int ai = 0; ai < 2; ++ai)
#pragma unroll
                for (int m = 0; m < 4; ++m) {
                    const int row = row0 + ai * 128 + m * 16; const float rs = rstd[row];
                    float v[2][8]; float ss = 0.f;
#pragma unroll
                    for (int bj = 0; bj < 2; ++bj)
#pragma unroll
                        for (int n = 0; n < 2; ++n)
#pragma unroll
                            for (int i = 0; i < 4; ++i) { const float xv = acc[ai][bj][m][n][i] * rs; v[bj][4 * n + i] = xv; ss += xv * xv; }
                    ss = xor32_sum(xor16_sum(ss));
                    const float inv = rsqrtf(ss * (1.0f / 64.0f) + EPS) * sc;
#pragma unroll
                    for (int bj = 0; bj < 2; ++bj) { float o[8];
#pragma unroll
                        for (int j = 0; j < 8; ++j) o[j] = v[bj][j] * inv * gv[bj][j];
                        *(u32x4*)(O + (size_t)row * AW + head * 64 + 32 * bj + 8 * fq) = pack8(o); }
                }
        } else if (pn < 8) {
            bf16_t* O = pn < 6 ? V : QI; const int cb = (pn & 1) * 256 + 32 * wc + 8 * fq;
#pragma unroll
            for (int ai = 0; ai < 2; ++ai)
#pragma unroll
                for (int m = 0; m < 4; ++m) {
                    const int row = row0 + ai * 128 + m * 16; const float rs = rstd[row];
#pragma unroll
                    for (int bj = 0; bj < 2; ++bj) { float o[8];
#pragma unroll
                        for (int n = 0; n < 2; ++n)
#pragma unroll
                            for (int i = 0; i < 4; ++i) o[4 * n + i] = acc[ai][bj][m][n][i] * rs;
                        *(u32x4*)(O + (size_t)row * AW + cb + 128 * bj) = pack8(o); }
                }
        } else if (pn < 12) {
            const int ch0 = (pn - 8) * 128 + 32 * wc + 8 * fq;
#pragma unroll
            for (int ai = 0; ai < 2; ++ai)
#pragma unroll
                for (int m = 0; m < 4; ++m) {
                    const int row = row0 + ai * 128 + m * 16; const float rs = rstd[row]; float o[8];
#pragma unroll
                    for (int n = 0; n < 2; ++n)
#pragma unroll
                        for (int i = 0; i < 4; ++i) { const float a = acc[ai][0][m][n][i] * rs, gg = acc[ai][1][m][n][i] * rs; o[4 * n + i] = a * sigmoidf_(gg); }
                    *(u32x4*)(U + (size_t)row * 512 + ch0) = pack8(o);
                }
        } else if (pn < 20) {
            const int cb = (pn - 12) * 256 + 32 * wc + 8 * fq;
            float bv[2][8];
#pragma unroll
            for (int bj = 0; bj < 2; ++bj)
#pragma unroll
                for (int j = 0; j < 8; ++j) bv[bj][j] = bgate[cb + 128 * bj + j];
#pragma unroll
            for (int ai = 0; ai < 2; ++ai)
#pragma unroll
                for (int m = 0; m < 4; ++m) {
                    const int row = row0 + ai * 128 + m * 16; const float rs = rstd[row];
#pragma unroll
                    for (int bj = 0; bj < 2; ++bj) { float o[8];
#pragma unroll
                        for (int n = 0; n < 2; ++n)
#pragma unroll
                            for (int i = 0; i < 4; ++i) o[4 * n + i] = sigmoid255(acc[ai][bj][m][n][i] * rs + bv[bj][4 * n + i]);
                        unsigned w0 = 0u, w1 = 0u;
#pragma unroll
                        for (int i = 0; i < 4; ++i) { w0 = __builtin_amdgcn_cvt_pk_u8_f32(fmaxf(o[i], 1.0f), i, w0); w1 = __builtin_amdgcn_cvt_pk_u8_f32(fmaxf(o[4 + i], 1.0f), i, w1); }
                        *(v2u*)((unsigned char*)G + (size_t)row * 2048 + cb + 128 * bj) = (v2u){w0, w1}; }
                }
        } else {
#pragma unroll
            for (int ai = 0; ai < 2; ++ai)
#pragma unroll
                for (int m = 0; m < 4; ++m) {
                    const int row = row0 + ai * 128 + m * 16; const float rs = rstd[row]; float o[8];
#pragma unroll
                    for (int n = 0; n < 2; ++n)
#pragma unroll
                        for (int i = 0; i < 4; ++i) o[4 * n + i] = acc[ai][0][m][n][i] * rs;
                    if (wc < 2) *(u32x4*)(KI + (size_t)row * 64 + 32 * wc + 8 * fq) = pack8(o);
                    else if (wc == 2 && fq == 0) {
                        *(f32x4*)(WI + (size_t)row * 8) = (f32x4){o[0] * IDX_SCALE, o[1] * IDX_SCALE, o[2] * IDX_SCALE, o[3] * IDX_SCALE};
                        *(f32x4*)(WI + (size_t)row * 8 + 4) = (f32x4){o[4] * IDX_SCALE, o[5] * IDX_SCALE, o[6] * IDX_SCALE, o[7] * IDX_SCALE}; }
                }
        }
    }
};
template <bool ADD> struct EpiGate {
    static constexpr bool PERM = true, AFTER_DRAIN = false;
    const bf16_t* G; int goff; bf16_t* O;
    __device__ __forceinline__ void operator()(const f32x4 (&acc)[2][2][4][2], const Unit& u, int wr, int wc, int fr, int fq) const {
        const int row0 = u.pm * 256 + wr * 64 + fr, col0 = u.pn * 256 + 32 * wc + 8 * fq;
#pragma unroll
        for (int ai = 0; ai < 2; ++ai)
#pragma unroll
            for (int m = 0; m < 4; ++m) { const int row = row0 + ai * 128 + m * 16;
#pragma unroll
                for (int bj = 0; bj < 2; ++bj) { const int col = col0 + 128 * bj; float gt[8], pv[8], o[8];
                    { const v2u gw = *(const v2u*)((const unsigned char*)G + (size_t)row * 2048 + goff + col);
#pragma unroll
                      for (int i = 0; i < 4; ++i) { gt[i] = (float)((gw.x >> (8 * i)) & 0xffu) * (1.0f / 255.0f); gt[4 + i] = (float)((gw.y >> (8 * i)) & 0xffu) * (1.0f / 255.0f); } }
                    if (ADD) unpack8(*(const u32x4*)(O + (size_t)row * D + col), pv);
#pragma unroll
                    for (int n = 0; n < 2; ++n)
#pragma unroll
                        for (int i = 0; i < 4; ++i) o[4 * n + i] = (ADD ? pv[4 * n + i] : 0.f) + gt[4 * n + i] * acc[ai][bj][m][n][i];
                    *(u32x4*)(O + (size_t)row * D + col) = pack8(o); } }
    }
};
struct EpiGate2 {
    static constexpr bool PERM = true, AFTER_DRAIN = false;
    const unsigned char* G; bf16_t* O;
    __device__ __forceinline__ void mid(f32x4 (&acc)[2][2][4][2], const Unit& u, int wr, int wc, int fr, int fq) const {
        const int row0 = u.pm * 256 + wr * 64 + fr, col0 = u.pn * 256 + 32 * wc + 8 * fq;
#pragma unroll
        for (int ai = 0; ai < 2; ++ai)
#pragma unroll
            for (int m = 0; m < 4; ++m) { const int row = row0 + ai * 128 + m * 16;
#pragma unroll
                for (int bj = 0; bj < 2; ++bj) { const int col = col0 + 128 * bj;
                    const v2u a = *(const v2u*)(G + (size_t)row * 2048 + col), b = *(const v2u*)(G + (size_t)row * 2048 + 1024 + col);
#pragma unroll
                    for (int i = 0; i < 4; ++i) {
                        acc[ai][bj][m][0][i] *= (float)((a.x >> (8 * i)) & 0xffu) * __builtin_amdgcn_rcpf((float)((b.x >> (8 * i)) & 0xffu));
                        acc[ai][bj][m][1][i] *= (float)((a.y >> (8 * i)) & 0xffu) * __builtin_amdgcn_rcpf((float)((b.y >> (8 * i)) & 0xffu)); } } }
    }
    __device__ __forceinline__ void operator()(const f32x4 (&acc)[2][2][4][2], const Unit& u, int wr, int wc, int fr, int fq) const {
        const int row0 = u.pm * 256 + wr * 64 + fr, col0 = u.pn * 256 + 32 * wc + 8 * fq;
#pragma unroll
        for (int ai = 0; ai < 2; ++ai)
#pragma unroll
            for (int m = 0; m < 4; ++m) { const int row = row0 + ai * 128 + m * 16;
#pragma unroll
                for (int bj = 0; bj < 2; ++bj) { const int col = col0 + 128 * bj; float o[8];
                    const v2u b = *(const v2u*)(G + (size_t)row * 2048 + 1024 + col);
#pragma unroll
                    for (int i = 0; i < 4; ++i) { o[i] = (float)((b.x >> (8 * i)) & 0xffu) * (1.0f / 255.0f) * acc[ai][bj][m][0][i]; o[4 + i] = (float)((b.y >> (8 * i)) & 0xffu) * (1.0f / 255.0f) * acc[ai][bj][m][1][i]; }
                    *(u32x4*)(O + (size_t)row * D + col) = pack8(o); } }
    }
};
struct EpiRes1 {
    static constexpr bool PERM = true, AFTER_DRAIN = false;
    const float* x; float* out; bf16_t* xb; float* ss;
    __device__ __forceinline__ void operator()(const f32x4 (&acc)[2][2][4][2], const Unit& u, int wr, int wc, int fr, int fq) const {
        const int row0 = u.pm * 256 + wr * 64 + fr, col0 = u.pn * 256 + 32 * wc + 8 * fq;
#pragma unroll
        for (int ai = 0; ai < 2; ++ai)
#pragma unroll
            for (int m = 0; m < 4; ++m) { const int row = row0 + ai * 128 + m * 16; float s = 0.f;
#pragma unroll
                for (int bj = 0; bj < 2; ++bj) { const size_t off = (size_t)row * D + col0 + 128 * bj;
                    float xv[8]; unpack8(*(const u32x4*)(xb + off), xv);
                    const f32x4 a = (f32x4){xv[0], xv[1], xv[2], xv[3]} + acc[ai][bj][m][0], b = (f32x4){xv[4], xv[5], xv[6], xv[7]} + acc[ai][bj][m][1];
                    u32x4 w; w.x = pk2(a[0], a[1]); w.y = pk2(a[2], a[3]); w.z = pk2(b[0], b[1]); w.w = pk2(b[2], b[3]); *(u32x4*)(xb + off) = w;
                    s += (a[0] * a[0] + a[1] * a[1]) + (a[2] * a[2] + a[3] * a[3]) + (b[0] * b[0] + b[1] * b[1]) + (b[2] * b[2] + b[3] * b[3]); }
                s = xor32_sum(xor16_sum(s));
                if (fq == 0) atomicAdd(ss + row, s); }
    }
};
struct EpiScaleRow {
    static constexpr bool PERM = true, AFTER_DRAIN = false;
    const float* ss; bf16_t* O; int ldc;
    __device__ __forceinline__ void operator()(const f32x4 (&acc)[2][2][4][2], const Unit& u, int wr, int wc, int fr, int fq) const {
        const int row0 = u.pm * 256 + wr * 64 + fr, col0 = u.pn * 256 + 32 * wc + 8 * fq;
#pragma unroll
        for (int ai = 0; ai < 2; ++ai)
#pragma unroll
            for (int m = 0; m < 4; ++m) { const int row = row0 + ai * 128 + m * 16; const float rs = rsqrtf(ss[row] * (1.0f / 1024.0f) + EPS);
#pragma unroll
                for (int bj = 0; bj < 2; ++bj) { float o[8];
#pragma unroll
                    for (int n = 0; n < 2; ++n)
#pragma unroll
                        for (int i = 0; i < 4; ++i) o[4 * n + i] = acc[ai][bj][m][n][i] * rs;
                    *(u32x4*)(O + (size_t)row * ldc + col0 + 128 * bj) = pack8(o); } }
    }
};
struct EpiPlain {
    static constexpr bool PERM = true, AFTER_DRAIN = false;
    bf16_t* O; int ldc;
    __device__ __forceinline__ void operator()(const f32x4 (&acc)[2][2][4][2], const Unit& u, int wr, int wc, int fr, int fq) const {
        const int row0 = u.pm * 256 + wr * 64 + fr, col0 = u.pn * 256 + 32 * wc + 8 * fq;
#pragma unroll
        for (int ai = 0; ai < 2; ++ai)
#pragma unroll
            for (int m = 0; m < 4; ++m) { const int row = row0 + ai * 128 + m * 16;
#pragma unroll
                for (int bj = 0; bj < 2; ++bj) { float o[8];
#pragma unroll
                    for (int n = 0; n < 2; ++n)
#pragma unroll
                        for (int i = 0; i < 4; ++i) o[4 * n + i] = acc[ai][bj][m][n][i];
                    *(u32x4*)(O + (size_t)row * ldc + col0 + 128 * bj) = pack8(o); } }
    }
};
struct EpiPle {
    static constexpr bool PERM = true, AFTER_DRAIN = false;
    const float* rstd; const bf16_t* pp; const bf16_t* xb; float* out;
    __device__ __forceinline__ void operator()(const f32x4 (&acc)[2][2][4][2], const Unit& u, int wr, int wc, int fr, int fq) const {
        const int row0 = u.pm * 256 + wr * 64 + fr, col0 = u.pn * 256 + 32 * wc + 8 * fq;
#pragma unroll
        for (int ai = 0; ai < 2; ++ai)
#pragma unroll
            for (int m = 0; m < 4; ++m) { const int row = row0 + ai * 128 + m * 16; const float rs = rsqrtf(rstd[row] * (1.0f / 1024.0f) + EPS);
#pragma unroll
                for (int bj = 0; bj < 2; ++bj) { const size_t off = (size_t)row * D + col0 + 128 * bj; float pv[8];
                    unpack8(*(const u32x4*)(pp + off), pv);
                    float xv[8]; unpack8(*(const u32x4*)(xb + off), xv);
                    f32x4 a = (f32x4){xv[0], xv[1], xv[2], xv[3]}, b = (f32x4){xv[4], xv[5], xv[6], xv[7]};
#pragma unroll
                    for (int i = 0; i < 4; ++i) { a[i] += sigmoidf_(acc[ai][bj][m][0][i] * rs) * pv[i]; b[i] += sigmoidf_(acc[ai][bj][m][1][i] * rs) * pv[4 + i]; }
                    *(f32x4*)(out + off) = a; *(f32x4*)(out + off + 4) = b; }
                asm volatile("" ::: "memory"); }
    }
};
}

__device__ __forceinline__ void tr_item(const float* W, int ldw, int K, int src_col0, int nvalid, bf16* WT, int dst_row0, const float* gain, LAS float* scr, int kb, int lane) {
    const int k0 = 64 * kb;
#pragma unroll
    for (int j = 0; j < 8; ++j) { const int kk = (lane >> 3) + 8 * j, c4 = (lane & 7) * 4; f32x4 v = (f32x4){0.f, 0.f, 0.f, 0.f};
        if (src_col0 >= 0 && c4 < nvalid) { v = *(const f32x4*)(W + (size_t)(k0 + kk) * ldw + src_col0 + c4); if (gain) v *= gain[k0 + kk]; }
        scr[kk * 33 + c4] = v[0]; scr[kk * 33 + c4 + 1] = v[1]; scr[kk * 33 + c4 + 2] = v[2]; scr[kk * 33 + c4 + 3] = v[3]; }
    LDS_WAIT(); asm volatile("" ::: "memory");
    const int c = lane & 7;
#pragma unroll
    for (int j = 0; j < 4; ++j) { const int n = (lane >> 3) + 8 * j; const LAS float* s = scr + (8 * c) * 33 + n;
        v4u o; o.x = pk2(s[0 * 33], s[1 * 33]); o.y = pk2(s[2 * 33], s[3 * 33]); o.z = pk2(s[4 * 33], s[5 * 33]); o.w = pk2(s[6 * 33], s[7 * 33]);
        *(v4u*)(WT + (size_t)(dst_row0 + n) * K + k0 + 8 * c) = o; }
    LDS_WAIT(); asm volatile("" ::: "memory");
}
__device__ __forceinline__ void win_src_col(int gidx, int& src, int& nvalid) {
    const int tile = gidx >> 3, gi = gidx & 7; nvalid = 32;
    if (tile < 2) src = (tile * 4 + (gi & 3)) * 64 + (gi >> 2) * 32;
    else if (tile < 4) src = 512 + ((tile - 2) * 4 + (gi & 3)) * 64 + (gi >> 2) * 32;
    else if (tile < 6) src = 1024 + (tile - 4) * 256 + gi * 32;
    else if (tile < 8) src = 1536 + (tile - 6) * 256 + gi * 32;
    else if (tile < 12) src = (gi < 4) ? 2120 + 128 * (tile - 8) + 32 * gi : 2632 + 128 * (tile - 8) + 32 * (gi - 4);
    else if (tile < 20) src = 3144 + (tile - 12) * 256 + 32 * gi;
    else { if (gi < 2) src = 2048 + 32 * gi; else if (gi == 2) { src = 2112; nvalid = 8; } else { src = -1; nvalid = 0; } }
}
__device__ __forceinline__ void cvt_bf16_stream(const float* src, bf16* dst, size_t n8, size_t start, size_t stride) {
    for (size_t i = start; i < n8; i += stride) { const f32x4 a = *(const f32x4*)(src + i * 8), b = *(const f32x4*)(src + i * 8 + 4);
        v4u o; o.x = pk2(a[0], a[1]); o.y = pk2(a[2], a[3]); o.z = pk2(b[0], b[1]); o.w = pk2(b[2], b[3]); *(v4u*)(dst + i * 8) = o; }
}
__device__ __forceinline__ void cvt_fp8_stream(const float* src, unsigned char* dst, size_t n16, size_t start, size_t stride, float scale) {
    for (size_t i = start; i < n16; i += stride) { v4u o;
#pragma unroll
        for (int j = 0; j < 4; ++j) { const f32x4 a = *(const f32x4*)(src + i * 16 + 4 * j) * scale; int pk = __builtin_amdgcn_cvt_pk_fp8_f32(a[0], a[1], 0, false); pk = __builtin_amdgcn_cvt_pk_fp8_f32(a[2], a[3], pk, true); o[j] = (unsigned)pk; }
        const size_t row = (i * 16) >> 10, col = (i * 16) & 1023;
        *(v4u*)(dst + ((col >> 7) * 16384 + row) * 128 + (col & 127)) = o; }
}
constexpr float EU_SCALE = 256.0f, EV_SCALE = 16.0f;
__device__ __forceinline__ int t5_bucket(int rel) {
    const int n = rel < 0 ? -rel : rel; int v;
    if (n < 8) v = n; else { v = 8 + (int)(logf((float)n / 8.0f) / logf(128.0f) * 8.0f); if (v > 15) v = 15; }
    return (rel > 0 ? 16 : 0) + v;
}
__device__ __forceinline__ void p0_prologue(Frame& F) {
    LAS float* scr = (LAS float*)(F.lds + RING_OFF + F.wave * 16384);
    const int gw = F.gw, NGW = F.NGW, lane = F.lane;
    constexpr int I_IN = 168 * 16, I_A = 32 * 8, I_C = 32 * 8, I_O = 32 * 16, I_Q = 64 * 16, I_G = 32 * 16, I_P = 32 * 4;
    constexpr int NITEMS = I_IN + I_A + I_C + I_O + I_Q + I_G + I_P;
    for (int it = gw; it < NITEMS; it += NGW) {
        int r = it;
        if (r < I_IN) { int src, nv; win_src_col(r / 16, src, nv); tr_item(F.w_in, 5192, D, src, nv, F.Win_t, (r / 16) * 32, F.attn_g, scr, r % 16, lane); continue; } r -= I_IN;
        if (r < I_A) { tr_item(F.w_att, D, 1024, (r / 8) * 32, 32, F.Wa_t, (r / 8) * 32, nullptr, scr, r % 8, lane); continue; } r -= I_A;
        if (r < I_C) { tr_item(F.w_conv, D, 1024, (r / 8) * 32, 32, F.Wa_t + 512, (r / 8) * 32, nullptr, scr, r % 8, lane);     continue; } r -= I_C;
        if (r < I_O) { tr_item(F.w_out, D, D, (r / 16) * 32, 32, F.Wout_t, (r / 16) * 32, nullptr, scr, r % 16, lane); continue; } r -= I_O;
        if (r < I_Q) { tr_item(F.w_pq, 2048, D, (r / 16) * 32, 32, F.Wq_t, (r / 16) * 32, F.ffn_g, scr, r % 16, lane); continue; } r -= I_Q;
        if (r < I_G) { tr_item(F.w_pg, D, D, (r / 16) * 32, 32, F.Wg_t, (r / 16) * 32, F.ple_g, scr, r % 16, lane); continue; } r -= I_G;
        tr_item(F.w_pp, D, PLE, (r / 4) * 32, 32, F.Wp_t, (r / 4) * 32, nullptr, scr, r % 4, lane);
    }
    const size_t gt = (size_t)blockIdx.x * (NWAVES * 64) + F.tid, GT = (size_t)F.G * NWAVES * 64;
    cvt_bf16_stream(F.subk, F.SUBK, (size_t)PEER_H * 2 * NKEYS * 128 / 8, gt, GT);
#ifdef NAIVE_P7
    cvt_bf16_stream(F.pu, F.EU, (size_t)16384 * D / 8, gt, GT);
    cvt_bf16_stream(F.pv, F.EV, (size_t)16384 * D / 8, gt, GT);
#else
    cvt_fp8_stream(F.pu, (unsigned char*)F.EU, (size_t)16384 * D / 16, gt, GT, EU_SCALE);
    cvt_fp8_stream(F.pv, (unsigned char*)F.EV, (size_t)16384 * D / 16, gt, GT, EV_SCALE);
#endif
    cvt_bf16_stream(F.p, F.PB, (size_t)M * PLE / 8, gt, GT);
    for (int m = gw; m < M; m += NGW) {
        const f32x4* xr = (const f32x4*)(F.x + (size_t)m * D) + lane; f32x4 v[4]; float s = 0.f;
#pragma unroll
        for (int j = 0; j < 4; ++j) { v[j] = xr[64 * j]; s += (v[j][0] * v[j][0] + v[j][1] * v[j][1]) + (v[j][2] * v[j][2] + v[j][3] * v[j][3]); }
        s = wave_sum(s);
        if (lane == 0) F.rstd1[m] = rsqrtf(s * (1.0f / D) + EPS);
        v2u* o8 = (v2u*)(F.XB + (size_t)m * D) + lane;
#pragma unroll
        for (int j = 0; j < 4; ++j) { v2u o; o.x = pk2(v[j][0], v[j][1]); o.y = pk2(v[j][2], v[j][3]); o8[64 * j] = o; }
    }
    if (blockIdx.x == 0 && F.wave == 0) { const float gq = wave_max(fabsf(F.q_g[lane])), gk = wave_max(fabsf(F.k_g[lane]));
        float bm = 0.f;
#pragma unroll
        for (int i = 0; i < 4; ++i) bm = fmaxf(bm, fabsf(F.rel_bias[lane + 64 * i]));
        bm = wave_max(bm);
        if (lane == 0) F.mb[0] = C2 * 64.0f * gq * gk + LOG2E * bm + 0.5f; }
    for (size_t i = gt; i < (size_t)NH * TABN; i += GT) { const int h = (int)(i / TABN), rel = (int)(i % TABN) - TABOFF; F.tab[i] = LOG2E * F.rel_bias[t5_bucket(rel) * NH + h]; }
}

__device__ __forceinline__ void p2_index_naive(Frame& F, float* scratch) {
    const int lane = F.lane;
    LAS unsigned* qi_l = (LAS unsigned*)(F.lds + F.wave * 1024);
    LAS unsigned* hist = (LAS unsigned*)(F.lds + 8192 + F.wave * 1024);
    float* scr = scratch + (size_t)F.gw * SEQ;
    const unsigned long long lt = __lanemask_lt();
    for (int t = F.gw; t < M; t += F.NGW) {
        const int b = t / SEQ, sq = t % SEQ, vis = (sq / 64 + 1) * 64, nst = vis / 64;
        unsigned* bm = F.bitmap + (size_t)t * 256;
        if (vis <= TOPK) { for (int wd = lane; wd < 256; wd += 64) bm[wd] = (wd * 32 < vis) ? 0xffffffffu : 0u; continue; }
        *(LAS v4u*)(qi_l + lane * 4) = *(const v4u*)(F.QI + (size_t)t * 512 + lane * 8);
        float w[8];
#pragma unroll
        for (int h = 0; h < 8; ++h) w[h] = F.WI[(size_t)t * 8 + h];
        LDS_WAIT();
        for (int st = 0; st < nst; ++st) {
            asm volatile("" ::: "memory");
            const int key = st * 64 + lane; const v4u* kr = (const v4u*)(F.KI + ((size_t)b * SEQ + key) * 64);
            v4u kk[8];
#pragma unroll
            for (int i = 0; i < 8; ++i) kk[i] = kr[i];
            float s = 0.f;
#pragma unroll
            for (int h = 0; h < 8; ++h) { float d = 0.f;
#pragma unroll
                for (int i = 0; i < 8; ++i) d = dot8(*(const LAS v4u*)(qi_l + h * 32 + i * 4), kk[i], d);
                s += w[h] * fmaxf(d, 0.f); }
            scr[key] = s;
        }
        unsigned prefix = 0u, remaining = TOPK;
        for (int pass = 0; pass < 4; ++pass) {
            const int shift = 24 - 8 * pass;
            *(LAS v4u*)(hist + lane * 4) = (v4u){0u, 0u, 0u, 0u};
            LDS_WAIT();
            for (int st = 0; st < nst; ++st) { const unsigned uu = sortable(scr[st * 64 + lane]);
                const bool ok = (pass == 0) || ((uu >> (shift + 8)) == prefix);
                if (ok) __hip_atomic_fetch_add(hist + ((uu >> shift) & 255u), 1u, __ATOMIC_RELAXED, __HIP_MEMORY_SCOPE_WORKGROUP); }
            LDS_WAIT();
            const v4u c = *(const LAS v4u*)(hist + lane * 4);
            const unsigned tot = c.x + c.y + c.z + c.w; unsigned incl = tot;
#pragma unroll
            for (int o = 1; o < 64; o <<= 1) { const unsigned v = __shfl_down(incl, o); incl += (lane + o < 64) ? v : 0u; }
            const unsigned excl = incl - tot;
            const bool mine = (excl < remaining) && (remaining <= incl);
            unsigned bsel = 0u, before = 0u;
            if (mine) { unsigned cum = excl;
                if (remaining <= cum + c.w) { bsel = 3u; before = cum; } else { cum += c.w;
                if (remaining <= cum + c.z) { bsel = 2u; before = cum; } else { cum += c.z;
                if (remaining <= cum + c.y) { bsel = 1u; before = cum; } else { cum += c.y; bsel = 0u; before = cum; } } }
                bsel += 4u * lane; }
            const unsigned long long mm = __ballot(mine);
            const int src = __ffsll((long long)mm) - 1;
            bsel = __shfl(bsel, src); before = __shfl(before, src);
            prefix = (prefix << 8) | bsel; remaining -= before;
            LDS_WAIT();
        }
        unsigned taken = 0u;
        for (int st = 0; st < nst; ++st) { const unsigned uu = sortable(scr[st * 64 + lane]);
            const bool gtb = uu > prefix, eq = uu == prefix; const unsigned long long meq = __ballot(eq);
            const unsigned rank = __popcll(meq & lt); const bool sel = gtb || (eq && (taken + rank < remaining)); taken += __popcll(meq);
            const unsigned long long ms = __ballot(sel);
            if (lane == 0) { bm[2 * st] = (unsigned)ms; bm[2 * st + 1] = (unsigned)(ms >> 32); } }
        for (int wd = 2 * nst + lane; wd < 256; wd += 64) bm[wd] = 0u;
    }
}
__device__ __forceinline__ void p2_conv_naive(Frame& F) {
    const int lane = F.lane, c0 = 8 * lane;
    for (int t = F.gw; t < M; t += F.NGW) {
        const int sq = t % SEQ; float y[8];
#pragma unroll
        for (int i = 0; i < 8; ++i) y[i] = F.conv_b[c0 + i];
        for (int j = 0; j < CONVW; ++j) { const int sp = sq - (CONVW - 1) + j; if (sp < 0) continue;
            float uv[8]; epi::unpack8(*(const v4u*)(F.UB + (size_t)(t - (CONVW - 1) + j) * 512 + c0), uv);
            const f32x4 w0 = *(const f32x4*)(F.conv_w + j * 512 + c0), w1 = *(const f32x4*)(F.conv_w + j * 512 + c0 + 4);
#pragma unroll
            for (int i = 0; i < 4; ++i) { y[i] += uv[i] * w0[i]; y[4 + i] += uv[4 + i] * w1[i]; } }
        float s = 0.f;
#pragma unroll
        for (int i = 0; i < 8; ++i) s += y[i];
        const float mean = wave_sum(s) * (1.0f / 512.0f); float q = 0.f;
#pragma unroll
        for (int i = 0; i < 8; ++i) { y[i] -= mean; q += y[i] * y[i]; }
        const float rstd = rsqrtf(wave_sum(q) * (1.0f / 512.0f) + EPS); float o[8];
#pragma unroll
        for (int i = 0; i < 8; ++i) { const float z = y[i] * rstd * F.ln_g[c0 + i] + F.ln_b[c0 + i]; o[i] = z * sigmoidf_(z); }
        *(v4u*)(F.CV + (size_t)t * 512 + c0) = epi::pack8(o);
    }
}
__device__ __forceinline__ void p3_attn_naive(Frame& F) {
    const int lane = F.lane;
    LAS int* sel = (LAS int*)(F.lds + F.wave * 2048);
    LAS float* pl = (LAS float*)(F.lds + F.wave * 2048 + 1024);
    const unsigned long long lt = __lanemask_lt();
    for (int t = F.gw; t < M; t += F.NGW) {
        const int b = t / SEQ, sq = t % SEQ, vis = (sq / 64 + 1) * 64, nst = vis / 64;
        const unsigned* bm = F.bitmap + (size_t)t * 256; int nsel = 0;
        for (int st = 0; st < nst; ++st) { const unsigned long long m = (unsigned long long)bm[2 * st] | ((unsigned long long)bm[2 * st + 1] << 32);
            const int pos = nsel + __popcll(m & lt); if (((m >> lane) & 1ull) && pos < TOPK) sel[pos] = st * 64 + lane;
            nsel += __popcll(m); nsel = nsel > TOPK ? TOPK : nsel; }
        LDS_WAIT();
        for (int h = 0; h < NH; ++h) {
            v4u qq[8]; const v4u* qr = (const v4u*)(F.Q + (size_t)t * AW + h * 64);
#pragma unroll
            for (int i = 0; i < 8; ++i) qq[i] = qr[i];
            float lg[4]; float mx = -INFINITY;
#pragma unroll
            for (int j = 0; j < 4; ++j) { const int idx = lane + 64 * j; lg[j] = -INFINITY;
                if (idx < nsel) { const int key = sel[idx]; const v4u* kr = (const v4u*)(F.K + ((size_t)b * SEQ + key) * AW + h * 64); float d = 0.f;
#pragma unroll
                    for (int i = 0; i < 8; ++i) d = dot8(qq[i], kr[i], d);
                    int ti = key - sq + TABOFF; ti = ti < 0 ? 0 : ti; d += F.tab[h * TABN + ti]; lg[j] = d; mx = fmaxf(mx, d); } }
            mx = wave_max(mx); float sm = 0.f;
#pragma unroll
            for (int j = 0; j < 4; ++j) { const int idx = lane + 64 * j; if (idx < nsel) { const float pj = exp2f(lg[j] - mx); sm += pj; pl[idx] = pj; } }
            sm = wave_sum(sm); LDS_WAIT();
            float o = 0.f; const bf16* vb = F.V + (size_t)b * SEQ * AW + h * 64 + lane;
            for (int j = 0; j < nsel; ++j) o += pl[j] * bf1(vb[(size_t)sel[j] * AW]);
            F.ATT[(size_t)t * AW + h * 64 + lane] = (bf16)f2bf(o / sm);
            LDS_WAIT();
        }
    }
}
__device__ __forceinline__ void p7_peer_naive(Frame& F) {
    const int lane = F.lane;
    LAS int* EI = (LAS int*)(F.lds + F.wave * 2048);
    LAS float* GT = (LAS float*)(F.lds + F.wave * 2048 + 512);
    LAS float* sv = (LAS float*)(F.lds + F.wave * 2048 + 1024);
    LAS int* si = (LAS int*)(F.lds + F.wave * 2048 + 1024 + 128);
    LAS float* ts = (LAS float*)(F.lds + F.wave * 2048 + 1024 + 256);
    for (int t = F.gw; t < M; t += F.NGW) {
        for (int h = 0; h < PEER_H; ++h) {
            for (int c = 0; c < 2; ++c) {
                v4u qv[16]; const v4u* qr = (const v4u*)(F.QP + (size_t)t * 2048 + h * 256 + c * 128);
#pragma unroll
                for (int i = 0; i < 16; ++i) qv[i] = qr[i];
                float s[2];
#pragma unroll
                for (int kk = 0; kk < 2; ++kk) { const v4u* kr = (const v4u*)(F.SUBK + ((size_t)(h * 2 + c) * NKEYS + lane + 64 * kk) * 128); float d = 0.f;
#pragma unroll
                    for (int i = 0; i < 16; ++i) d = dot8(qv[i], kr[i], d);
                    s[kk] = d; }
                unsigned long long k0 = ((unsigned long long)sortable(s[0]) << 32) | (0xffffffffu - (unsigned)lane), k1 = ((unsigned long long)sortable(s[1]) << 32) | (0xffffffffu - (unsigned)(lane + 64));
                for (int r = 0; r < PTOPK; ++r) {
                    const unsigned long long best = wave_max_u64(k0 > k1 ? k0 : k1);
                    const int bi = (int)(0xffffffffu - (unsigned)best);
                    if (k0 == best) { sv[c * 16 + r] = s[0]; si[c * 16 + r] = bi; k0 = 0ull; }
                    if (k1 == best) { sv[c * 16 + r] = s[1]; si[c * 16 + r] = bi; k1 = 0ull; }
                }
            }
            LDS_WAIT();
            unsigned long long ck[4]; float cs[4];
#pragma unroll
            for (int jj = 0; jj < 4; ++jj) { const int n = lane + 64 * jj; cs[jj] = sv[n >> 4] + sv[16 + (n & 15)]; ck[jj] = ((unsigned long long)sortable(cs[jj]) << 32) | (0xffffffffu - (unsigned)n); }
            for (int r = 0; r < PTOPK; ++r) {
                unsigned long long loc = ck[0] > ck[1] ? ck[0] : ck[1]; const unsigned long long loc2 = ck[2] > ck[3] ? ck[2] : ck[3]; loc = loc > loc2 ? loc : loc2;
                const unsigned long long best = wave_max_u64(loc);
                const int n = (int)(0xffffffffu - (unsigned)best);
#pragma unroll
                for (int jj = 0; jj < 4; ++jj) if (ck[jj] == best) { ts[r] = cs[jj]; EI[h * 16 + r] = si[n >> 4] * NKEYS + si[16 + (n & 15)]; ck[jj] = 0ull; }
            }
            LDS_WAIT();
            { const float t0 = ts[0]; float e = (lane < 16) ? __expf(ts[lane & 15] - t0) : 0.f; const float sum = wave_sum(e); if (lane < 16) GT[h * 16 + lane] = e / sum; }
            LDS_WAIT();
        }
        const float rs2 = rsqrtf(F.ss1[t] * (1.0f / D) + EPS);
        f32x4 x1[4]; float hx[16], oa[16];
#pragma unroll
        for (int j = 0; j < 4; ++j) { x1[j] = *((const f32x4*)(F.out + (size_t)t * D) + lane + 64 * j); const f32x4 g = *((const f32x4*)F.ffn_g + lane + 64 * j);
#pragma unroll
            for (int i = 0; i < 4; ++i) { hx[4 * j + i] = x1[j][i] * rs2 * g[i]; oa[4 * j + i] = 0.f; } }
        for (int n = 0; n < PEER_H * PTOPK; ++n) {
            const int e = EI[n]; const float g = GT[n];
            const v2u* ur = (const v2u*)(F.EU + (size_t)e * D) + lane; const v2u* vr = (const v2u*)(F.EV + (size_t)e * D) + lane; float d = 0.f; v2u vv[4];
#pragma unroll
            for (int j = 0; j < 4; ++j) { const v2u uu = ur[64 * j]; vv[j] = vr[64 * j];
                d += bflo(uu.x) * hx[4 * j] + bfhi(uu.x) * hx[4 * j + 1] + bflo(uu.y) * hx[4 * j + 2] + bfhi(uu.y) * hx[4 * j + 3]; }
            d = wave_sum(d); const float a = gelu_tanh(d) * g;
#pragma unroll
            for (int j = 0; j < 4; ++j) { oa[4 * j] += a * bflo(vv[j].x); oa[4 * j + 1] += a * bfhi(vv[j].x); oa[4 * j + 2] += a * bflo(vv[j].y); oa[4 * j + 3] += a * bfhi(vv[j].y); }
        }
        float s = 0.f;
#pragma unroll
        for (int j = 0; j < 4; ++j) { f32x4 o;
#pragma unroll
            for (int i = 0; i < 4; ++i) { o[i] = x1[j][i] + oa[4 * j + i]; s += o[i] * o[i]; }
            *((f32x4*)(F.out + (size_t)t * D) + lane + 64 * j) = o;
            v2u w; w.x = pk2(o[0], o[1]); w.y = pk2(o[2], o[3]); *((v2u*)(F.XB + (size_t)t * D) + lane + 64 * j) = w; }
        s = wave_sum(s); if (lane == 0) F.rstd3[t] = rsqrtf(s * (1.0f / D) + EPS);
        LDS_WAIT();
    }
}


__device__ __forceinline__ void p2_conv(Frame& F) {
    const int tid = F.tid, lane = F.lane, wave = F.wave;
    LAS bf16* UT = (LAS bf16*)(F.lds + RING_OFF);
    LAS float* YT = (LAS float*)(F.lds + RING_OFF + 63488);
    float w[CONVW];
#pragma unroll
    for (int j = 0; j < CONVW; ++j) w[j] = F.conv_w[j * 512 + tid];
    const float cb = F.conv_b[tid];
    for (int tile = blockIdx.x; tile < M / 32; tile += F.G) {
        const int t0 = tile * 32, s0 = t0 % SEQ;
        __syncthreads();
#pragma unroll
        for (int i = 0; i < 8; ++i) { const int p = tid + 512 * i, row = p >> 6, c16 = p & 63;
            if (row < 62) { v4u v = (v4u){0u, 0u, 0u, 0u}; if (s0 - 30 + row >= 0) v = *(const v4u*)(F.UB + (size_t)(t0 - 30 + row) * 512 + c16 * 8); *(LAS v4u*)(UT + row * 512 + c16 * 8) = v; } }
        __syncthreads();
        { float u[62];
#pragma unroll
          for (int k = 0; k < 62; ++k) u[k] = bf1(UT[k * 512 + tid]);
#pragma unroll
          for (int o = 0; o < 32; ++o) { float y0 = cb, y1 = 0.f;
#pragma unroll
              for (int j = 0; j < CONVW - 1; j += 2) { y0 += w[j] * u[o + j]; y1 += w[j + 1] * u[o + j + 1]; }
              y0 += w[CONVW - 1] * u[o + CONVW - 1];
              YT[o * 512 + tid] = y0 + y1; } }
        __syncthreads();
#pragma unroll
        for (int i = 0; i < 4; ++i) { const int tk = wave * 4 + i; const f32x4 a = *(const LAS f32x4*)(YT + tk * 512 + 8 * lane), b = *(const LAS f32x4*)(YT + tk * 512 + 8 * lane + 4);
            float y[8] = {a[0], a[1], a[2], a[3], b[0], b[1], b[2], b[3]}; float s = 0.f;
#pragma unroll
            for (int e = 0; e < 8; ++e) s += y[e];
            const float mean = wave_sum(s) * (1.0f / 512.0f); float q = 0.f;
#pragma unroll
            for (int e = 0; e < 8; ++e) { y[e] -= mean; q += y[e] * y[e]; }
            const float rstd = rsqrtf(wave_sum(q) * (1.0f / 512.0f) + EPS); float o[8];
            const f32x4 g0 = *(const f32x4*)(F.ln_g + 8 * lane), g1 = *(const f32x4*)(F.ln_g + 8 * lane + 4), b0 = *(const f32x4*)(F.ln_b + 8 * lane), b1 = *(const f32x4*)(F.ln_b + 8 * lane + 4);
#pragma unroll
            for (int e = 0; e < 8; ++e) { const float z = y[e] * rstd * (e < 4 ? g0[e & 3] : g1[e & 3]) + (e < 4 ? b0[e & 3] : b1[e & 3]); o[e] = z * sigmoidf_(z); }
            *(v4u*)(F.ATT + (size_t)(t0 + tk) * 1024 + 512 + 8 * lane) = epi::pack8(o); }
    }
}
typedef short bf16x8_t __attribute__((ext_vector_type(8)));
typedef short s16x2 __attribute__((ext_vector_type(2)));
typedef unsigned short u16x2 __attribute__((ext_vector_type(2)));
constexpr int KT_BYTES = 512 * 128;
constexpr unsigned SC_INVALID = 0x80008000u;
__device__ __forceinline__ unsigned score_key16(float f) { const _Float16 hv = (_Float16)f; const unsigned short b = __builtin_bit_cast(unsigned short, hv); return (unsigned)(unsigned short)(b ^ (unsigned short)(((short)b >> 15) & 0x7FFF)); }
__device__ __forceinline__ unsigned pk_lt_count(unsigned acc, unsigned v, unsigned cpk) {
    const s16x2 d = __builtin_elementwise_sub_sat(__builtin_bit_cast(s16x2, v), __builtin_bit_cast(s16x2, cpk));
    const u16x2 m = __builtin_bit_cast(u16x2, d) >> (u16x2){15, 15};
    return __builtin_bit_cast(unsigned, (u16x2)(__builtin_bit_cast(u16x2, acc) + m));
}
__device__ __forceinline__ unsigned pk_ne_count(unsigned acc, unsigned v, unsigned cpk) {
    const u16x2 e = __builtin_elementwise_min(__builtin_bit_cast(u16x2, v ^ cpk), (u16x2){1, 1});
    return __builtin_bit_cast(unsigned, (u16x2)(__builtin_bit_cast(u16x2, acc) + e));
}
__device__ __forceinline__ int half_sum_i(int v) {
    v += __builtin_amdgcn_update_dpp(0, v, 0xB1, 0xF, 0xF, false); v += __builtin_amdgcn_update_dpp(0, v, 0x4E, 0xF, 0xF, false);
    v += __builtin_amdgcn_update_dpp(0, v, 0x141, 0xF, 0xF, false); v += __builtin_amdgcn_update_dpp(0, v, 0x140, 0xF, 0xF, false);
    const auto sw = __builtin_amdgcn_permlane16_swap((unsigned)v, (unsigned)v, false, false); return (int)(sw[0] + sw[1]); }
#define P2_WRITELANE2(WA, WB, VA, VB, LN) asm volatile("s_nop 1\n\tv_writelane_b32 %0, %2, %4\n\tv_writelane_b32 %1, %3, %4" : "+v"(WA), "+v"(WB) : "s"(VA), "s"(VB), "n"(LN))
__device__ __forceinline__ void p2_index(Frame& F) {
    const int lane = F.lane, wave = F.wave, tid = F.tid, B = (int)blockIdx.x;
    LAS unsigned char* KT = F.lds + RING_OFF;
    for (int it = 0;; ++it) {
        const int L = it * F.G + B; if (L >= M / 16) break;
        const int b = L / 512, r512 = L % 512, j = (r512 < 256) ? r512 : 767 - r512;
        const int q0 = 16 * j, vis = (q0 / 64 + 1) * 64;
        const size_t row0 = (size_t)b * SEQ;
        unsigned* bm0 = F.bitmap + (row0 + q0 + 2 * wave) * 256; unsigned* bm1 = bm0 + 256;
        if (vis <= TOPK) {
#pragma unroll
            for (int g = 0; g < 4; ++g) { const unsigned w = ((64 * g + lane) * 32 < vis) ? 0xffffffffu : 0u; bm0[64 * g + lane] = w; bm1[64 * g + lane] = w; }
            continue;
        }
        bf16x8_t af[2];
        { const int rw = lane & 15, tq = rw >> 3, hh = rw & 7; const bf16* qp = F.QI + (row0 + q0 + 2 * wave + tq) * 512 + hh * 64 + 8 * (lane >> 4);
          const float wrow = F.WI[(row0 + q0 + 2 * wave + tq) * 8 + hh];
          v4u a0 = *(const v4u*)qp, a1 = *(const v4u*)(qp + 32);
#pragma unroll
          for (int i = 0; i < 4; ++i) { a0[i] = pk2(bflo(a0[i]) * wrow, bfhi(a0[i]) * wrow); a1[i] = pk2(bflo(a1[i]) * wrow, bfhi(a1[i]) * wrow); }
          af[0] = __builtin_bit_cast(bf16x8_t, a0); af[1] = __builtin_bit_cast(bf16x8_t, a1); }
        const f32x4 w4 = *(const f32x4*)(F.WI + (row0 + q0 + 2 * wave + (lane >> 5)) * 8 + ((lane >> 4) & 1) * 4);
        float clo[4], chi[4];
#pragma unroll
        for (int i = 0; i < 4; ++i) { clo[i] = (w4[i] >= 0.f) ? 0.f : -INFINITY; chi[i] = (w4[i] >= 0.f) ? INFINITY : 0.f; }
        typedef unsigned u32x16_t __attribute__((ext_vector_type(16)));
        u32x16_t scv[8];
#pragma unroll
        for (int i = 0; i < 8; ++i)
#pragma unroll
            for (int j = 0; j < 16; ++j) scv[i][j] = SC_INVALID;
        const int nt2 = (vis + 511) / 512;
        const int srow = 64 * wave + (lane >> 3), schunk = (lane & 7) ^ (lane >> 3);
        const bf16* gsrc = F.KI + (row0 + srow) * 64 + schunk * 8;
#define P2_STAGE(BUF, TILEBASE) do { _Pragma("unroll") for (int i_ = 0; i_ < 8; ++i_) \
            __builtin_amdgcn_global_load_lds((const unsigned*)(gsrc + (size_t)(TILEBASE) * 64 + i_ * 512), (LAS unsigned*)((BUF) + wave * 8192 + i_ * 1024), 16, 0, 0); } while (0)
        __syncthreads();
        P2_STAGE(KT, 0);
        VM_WAIT(); __syncthreads();
        const int brow = lane & 15, q4 = lane >> 4;
        const int fo0 = brow * 128 + ((q4 ^ (brow & 7)) << 4), fo1 = brow * 128 + (((4 + q4) ^ (brow & 7)) << 4);
#define P2_LOADF(DST, BUF, R) do { _Pragma("unroll") for (int kb_ = 0; kb_ < 4; ++kb_) { DST[kb_][0] = *(const LAS bf16x8_t*)((BUF) + (4 * (R) + kb_) * 2048 + fo0); DST[kb_][1] = *(const LAS bf16x8_t*)((BUF) + (4 * (R) + kb_) * 2048 + fo1); } } while (0)
        for (int T = 0; T < nt2; ++T) {
            const int base = 512 * T;
            LAS unsigned char* buf = KT + (T & 1) * KT_BYTES; LAS unsigned char* nbuf = KT + ((T + 1) & 1) * KT_BYTES;
            if (T + 1 < nt2) P2_STAGE(nbuf, base + 512);
            bf16x8_t fA[4][2], fB[4][2];
#ifndef P2_SCREP
#define P2_SCREP 1
#endif
            for (int srep_ = 0; srep_ < P2_SCREP; ++srep_) {
            P2_LOADF(fA, buf, 0);
            f32x4 accA[4], accB[4];
#define P2_MMA(ACC, FR) do { _Pragma("unroll") for (int kb_ = 0; kb_ < 4; ++kb_) ACC[kb_] = __builtin_amdgcn_mfma_f32_16x16x32_bf16(af[0], FR[kb_][0], (f32x4){0.f, 0.f, 0.f, 0.f}, 0, 0, 0); \
                              _Pragma("unroll") for (int kb_ = 0; kb_ < 4; ++kb_) ACC[kb_] = __builtin_amdgcn_mfma_f32_16x16x32_bf16(af[1], FR[kb_][1], ACC[kb_], 0, 0, 0); } while (0)
#define P2_ADDF(A, B) ({ float r_; asm("v_add_f32 %0, %1, %2" : "=v"(r_) : "v"(A), "v"(B)); r_; })
#define P2_FIN(ACC, R) do { float ps_[4]; \
                _Pragma("unroll") for (int kb_ = 0; kb_ < 4; ++kb_) ps_[kb_] = P2_ADDF(P2_ADDF(__builtin_amdgcn_fmed3f(ACC[kb_][0], clo[0], chi[0]), __builtin_amdgcn_fmed3f(ACC[kb_][1], clo[1], chi[1])), P2_ADDF(__builtin_amdgcn_fmed3f(ACC[kb_][2], clo[2], chi[2]), __builtin_amdgcn_fmed3f(ACC[kb_][3], clo[3], chi[3]))); \
                const auto swa_ = __builtin_amdgcn_permlane16_swap(__float_as_uint(ps_[0]), __float_as_uint(ps_[1]), false, false); \
                const auto swb_ = __builtin_amdgcn_permlane16_swap(__float_as_uint(ps_[2]), __float_as_uint(ps_[3]), false, false); \
                const float s0_ = P2_ADDF(__uint_as_float(swa_[0]), __uint_as_float(swa_[1])), s1_ = P2_ADDF(__uint_as_float(swb_[0]), __uint_as_float(swb_[1])); \
                typedef _Float16 h16x2_ __attribute__((ext_vector_type(2))); \
                const h16x2_ hv_ = {(_Float16)s0_, (_Float16)s1_}; const unsigned hb_ = __builtin_bit_cast(unsigned, hv_); \
                const unsigned kk_ = hb_ ^ (__builtin_bit_cast(unsigned, (s16x2)(__builtin_bit_cast(s16x2, hb_) >> (s16x2){15, 15})) & 0x7FFF7FFFu); \
                scv[R][T] = (base + 64 * (R) < vis) ? kk_ : SC_INVALID; } while (0)
            P2_LOADF(fB, buf, 1);
            P2_MMA(accA, fA);
            __builtin_amdgcn_sched_barrier(0);
#pragma unroll
            for (int r = 1; r < 8; ++r) {
                bf16x8_t (&cur)[4][2] = (r & 1) ? fB : fA; bf16x8_t (&nxt)[4][2] = (r & 1) ? fA : fB;
                if (r & 1) { P2_MMA(accB, cur); } else { P2_MMA(accA, cur); }
                __builtin_amdgcn_sched_barrier(0);
                if (r < 7) P2_LOADF(nxt, buf, r + 1);
                if (r & 1) { P2_FIN(accA, r - 1); } else { P2_FIN(accB, r - 1); }
                __builtin_amdgcn_sched_barrier(0);
            }
            P2_FIN(accB, 7);
#undef P2_MMA
#undef P2_FIN
            }
            VM_WAIT(); __syncthreads();
        }
#undef P2_STAGE
#undef P2_LOADF
        int Tu, lastrej, eqc;
        { const int ltfix = (128 - 8 * nt2) * 2;
#define P2_SS(V, CPK) __builtin_bit_cast(unsigned, __builtin_elementwise_sub_sat(__builtin_bit_cast(s16x2, (unsigned)(V)), __builtin_bit_cast(s16x2, CPK)))
#define P2_COUNT_GE(CU, GE, LTL) do { const unsigned cs_ = (unsigned)((CU) - 32768) & 0xffffu, cpk_ = cs_ | (cs_ << 16); \
            unsigned a0_ = 0u, a1_ = 0u, a2_ = 0u, a3_ = 0u; \
            _Pragma("unroll") for (int c = 0; c < 16; ++c) if (c < nt2) { \
                const unsigned d0_ = P2_SS(scv[0][c], cpk_), d1_ = P2_SS(scv[1][c], cpk_), d2_ = P2_SS(scv[2][c], cpk_), d3_ = P2_SS(scv[3][c], cpk_), \
                               d4_ = P2_SS(scv[4][c], cpk_), d5_ = P2_SS(scv[5][c], cpk_), d6_ = P2_SS(scv[6][c], cpk_), d7_ = P2_SS(scv[7][c], cpk_); \
                const unsigned p0_ = __builtin_amdgcn_perm(d0_, d1_, 0x07050301u), p1_ = __builtin_amdgcn_perm(d2_, d3_, 0x07050301u), p2_ = __builtin_amdgcn_perm(d4_, d5_, 0x07050301u), p3_ = __builtin_amdgcn_perm(d6_, d7_, 0x07050301u); \
                a0_ += (unsigned)__builtin_popcount(p0_ & 0x80808080u); a1_ += (unsigned)__builtin_popcount(p1_ & 0x80808080u); a2_ += (unsigned)__builtin_popcount(p2_ & 0x80808080u); a3_ += (unsigned)__builtin_popcount(p3_ & 0x80808080u); \
                asm volatile("" : "+v"(a0_), "+v"(a1_), "+v"(a2_), "+v"(a3_)); } \
            LTL = (int)((a0_ + a1_) + (a2_ + a3_)); GE = 8192 - half_sum_i(LTL + ltfix); } while (0)
          int est = 0;
          { const int nvs = vis < 512 ? vis : 512, ks = (TOPK * nvs) / vis;
            for (int bit = 15; bit >= 5; --bit) {
                const int cu = est | (1 << bit); const unsigned cs = (unsigned)(cu - 32768) & 0xffffu, cpk = cs | (cs << 16);
                unsigned a = 0u;
#pragma unroll
                for (int r = 0; r < 8; ++r) a = pk_lt_count(a, scv[r][0], cpk);
                const int lt = half_sum_i((int)(a & 0xffffu) + (int)(a >> 16));
                if (512 - lt >= ks) est = cu; } }
          int lo = 0, hi = 65536, chi = 0, ge, ltl, step = 64; bool kl = false, kh = false;
          int ltlo = 0, lthi = 16 * nt2;
          for (;;) {
              const bool fin = kl && kh && (hi - lo <= 1);
              if (__ballot(!fin) == 0ull) break;
              const bool gal = kl != kh;
              int cand = (kl && kh) ? lo + ((hi - lo) >> 1) : kl ? lo + step : kh ? hi - step : est;
              cand = cand < 0 ? 0 : (cand > 65535 ? 65535 : cand);
              P2_COUNT_GE(cand, ge, ltl);
              if (ge >= TOPK) { if (cand >= lo) { lo = cand; ltlo = ltl; } kl = true; if (cand == 65535) kh = true; }
              else { if (cand < hi) { hi = cand; chi = ge; lthi = ltl; } kh = true; }
              if (gal) step <<= 1;
          }
#undef P2_COUNT_GE
#undef P2_SS
          Tu = lo; lastrej = chi; eqc = lthi - ltlo; }
        const unsigned ts16 = (unsigned)(Tu - 32768) & 0xffffu, tpk = ts16 | (ts16 << 16);
        const int need = TOPK - lastrej;
        int quota;
        { const int eq = eqc;
          int incl = eq;
#pragma unroll
          for (int o = 1; o < 32; o <<= 1) { const int v = __shfl_up(incl, o, 32); incl += ((lane & 31) >= o) ? v : 0; }
          const int excl = incl - eq; quota = need - excl; quota = quota < 0 ? 0 : (quota > eq ? eq : quota); }
        const int Ts = (int)(short)ts16;
#ifndef P2_FINREP
#define P2_FINREP 1
#endif
        int run = 0;
        const bool simple = __ballot((quota > 0) && (quota < eqc)) == 0ull;
        const short te = (short)((quota > 0) ? Ts - 1 : Ts);
        for (int frep_ = 0; frep_ < P2_FINREP; ++frep_) { run = 0;
        for (int g = 0; g < 4; ++g) {
            unsigned W0 = 0u, W1 = 0u;
            if (4 * g < nt2) {
                if (simple) {
#pragma unroll
                  for (int s = 0; s < 64; ++s) {
                    const unsigned v = scv[(s >> 1) & 7][4 * g + (s >> 4)];
                    const short key = (s & 1) ? (short)(v >> 16) : (short)(v & 0xffffu);
                    const unsigned long long msk = __ballot(key > te);
                    const unsigned mlo = (unsigned)msk, mhi = (unsigned)(msk >> 32);
                    P2_WRITELANE2(W0, W1, mlo, mhi, s);
                  }
                } else {
#pragma unroll
                  for (int s = 0; s < 64; ++s) {
                    const unsigned v = scv[(s >> 1) & 7][4 * g + (s >> 4)];
                    const int key = (s & 1) ? ((int)v >> 16) : (int)(short)(v & 0xffffu);
                    const bool eq = key == Ts; const bool take = eq && (run < quota); run += eq ? 1 : 0;
                    const unsigned long long msk = __ballot((key > Ts) || take);
                    const unsigned mlo = (unsigned)msk, mhi = (unsigned)(msk >> 32);
                    P2_WRITELANE2(W0, W1, mlo, mhi, s);
                  }
                }
            }
            bm0[64 * g + lane] = W0; bm1[64 * g + lane] = W1;
        }
        }
    }
}
__device__ __forceinline__ float unsort_mid(unsigned m, unsigned lowmask, unsigned mid) { const unsigned u = (m & ~lowmask) | mid; return __uint_as_float((u & 0x80000000u) ? (u ^ 0x80000000u) : ~u); }
__device__ __forceinline__ unsigned umax3(unsigned a, unsigned b, unsigned c) { return max(max(a, b), c); }
__device__ __forceinline__ void ce_desc(unsigned& a, unsigned& b) { const unsigned hi = max(a, b), lo = min(a, b); a = hi; b = lo; }
__device__ __forceinline__ void merge16_desc(unsigned (&v)[16]) {
#pragma unroll
    for (int j = 8; j >= 1; j >>= 1)
#pragma unroll
        for (int i = 0; i < 16; ++i) { const int l = i ^ j; if (l > i) ce_desc(v[i], v[l]); }
}
__device__ __forceinline__ void sort16_desc(unsigned (&v)[16]) {
#pragma unroll
    for (int k = 2; k <= 16; k <<= 1)
#pragma unroll
        for (int j = k >> 1; j >= 1; j >>= 1)
#pragma unroll
            for (int i = 0; i < 16; ++i) { const int l = i ^ j; if (l > i) { if ((i & k) == 0) ce_desc(v[i], v[l]); else ce_desc(v[l], v[i]); } }
}
constexpr int SK_PITCH = 272;
__device__ __forceinline__ void p7_peer(Frame& F, unsigned* keys1, unsigned short* eig, float* gtg) {
    const int lane = F.lane, wave = F.wave, tid = F.tid;
    LAS unsigned char* SK = F.lds + RING_OFF;
    LAS int* EI = (LAS int*)(F.lds + RING_OFF);
    LAS float* GT = (LAS float*)(F.lds + RING_OFF + 32768);
    const int nunits = M / 64;
    for (int unit = blockIdx.x; unit < nunits; unit += F.G) {
        const int t0 = unit * 64;
        const int c = wave >> 2, tok = t0 + (wave & 3) * 16 + (lane & 15), q4 = lane >> 4;
        v4u stg[8]; bf16x8_t qn[4];
#define P7_PREF(H) do { const v4u* src_ = (const v4u*)(F.SUBK + (size_t)(H) * 2 * NKEYS * 128);     \
            _Pragma("unroll") for (int i = 0; i < 8; ++i) stg[i] = src_[tid + 512 * i]; \
            _Pragma("unroll") for (int s_ = 0; s_ < 4; ++s_) qn[s_] = *(const bf16x8_t*)(F.QP + (size_t)tok * 2048 + (H) * 256 + c * 128 + 32 * s_ + 8 * q4); } while (0)
        P7_PREF(0);
        for (int h = 0; h < PEER_H; ++h) {
            __syncthreads();
#pragma unroll
            for (int i = 0; i < 8; ++i) { const int p = tid + 512 * i, row = p >> 4, c16 = p & 15; *(LAS v4u*)(SK + row * SK_PITCH + c16 * 16) = stg[i]; }
            bf16x8_t qf[4];
#pragma unroll
            for (int s = 0; s < 4; ++s) qf[s] = qn[s];
            __syncthreads();
            if (h + 1 < PEER_H) P7_PREF(h + 1);
            unsigned pk[32];
#pragma unroll
            for (int kb = 0; kb < 8; ++kb) { f32x4 acc = (f32x4){0.f, 0.f, 0.f, 0.f};
#pragma unroll
                for (int s = 0; s < 4; ++s) { const bf16x8_t a = *(const LAS bf16x8_t*)(SK + (c * 128 + 16 * kb + (lane & 15)) * SK_PITCH + (32 * s + 8 * q4) * 2);
                    acc = __builtin_amdgcn_mfma_f32_16x16x32_bf16(a, qf[s], acc, 0, 0, 0); }
#pragma unroll
                for (int i = 0; i < 4; ++i) pk[kb * 4 + i] = (sortable(acc[i]) & ~0x7Fu) | (unsigned)(127 - (16 * kb + 4 * q4 + i)); }
            unsigned Mr[16];
            { unsigned A[16], B[16];
#pragma unroll
              for (int i = 0; i < 16; ++i) { A[i] = pk[i]; B[i] = pk[16 + i]; }
              sort16_desc(A); sort16_desc(B);
#pragma unroll
              for (int i = 0; i < 16; ++i) Mr[i] = max(A[i], B[15 - i]);
              merge16_desc(Mr);
              unsigned P[16];
#pragma unroll
              for (int i = 0; i < 16; ++i) { const auto sw = __builtin_amdgcn_permlane16_swap(Mr[15 - i], Mr[i], false, false); P[i] = sw[1]; }
#pragma unroll
              for (int i = 0; i < 16; ++i) Mr[i] = max(Mr[i], P[i]);
              merge16_desc(Mr);
#pragma unroll
              for (int i = 0; i < 16; ++i) { const auto sw = __builtin_amdgcn_permlane32_swap(Mr[15 - i], Mr[15 - i], false, false); P[i] = sw[1]; }
#pragma unroll
              for (int i = 0; i < 16; ++i) Mr[i] = max(Mr[i], P[i]);
              merge16_desc(Mr); }
            if (q4 == 0) { v4u* dst = (v4u*)(keys1 + (((size_t)tok * 8 + h) * 2 + c) * 16);
#pragma unroll
                for (int i = 0; i < 4; ++i) dst[i] = (v4u){Mr[4 * i], Mr[4 * i + 1], Mr[4 * i + 2], Mr[4 * i + 3]}; }
        }
#undef P7_PREF
        VM_WAIT(); __syncthreads();
        { const int tl = tid & 63, h = tid >> 6, tok = t0 + tl;
          const unsigned* kp = keys1 + ((size_t)tok * 8 + h) * 32;
          unsigned kk[32];
#pragma unroll
          for (int i = 0; i < 8; ++i) { const v4u w = ((const v4u*)kp)[i]; kk[4 * i] = w.x; kk[4 * i + 1] = w.y; kk[4 * i + 2] = w.z; kk[4 * i + 3] = w.w; }
          float s0[16], s1[16];
#pragma unroll
          for (int i = 0; i < 16; ++i) { s0[i] = unsort_mid(kk[i], 0x7Fu, 0x40u); s1[i] = unsort_mid(kk[16 + i], 0x7Fu, 0x40u); }
          unsigned x0[16], x1[16];
#pragma unroll
          for (int i = 0; i < 16; ++i) { x0[i] = (127u - (kk[i] & 0x7Fu)) * NKEYS; x1[i] = 127u - (kk[16 + i] & 0x7Fu); }
          unsigned ck[50]; { int k = 0;
#pragma unroll
            for (int i = 0; i < 16; ++i)
#pragma unroll
                for (int j = 0; j < 16; ++j) if ((i + 1) * (j + 1) <= 16) { ck[k] = (sortable(s0[i] + s1[j]) & ~0x3FFFu) | (x0[i] + x1[j]); ++k; } }
          unsigned G1[16], G2[16], G3[16], Fw[16];
#pragma unroll
          for (int i = 0; i < 16; ++i) { G1[i] = ck[i]; G2[i] = ck[16 + i]; G3[i] = ck[32 + i]; }
          sort16_desc(G2); sort16_desc(G3);
          { unsigned g40 = ck[48], g41 = ck[49]; ce_desc(g40, g41);
#pragma unroll
            for (int i = 0; i < 16; ++i) G1[i] = max(G1[i], G2[15 - i]);
            merge16_desc(G1);
            G3[15] = max(G3[15], g40); G3[14] = max(G3[14], g41);
            merge16_desc(G3); }
#pragma unroll
          for (int i = 0; i < 16; ++i) Fw[i] = max(G1[i], G3[15 - i]);
          merge16_desc(Fw);
          float ts[16];
#pragma unroll
          for (int r = 0; r < 16; ++r) { ts[r] = unsort_mid(Fw[r], 0x3FFFu, 0x2000u); EI[tl * 128 + h * 16 + r] = (int)(Fw[r] & 0x3FFFu); }
          float ex[16]; float sum = 0.f;
#pragma unroll
          for (int r = 0; r < 16; ++r) { ex[r] = __expf(ts[r] - ts[0]); sum += ex[r]; }
          const float inv = 1.0f / sum;
#pragma unroll
          for (int r = 0; r < 16; ++r) GT[tl * 128 + h * 16 + r] = ex[r] * inv;
        }
        __syncthreads();
        { v2u* de = (v2u*)(eig + (size_t)t0 * 128); v4u* dg = (v4u*)(gtg + (size_t)t0 * 128); const LAS v4u* se = (const LAS v4u*)EI; const LAS v4u* sg = (const LAS v4u*)GT;
#pragma unroll
          for (int i = 0; i < 4; ++i) { const v4u e4 = se[tid + 512 * i]; v2u o; o.x = e4.x | (e4.y << 16); o.y = e4.z | (e4.w << 16); de[tid + 512 * i] = o; dg[tid + 512 * i] = sg[tid + 512 * i]; } }
    }
}
constexpr int CW_UCNT = 8192, CW_VCNT = 9216;
__device__ __forceinline__ int p7_next_unit(Frame& F, unsigned* cnt, int myp, int& pq, int ntiles) {
    for (;;) {
        if (pq >= 8) return -1;
        const int p = (myp + pq) & 7;
        if (F.tid == 0) F.MISC[16] = __hip_atomic_fetch_add(cnt + 64 * p, 1u, __ATOMIC_RELAXED, __HIP_MEMORY_SCOPE_AGENT);
        __syncthreads(); const unsigned idx = F.MISC[16]; __syncthreads();
        if (idx < (unsigned)ntiles) return p * ntiles + (int)idx;
        ++pq;
    }
}
typedef float f32x2_ __attribute__((ext_vector_type(2)));
__device__ __forceinline__ void p7_uphase(Frame& F, const unsigned short* eig, bf16* part, int cntoff) {
    const int lane = F.lane, wave = F.wave;
    const int myp = (int)(xb_xcc_id() & 7u); int pq = 0;
    LAS int* EL = (LAS int*)(F.lds + RING_OFF + wave * 4096);
    const unsigned char* EU8 = (const unsigned char*)F.EU;
    const int g = lane >> 3, c = lane & 7;
    for (;;) {
        const int unit = p7_next_unit(F, F.ctl + CW_UCNT + cntoff, myp, pq, M / 256); if (unit < 0) break;
        const int p = unit / (M / 256), tw = (unit % (M / 256)) * 256 + wave * 32;
        const unsigned char* ubase = EU8 + (size_t)p * (16384 * 128) + 16 * c;
        bf16* pp = part + (size_t)p * M * 128;
        f32x4 g2[4];
#pragma unroll
        for (int q = 0; q < 4; ++q) g2[q] = *(const f32x4*)(F.ffn_g + 128 * p + 16 * c + 4 * q);
        int e0, e1;
#define PU_FETCH(T) do { e0 = __builtin_nontemporal_load(eig + (size_t)(T) * 128 + lane); e1 = __builtin_nontemporal_load(eig + (size_t)(T) * 128 + 64 + lane); } while (0)
#define PU_STASH(BUF) do { EL[(BUF) * 128 + lane] = e0; EL[(BUF) * 128 + 64 + lane] = e1; LDS_WAIT(); } while (0)
#define PU_XLOAD(S, T) do { xa##S = __builtin_nontemporal_load((const v4u*)(F.XB + (size_t)(T) * D + 128 * p + 16 * c)); xb##S = __builtin_nontemporal_load((const v4u*)(F.XB + (size_t)(T) * D + 128 * p + 16 * c + 8)); ss##S = F.ss1[T]; } while (0)
#define PU_XCVT(S) do { xv[0] = (f32x4){bflo(xa##S.x), bfhi(xa##S.x), bflo(xa##S.y), bfhi(xa##S.y)}; xv[1] = (f32x4){bflo(xa##S.z), bfhi(xa##S.z), bflo(xa##S.w), bfhi(xa##S.w)}; \
            xv[2] = (f32x4){bflo(xb##S.x), bfhi(xb##S.x), bflo(xb##S.y), bfhi(xb##S.y)}; xv[3] = (f32x4){bflo(xb##S.z), bfhi(xb##S.z), bflo(xb##S.w), bfhi(xb##S.w)}; rs2 = rsqrtf(ss##S * (1.0f / D) + EPS); } while (0)
#define PU_GATHER(VR, BUF) do { _Pragma("unroll") for (int i_ = 0; i_ < 16; ++i_) { const int e_ = EL[(BUF) * 128 + 8 * i_ + g]; VR[i_] = *(const v4u*)(ubase + (size_t)e_ * 128); } } while (0)
#define PU_REDUCE(VR, S, T) do { \
            PU_XCVT(S); f32x2_ hx2[8]; \
            _Pragma("unroll") for (int q_ = 0; q_ < 4; ++q_) { const f32x4 h_ = xv[q_] * g2[q_] * rs2; hx2[2 * q_] = (f32x2_){h_[0], h_[1]}; hx2[2 * q_ + 1] = (f32x2_){h_[2], h_[3]}; } \
            float v16[16]; \
            _Pragma("unroll") for (int i_ = 0; i_ < 16; ++i_) { f32x2_ d2_ = (f32x2_){0.f, 0.f}; \
                _Pragma("unroll") for (int j_ = 0; j_ < 4; ++j_) { const f32x2_ lo_ = __builtin_amdgcn_cvt_pk_f32_fp8((int)VR[i_][j_], false), hi_ = __builtin_amdgcn_cvt_pk_f32_fp8((int)VR[i_][j_], true); \
                    d2_ = __builtin_elementwise_fma(lo_, hx2[2 * j_], d2_); d2_ = __builtin_elementwise_fma(hi_, hx2[2 * j_ + 1], d2_); } \
                v16[i_] = d2_.x + d2_.y; } \
              \
            float w8[8], w4[4], w2[2]; \
              \
            _Pragma("unroll") for (int j_ = 0; j_ < 8; ++j_) { const float a_ = v16[2 * j_], b_ = v16[2 * j_ + 1]; w8[j_] = ((lane & 1) ? b_ : a_) + lane_xor1((lane & 1) ? a_ : b_); } \
            _Pragma("unroll") for (int j_ = 0; j_ < 4; ++j_) { const float a_ = w8[2 * j_], b_ = w8[2 * j_ + 1]; w4[j_] = ((lane & 2) ? b_ : a_) + lane_xor2((lane & 2) ? a_ : b_); } \
            _Pragma("unroll") for (int j_ = 0; j_ < 2; ++j_) { const float a_ = w4[2 * j_], b_ = w4[2 * j_ + 1]; w2[j_] = ((lane & 4) ? b_ : a_) + lane_xor4((lane & 4) ? a_ : b_, (lane & 4) != 0); } \
            pp[(size_t)(T) * 128 + 8 * c + g] = (bf16)f2bf(w2[0]); pp[(size_t)(T) * 128 + 64 + 8 * c + g] = (bf16)f2bf(w2[1]); } while (0)
        v4u vA[16], vB[16]; f32x4 xv[4]; float rs2; v4u xaA, xbA, xaB, xbB; float ssA, ssB;
        PU_FETCH(tw); PU_STASH(0); PU_GATHER(vA, 0); PU_FETCH(tw + 1); PU_STASH(1); PU_XLOAD(A, tw);
        for (int ti = 0; ti < 32; ti += 2) {
            PU_XLOAD(B, tw + ti + 1);
            if (ti + 2 < 32) PU_FETCH(tw + ti + 2);
            PU_GATHER(vB, 1);
            PU_REDUCE(vA, A, tw + ti);
            if (ti + 2 < 32) PU_STASH(0);
            PU_XLOAD(A, tw + (ti + 2 < 32 ? ti + 2 : 31));
            if (ti + 3 < 32) PU_FETCH(tw + ti + 3);
            if (ti + 2 < 32) PU_GATHER(vA, 0);
            PU_REDUCE(vB, B, tw + ti + 1);
            if (ti + 3 < 32) PU_STASH(1);
        }
#undef PU_FETCH
#undef PU_STASH
#undef PU_XLOAD
#undef PU_XCVT
#undef PU_GATHER
#undef PU_REDUCE
    }
}
__device__ __forceinline__ void p7_reduce(Frame& F, const bf16* part, const float* gtg, float* actg) {
    const int lane = F.lane, ts = lane >> 4, e0 = (lane & 15) * 8;
    for (int t4 = F.gw * 4; t4 < M; t4 += F.NGW * 4) {
        const int t = t4 + ts;
        v4u w[8];
#pragma unroll
        for (int q = 0; q < 8; ++q) w[q] = __builtin_nontemporal_load((const v4u*)(part + ((size_t)q * M + t) * 128 + e0));
        const f32x4 g0 = *(const f32x4*)(gtg + (size_t)t * 128 + e0), g1 = *(const f32x4*)(gtg + (size_t)t * 128 + e0 + 4);
        float sacc[8];
#pragma unroll
        for (int i = 0; i < 8; ++i) sacc[i] = 0.f;
#pragma unroll
        for (int q = 0; q < 8; ++q)
#pragma unroll
            for (int i = 0; i < 4; ++i) { sacc[2 * i] += bflo(w[q][i]); sacc[2 * i + 1] += bfhi(w[q][i]); }
        f32x4 o0, o1;
#pragma unroll
        for (int i = 0; i < 4; ++i) { o0[i] = gelu_tanh(sacc[i] * (1.0f / EU_SCALE)) * g0[i]; o1[i] = gelu_tanh(sacc[4 + i] * (1.0f / EU_SCALE)) * g1[i]; }
        *(f32x4*)(actg + (size_t)t * 128 + e0) = o0; *(f32x4*)(actg + (size_t)t * 128 + e0 + 4) = o1;
    }
}
__device__ __forceinline__ void p7_vphase(Frame& F, const unsigned short* eig, const float* actg, float* ss2, int cntoff, bool dry) {
    const int lane = F.lane, wave = F.wave;
    const int myp = (int)(xb_xcc_id() & 7u); int pq = 0;
    LAS int* EL = (LAS int*)(F.lds + RING_OFF + wave * 4096);
    LAS float* AL = (LAS float*)(F.lds + RING_OFF + wave * 4096 + 1024);
    LAS float* OS = (LAS float*)(F.lds + RING_OFF + wave * 4096 + 2048);
    const unsigned char* EV8 = (const unsigned char*)F.EV;
    const int g = lane >> 3, c = lane & 7;
    const int b3 = (lane >> 3) & 1, b4 = (lane >> 4) & 1, b5 = (lane >> 5) & 1;
    const int colp = 16 * (lane & 7) + 8 * b5 + 4 * b4 + 2 * b3;
    for (;;) {
        const int unit = p7_next_unit(F, F.ctl + CW_VCNT + cntoff, myp, pq, M / 256); if (unit < 0) break;
        const int p = unit / (M / 256), tw = (unit % (M / 256)) * 256 + wave * 32;
        const unsigned char* vbase = EV8 + (size_t)p * (16384 * 128) + 16 * c;
        int e0, e1; float a0, a1;
#define PV_FETCH(T) do { e0 = __builtin_nontemporal_load(eig + (size_t)(T) * 128 + lane); e1 = __builtin_nontemporal_load(eig + (size_t)(T) * 128 + 64 + lane); \
                         a0 = __builtin_nontemporal_load(actg + (size_t)(T) * 128 + lane); a1 = __builtin_nontemporal_load(actg + (size_t)(T) * 128 + 64 + lane); } while (0)
#define PV_STASH(BUF) do { EL[(BUF) * 128 + lane] = e0; EL[(BUF) * 128 + 64 + lane] = e1; AL[(BUF) * 128 + lane] = a0 * (1.0f / EV_SCALE); AL[(BUF) * 128 + 64 + lane] = a1 * (1.0f / EV_SCALE); LDS_WAIT(); } while (0)
#define PV_GATHER(VR, BUF) do { _Pragma("unroll") for (int i_ = 0; i_ < 16; ++i_) { const int e_ = EL[(BUF) * 128 + 8 * i_ + g]; VR[i_] = *(const v4u*)(vbase + (size_t)e_ * 128); } } while (0)
#define PV_XLOAD(T) do { xw = *(const unsigned*)(F.XB + (size_t)(T) * D + 128 * p + colp); } while (0)
#define PV_REDUCE(VR, BUF, T) do { \
            const size_t off_ = (size_t)(T) * D + 128 * p + colp; \
            f32x2_ ac2[8]; \
            _Pragma("unroll") for (int k_ = 0; k_ < 8; ++k_) ac2[k_] = (f32x2_){0.f, 0.f}; \
            _Pragma("unroll") for (int i_ = 0; i_ < 16; ++i_) { const float a_ = AL[(BUF) * 128 + 8 * i_ + g]; const f32x2_ aa_ = (f32x2_){a_, a_}; \
                _Pragma("unroll") for (int j_ = 0; j_ < 4; ++j_) { const f32x2_ lo_ = __builtin_amdgcn_cvt_pk_f32_fp8((int)VR[i_][j_], false), hi_ = __builtin_amdgcn_cvt_pk_f32_fp8((int)VR[i_][j_], true); \
                    ac2[2 * j_] = __builtin_elementwise_fma(aa_, lo_, ac2[2 * j_]); ac2[2 * j_ + 1] = __builtin_elementwise_fma(aa_, hi_, ac2[2 * j_ + 1]); } } \
            float acc[16]; \
            _Pragma("unroll") for (int k_ = 0; k_ < 8; ++k_) { acc[2 * k_] = ac2[k_].x; acc[2 * k_ + 1] = ac2[k_].y; } \
            float a8[8], a4[4], c2[2]; \
              \
            _Pragma("unroll") for (int j_ = 0; j_ < 8; ++j_) { const auto sw_ = __builtin_amdgcn_permlane32_swap(__float_as_uint(acc[j_]), __float_as_uint(acc[j_ + 8]), false, false); a8[j_] = __uint_as_float(sw_[0]) + __uint_as_float(sw_[1]); } \
            _Pragma("unroll") for (int j_ = 0; j_ < 4; ++j_) { const auto sw_ = __builtin_amdgcn_permlane16_swap(__float_as_uint(a8[j_]), __float_as_uint(a8[j_ + 4]), false, false); a4[j_] = __uint_as_float(sw_[0]) + __uint_as_float(sw_[1]); } \
            _Pragma("unroll") for (int j_ = 0; j_ < 2; ++j_) { const float a_ = a4[j_], b_ = a4[j_ + 2]; c2[j_] = (b3 ? b_ : a_) + lane_xor8(b3 ? a_ : b_); } \
            const float x0_ = bflo(xw) + c2[0], x1_ = bfhi(xw) + c2[1]; \
            if (!dry) *(unsigned*)(F.XB + off_) = pk2(x0_, x1_); \
            const float ssq_ = wave_sum(x0_ * x0_ + x1_ * x1_); if (lane == 0) atomicAdd(ss2 + (T), dry ? 0.f : ssq_); } while (0)
        v4u vA[16], vB[16]; unsigned xw;
        PV_FETCH(tw); PV_STASH(0); PV_GATHER(vA, 0); PV_FETCH(tw + 1); PV_STASH(1);
        for (int ti = 0; ti < 32; ti += 2) {
            PV_XLOAD(tw + ti);
            if (ti + 2 < 32) PV_FETCH(tw + ti + 2);
            PV_GATHER(vB, 1);
            PV_REDUCE(vA, 0, tw + ti);
            if (ti + 2 < 32) PV_STASH(0);
            PV_XLOAD(tw + ti + 1);
            if (ti + 3 < 32) PV_FETCH(tw + ti + 3);
            if (ti + 2 < 32) PV_GATHER(vA, 0);
            PV_REDUCE(vB, 1, tw + ti + 1);
            if (ti + 3 < 32) PV_STASH(1);
        }
#undef PV_XLOAD
#undef PV_FETCH
#undef PV_STASH
#undef PV_GATHER
#undef PV_REDUCE
    }
}
constexpr int NPHASE = 12;
struct Args { const float* in[23]; float* out; unsigned char* ws; int ph_lo, ph_hi; };
__global__ void __launch_bounds__(NWAVES * 64, 2) fwd(Args args) {
    extern __shared__ __attribute__((aligned(16))) unsigned char lds[];
    Frame F;
    F.lds = (LAS unsigned char*)lds; F.MISC = (volatile LAS unsigned*)(F.lds + MISC_OFF);
    F.tid = threadIdx.x; F.lane = F.tid & 63; F.wave = __builtin_amdgcn_readfirstlane(F.tid >> 6); F.G = gridDim.x;
    F.gw = blockIdx.x * NWAVES + F.wave; F.NGW = F.G * NWAVES;
    unsigned char* ws = args.ws;
    F.ctl = (unsigned*)(ws + WS_CTL);
    F.x = args.in[0]; F.p = args.in[1]; F.rel_bias = args.in[2]; F.attn_g = args.in[3]; F.w_in = args.in[4]; F.b_gate = args.in[5]; F.q_g = args.in[6]; F.k_g = args.in[7];
    F.w_att = args.in[8]; F.conv_w = args.in[9]; F.conv_b = args.in[10]; F.ln_g = args.in[11]; F.ln_b = args.in[12]; F.w_conv = args.in[13]; F.w_out = args.in[14]; F.ffn_g = args.in[15];
    F.w_pq = args.in[16]; F.subk = args.in[17]; F.pu = args.in[18]; F.pv = args.in[19]; F.ple_g = args.in[20]; F.w_pg = args.in[21]; F.w_pp = args.in[22]; F.out = args.out;
    F.ss1 = (float*)(ws + WS_SS1); F.ss2 = (float*)(ws + WS_SS1 + 128 * 1024); F.rstd1 = (float*)(ws + WS_RSTD1); F.rstd3 = (float*)(ws + WS_RSTD3); F.tab = (float*)(ws + WS_TAB); F.mb = (float*)(ws + WS_TAB + 64 * 1024); F.WI = (float*)(ws + WS_WI); F.KI = (bf16*)(ws + WS_KI);
    F.Win_t = (bf16*)(ws + WS_WIN); F.Wa_t = (bf16*)(ws + WS_WA); F.Wc_t = (bf16*)(ws + WS_WC); F.Wout_t = (bf16*)(ws + WS_WOUT); F.Wq_t = (bf16*)(ws + WS_WQ); F.Wg_t = (bf16*)(ws + WS_WG); F.Wp_t = (bf16*)(ws + WS_WP);
    F.SUBK = (bf16*)(ws + WS_SUBK); F.EU = (bf16*)(ws + WS_EU); F.EV = (bf16*)(ws + WS_EV); F.PB = (bf16*)(ws + WS_PB);
    F.XB = (bf16*)(ws + WS_RC); F.ATT = (bf16*)(ws + WS_RA + 64 * MiB); F.CV = (bf16*)(ws + WS_RA + 96 * MiB);
    F.UB = (bf16*)(ws + WS_RD); F.bitmap = (unsigned*)(ws + WS_RD + 32 * MiB); F.MIX = (bf16*)(ws + WS_RD); F.PP = (bf16*)(ws + WS_RD);
    F.Q = (bf16*)(ws + WS_RB); F.K = (bf16*)(ws + WS_RB + 32 * MiB); F.V = (bf16*)(ws + WS_RB + 64 * MiB); F.QI = (bf16*)(ws + WS_RB + 96 * MiB);
    F.GB = (bf16*)(ws + WS_RA); F.QP = (bf16*)(ws + WS_RA);
    for (int u = F.tid; u < (LDS_BYTES - LDSCTL_OFF) / 4; u += NWAVES * 64) ((LAS unsigned*)(F.lds + LDSCTL_OFF))[u] = 0u;
    __syncthreads();
    const int lo = args.ph_lo, hi = args.ph_hi;
    XcdBarrier bar; bar.bar = F.ctl + CW_BAR; bar.x = 0; bar.st = nullptr;
    if (hi - lo > 1) bar = xcd_barrier_post(F.ctl + CW_BAR, F.MISC + 8);
#ifndef PH_MASK
#define PH_MASK 0xfff
#endif
#define IN(k) (((PH_MASK >> (k)) & 1) && lo <= (k) && (k) < hi)
#define SEAM(k) do { if (IN(k) && IN((k) + 1)) xcd_barrier(bar); } while (0)
#ifndef REP_MASK
#define REP_MASK 0
#endif
#define NREP(k) (((REP_MASK >> (k)) & 1) ? 2 : 1)
    const int bid = (int)blockIdx.x;

    if (IN(0)) for (int rep_ = 0; rep_ < NREP(0); ++rep_) { p0_prologue(F); } SEAM(0);
    if (IN(1)) for (int rep_ = 0; rep_ < NREP(1); ++rep_) {
        pg8::Gemm g{F.XB, F.Win_t, M, NIN, opaque_i(D)}; pg8::StaticOrder S; S.init(M, NIN, F.G, bid);
        epi::EpiInProj E{F.rstd1, F.Q, F.K, F.V, F.QI, F.UB, F.GB, F.KI, F.WI, F.q_g, F.k_g, F.b_gate};
        pg8::gemm_phase<epi::EpiInProj, pg8::StaticOrder, true, true>(F.lds + RING_OFF, g, S, E);
    } SEAM(1);
#ifdef NAIVE_P2
    if (IN(2)) for (int rep_ = 0; rep_ < NREP(2); ++rep_) { p2_index_naive(F, F.out); p2_conv_naive(F); } SEAM(2);
#else
    if (IN(2)) for (int rep_ = 0; rep_ < NREP(2); ++rep_) { for (int r2_ = 0; r2_ < NREP(9); ++r2_) p2_index(F); for (int r2_ = 0; r2_ < NREP(10); ++r2_) p2_conv(F); } SEAM(2);
#endif
#ifdef NAIVE_P3
    if (IN(3)) for (int rep_ = 0; rep_ < NREP(3); ++rep_) { p3_attn_naive(F); } SEAM(3);
#else
    if (IN(3)) for (int rep_ = 0; rep_ < NREP(3); ++rep_) { static_assert(attn2::ATTN_LDS_BYTES <= RING_BYTES && attn2::TBN == TABN && attn2::TBOFF == TABOFF, "attention body vs frame");
        const attn2::StaticOrder S((int)F.G, bid);
        attn2::attn_phase((char*)lds + RING_OFF, (const attn2::bf16*)F.Q, (const attn2::bf16*)F.K, (const attn2::bf16*)F.V, (attn2::bf16*)F.ATT, F.bitmap, F.tab, F.mb, S); } SEAM(3);
#endif
    if (IN(4)) for (int rep_ = 0; rep_ < NREP(4); ++rep_) {
        { pg8::Gemm g{F.ATT, F.Wa_t, M, D, opaque_i(1024)}; pg8::StaticOrder S; S.init(M, D, F.G, bid); epi::EpiGate2 E{(const unsigned char*)F.GB, F.MIX};
          pg8::gemm_phase<epi::EpiGate2, pg8::StaticOrder, true, true, true>(F.lds + RING_OFF, g, S, E); }
    } SEAM(4);
    if (IN(5)) for (int rep_ = 0; rep_ < NREP(5); ++rep_) {
        pg8::Gemm g{F.MIX, F.Wout_t, M, D, opaque_i(D)}; pg8::StaticOrder S; S.init(M, D, F.G, bid); epi::EpiRes1 E{F.x, F.out, F.XB, F.ss1};
        pg8::gemm_phase<epi::EpiRes1, pg8::StaticOrder, true, true>(F.lds + RING_OFF, g, S, E);
    } SEAM(5);
    if (IN(6)) for (int rep_ = 0; rep_ < NREP(6); ++rep_) {
        pg8::Gemm g{F.XB, F.Wq_t, M, 2048, opaque_i(D)}; pg8::StaticOrder S; S.init(M, 2048, F.G, bid); epi::EpiScaleRow E{F.ss1, F.QP, 2048};
        pg8::gemm_phase<epi::EpiScaleRow, pg8::StaticOrder, true, true>(F.lds + RING_OFF, g, S, E);
    } SEAM(6);
#ifdef NAIVE_P7
    if (IN(7)) for (int rep_ = 0; rep_ < NREP(7); ++rep_) { p7_peer_naive(F); } SEAM(7);
#else
    if (IN(7)) for (int rep_ = 0; rep_ < NREP(7); ++rep_) { p7_peer(F, (unsigned*)(ws + WS_RB), (unsigned short*)(ws + WS_RB + 40 * MiB), (float*)(ws + WS_RB + 56 * MiB)); } SEAM(7);
    if (IN(8)) for (int rep_ = 0; rep_ < NREP(11); ++rep_) { p7_uphase(F, (const unsigned short*)(ws + WS_RB + 40 * MiB), (bf16*)(ws + WS_RA), rep_ * 2048); } SEAM(8);
    if (IN(9)) for (int rep_ = 0; rep_ < NREP(13); ++rep_) { p7_reduce(F, (const bf16*)(ws + WS_RA), (const float*)(ws + WS_RB + 56 * MiB), (float*)(ws + WS_RB + 72 * MiB)); } SEAM(9);
    if (IN(10)) for (int rep_ = 0; rep_ < NREP(12); ++rep_) { p7_vphase(F, (const unsigned short*)(ws + WS_RB + 40 * MiB), (const float*)(ws + WS_RB + 72 * MiB), F.ss2, rep_ * 2048, rep_ + 1 < NREP(12)); } SEAM(10);
#endif
    if (IN(11)) for (int rep_ = 0; rep_ < NREP(8); ++rep_) {
#ifndef NO8A
        { pg8::Gemm g{F.PB, F.Wp_t, M, D, opaque_i(PLE)}; pg8::StaticOrder S; S.init(M, D, F.G, bid); epi::EpiPlain E{F.PP, D};
          pg8::gemm_phase<epi::EpiPlain, pg8::StaticOrder, true, true>(F.lds + RING_OFF, g, S, E); }
#endif
#ifndef NO8B
        { pg8::Gemm g{F.XB, F.Wg_t, M, D, opaque_i(D)}; pg8::StaticOrder S; S.init(M, D, F.G, bid); epi::EpiPle E{F.ss2, F.PP, F.XB, F.out};
          pg8::gemm_phase<epi::EpiPle, pg8::StaticOrder, true, true>(F.lds + RING_OFF, g, S, E); }
#endif
    }
#undef IN
#undef SEAM
}

#ifndef MK_MULTI
#define MK_MULTI 0
#endif
extern "C" void kernel_launch(void* const* d_in, const int* in_sizes, int n_in, void* d_out, int out_size, void* d_ws, size_t ws_size, hipStream_t stream) {
    static int grid = 0;
    if (grid == 0) {
        if (n_in != 23 || in_sizes[0] != M * D || out_size != M * D || ws_size < WS_END) { fprintf(stderr, "kernel_launch: unexpected problem: n_in %d in0 %d out %d ws %zu (need %zu)\n", n_in, n_in > 0 ? in_sizes[0] : -1, out_size, ws_size, (size_t)WS_END); grid = -1; return; }
        int dev = 0, cus = 0;
        if (hipGetDevice(&dev) != hipSuccess || hipDeviceGetAttribute(&cus, hipDeviceAttributeMultiprocessorCount, dev) != hipSuccess) { grid = -1; return; }
        if (hipFuncSetAttribute((const void*)fwd, hipFuncAttributeMaxDynamicSharedMemorySize, LDS_BYTES) != hipSuccess) { fprintf(stderr, "kernel_launch: hipFuncSetAttribute failed\n"); grid = -1; return; }
        int per_cu = 0;
        if (hipOccupancyMaxActiveBlocksPerMultiprocessor(&per_cu, (const void*)fwd, NWAVES * 64, LDS_BYTES) != hipSuccess || per_cu < 1) fprintf(stderr, "kernel_launch: occupancy query says %d\n", per_cu);
        (void)hipGetLastError();
        grid = cus;
    }
    if (grid < 0) return;
    if (hipMemsetAsync((char*)d_ws + WS_CTL, 0, CTL_ZERO_BYTES, stream) != hipSuccess) return;
    Args a{};
    for (int i = 0; i < 23; ++i) a.in[i] = (const float*)d_in[i];
    a.out = (float*)d_out; a.ws = (unsigned char*)d_ws;
#if MK_MULTI
    for (int ph = 0; ph < NPHASE; ++ph) { a.ph_lo = ph; a.ph_hi = ph + 1; hipLaunchKernelGGL(fwd, dim3(grid), dim3(NWAVES * 64), LDS_BYTES, stream, a); }
#else
    a.ph_lo = 0; a.ph_hi = NPHASE; hipLaunchKernelGGL(fwd, dim3(grid), dim3(NWAVES * 64), LDS_BYTES, stream, a);
#endif
}
```
